# Optimizing an MI355X kernel written in HIP

```python
import jax, jax.numpy as jnp
from jax import lax
import numpy as np

D_MODEL = 1024
BATCH = 16
SEQ = 2048
DEPTH = 1

MEM_LEN = 256
HEAD_DIM = 64
FOX_HEADS = D_MODEL // 128
FOX_W = FOX_HEADS * HEAD_DIM
RWKV_HEADS = D_MODEL // 128
RWKV_W = RWKV_HEADS * HEAD_DIM
MEM_HEADS = 4
MEM_W = D_MODEL // 2
MEM_HEAD_DIM = MEM_W // MEM_HEADS
DECAY_LORA = 64
AAA_LORA = 64
GATE_LORA = 128
N_BRANCH = 3
D_FF = -(-8 * D_MODEL // (3 * 256)) * 256
Q_BLOCK = 128
NORM_EPS = 1e-6
GN_EPS = 64e-5

FOX_COLS = 3 * FOX_W + FOX_HEADS
RWKV_WIDTHS = (RWKV_W, RWKV_W, RWKV_W, DECAY_LORA, AAA_LORA, GATE_LORA)
RWKV_COLS = sum(RWKV_WIDTHS)
GATE_COLS = N_BRANCH * D_MODEL
IN_COLS = FOX_COLS + RWKV_COLS + MEM_W + GATE_COLS

kernel_name = "fox_rwkv7_memxattn_gated_hybrid"


def _split(x, widths):
    idx = [int(i) for i in np.cumsum(widths)[:-1]]
    return jnp.split(x, idx, axis=-1)


def rmsnorm(x, g):
    xf = x.astype(jnp.float32)
    y = xf * lax.rsqrt(jnp.mean(xf * xf, axis=-1, keepdims=True) + NORM_EPS)
    return (y * g.astype(jnp.float32)).astype(x.dtype)


def forgetting_attention(q, k, v, f_logit):
    B, S, H, Dh = q.shape
    c = jnp.cumsum(jax.nn.log_sigmoid(f_logit.astype(jnp.float32)), axis=1)
    cT = jnp.transpose(c, (0, 2, 1))
    scale = Dh ** -0.5
    tri = jnp.tril(jnp.ones((Q_BLOCK, Q_BLOCK), dtype=bool))
    outs = []
    for i in range(S // Q_BLOCK):
        lo, hi = i * Q_BLOCK, (i + 1) * Q_BLOCK
        logits = jnp.einsum('bqhd,bkhd->bhqk', q[:, lo:hi], k[:, :hi]).astype(jnp.float32) * scale
        bias = cT[:, :, lo:hi, None] - cT[:, :, None, :hi]
        mask = jnp.concatenate([jnp.ones((Q_BLOCK, lo), dtype=bool), tri], axis=1)
        logits = jnp.where(mask, logits + bias, -jnp.inf)
        p = jax.nn.softmax(logits, axis=-1).astype(v.dtype)
        outs.append(jnp.einsum('bhqk,bkhd->bqhd', p, v[:, :hi]))
    return jnp.concatenate(outs, axis=1).reshape(B, S, H * Dh)


def rwkv7_time_mix(p, mu, w0, w_up, a0, a_up, g_up, k_k, k_a, r_k, gn_g, gn_b):
    B, S, _ = p.shape
    H, N = RWKV_HEADS, HEAD_DIM
    p = p.astype(jnp.float32)
    p_prev = jnp.pad(p, ((0, 0), (1, 0), (0, 0)))[:, :-1]
    p = p + (p_prev - p) * mu
    r, k, v, wd, ad, gd = _split(p, RWKV_WIDTHS)
    w_log = -jnp.exp(jax.nn.log_sigmoid(w0 + jnp.tanh(wd) @ w_up) - 0.5)
    a = jax.nn.sigmoid(a0 + ad @ a_up)
    g = jax.nn.sigmoid(gd) @ g_up
    kk = (k * k_k).reshape(B, S, H, N)
    kk = kk * lax.rsqrt(jnp.maximum(jnp.sum(kk * kk, axis=-1, keepdims=True), 1e-24))
    k = k * (1.0 + (a - 1.0) * k_a)
    rh = r.reshape(B, S, H, N)
    kh = k.reshape(B, S, H, N)
    vh = v.reshape(B, S, H, N)
    ah = a.reshape(B, S, H, N)
    wh = jnp.exp(w_log).reshape(B, S, H, N)
    a_vec = -kk
    b_vec = kk * ah

    def step(state, inp):
        r_t, w_t, k_t, v_t, a_t, b_t = inp
        sa = jnp.einsum('bhij,bhj->bhi', state, a_t)
        state = state * w_t[:, :, None, :] + sa[..., None] * b_t[:, :, None, :] + v_t[..., None] * k_t[:, :, None, :]
        y = jnp.einsum('bhij,bhj->bhi', state, r_t)
        return state, y

    xs = tuple(jnp.moveaxis(t, 1, 0) for t in (rh, wh, kh, vh, a_vec, b_vec))
    s0 = jnp.zeros((B, H, N, N), jnp.float32)
    _, ys = lax.scan(step, s0, xs)
    y = jnp.moveaxis(ys, 0, 1)
    mean = jnp.mean(y, axis=-1, keepdims=True)
    var = jnp.mean(jnp.square(y - mean), axis=-1, keepdims=True)
    y = ((y - mean) * lax.rsqrt(var + GN_EPS)).reshape(B, S, H * N) * gn_g + gn_b
    bonus = jnp.sum(rh * kh * r_k, axis=-1, keepdims=True) * vh
    return (y + bonus.reshape(B, S, H * N)) * g


def memory_cross_attention(q, mem_kv):
    B, S, _ = q.shape
    km, vm = _split(mem_kv, (MEM_W, MEM_W))
    qh = q.reshape(B, S, MEM_HEADS, MEM_HEAD_DIM)
    kh = km.reshape(B, -1, MEM_HEADS, MEM_HEAD_DIM)
    vh = vm.reshape(B, -1, MEM_HEADS, MEM_HEAD_DIM)
    logits = jnp.einsum('bqhd,bkhd->bhqk', qh, kh).astype(jnp.float32) * MEM_HEAD_DIM ** -0.5
    p = jax.nn.softmax(logits, axis=-1).astype(vh.dtype)
    return jnp.einsum('bhqk,bkhd->bqhd', p, vh).reshape(B, S, MEM_W)


def setup_inputs(seed: int = 0) -> dict:
    key = jax.random.key(seed)
    ks = jax.random.split(key, 32)
    f32 = jnp.float32
    L, D = DEPTH, D_MODEL

    def nrm(k, shape, fan_in):
        return jax.random.normal(k, shape, f32) * fan_in ** -0.5

    def gain(k, shape):
        return 1.0 + 0.1 * jax.random.normal(k, shape, f32)

    return {
        "x": jax.random.normal(ks[0], (BATCH, SEQ, D), f32),
        "mem": jax.random.normal(ks[1], (BATCH, MEM_LEN, D), f32),
        "pre1_g": gain(ks[2], (L, D)),
        "post1_g": gain(ks[3], (L, D)),
        "pre2_g": gain(ks[4], (L, D)),
        "post2_g": gain(ks[5], (L, D)),
        "mem_norm_g": gain(ks[6], (L, D)),
        "w_in": nrm(ks[7], (L, D, IN_COLS), D),
        "fox_f_bias": jax.random.uniform(ks[8], (L, FOX_HEADS), f32, 1.0, 4.0),
        "rwkv_mu": jax.random.uniform(ks[9], (L, RWKV_COLS), f32),
        "rwkv_w0": jax.random.normal(ks[10], (L, RWKV_W), f32),
        "rwkv_w_up": nrm(ks[11], (L, DECAY_LORA, RWKV_W), DECAY_LORA),
        "rwkv_a0": 0.5 * jax.random.normal(ks[12], (L, RWKV_W), f32),
        "rwkv_a_up": nrm(ks[13], (L, AAA_LORA, RWKV_W), AAA_LORA),
        "rwkv_g_up": nrm(ks[14], (L, GATE_LORA, RWKV_W), GATE_LORA),
        "rwkv_k_k": 0.85 + 0.05 * jax.random.normal(ks[15], (L, RWKV_W), f32),
        "rwkv_k_a": 1.0 + 0.05 * jax.random.normal(ks[16], (L, RWKV_W), f32),
        "rwkv_r_k": 0.1 * jax.random.normal(ks[17], (L, RWKV_HEADS, HEAD_DIM), f32),
        "rwkv_gn_g": gain(ks[18], (L, RWKV_W)),
        "rwkv_gn_b": 0.02 * jax.random.normal(ks[19], (L, RWKV_W), f32),
        "w_mem_kv": nrm(ks[20], (L, D, 2 * MEM_W), D),
        "w_fox_out": nrm(ks[21], (L, FOX_W, D), FOX_W),
        "w_rwkv_out": nrm(ks[22], (L, RWKV_W, D), RWKV_W),
        "w_mem_out": nrm(ks[23], (L, MEM_W, D), MEM_W),
        "w_o": nrm(ks[24], (L, D, D), D),
        "w_ffn_gate": nrm(ks[25], (L, D, D_FF), D),
        "w_ffn_up": nrm(ks[26], (L, D, D_FF), D),
        "w_ffn_down": nrm(ks[27], (L, D_FF, D), D_FF),
    }


def reference(x, mem, pre1_g, post1_g, pre2_g, post2_g, mem_norm_g, w_in, fox_f_bias,
              rwkv_mu, rwkv_w0, rwkv_w_up, rwkv_a0, rwkv_a_up, rwkv_g_up, rwkv_k_k, rwkv_k_a,
              rwkv_r_k, rwkv_gn_g, rwkv_gn_b, w_mem_kv, w_fox_out, w_rwkv_out, w_mem_out, w_o,
              w_ffn_gate, w_ffn_up, w_ffn_down):
    B, S, D = x.shape
    h = x
    for l in range(DEPTH):
        u = rmsnorm(h, pre1_g[l])
        proj = u @ w_in[l]
        p_fox, p_rwkv, p_memq, p_gate = _split(proj, (FOX_COLS, RWKV_COLS, MEM_W, GATE_COLS))

        fq, fk, fv, ff = _split(p_fox, (FOX_W, FOX_W, FOX_W, FOX_HEADS))
        fox_out = forgetting_attention(
            fq.reshape(B, S, FOX_HEADS, HEAD_DIM), fk.reshape(B, S, FOX_HEADS, HEAD_DIM),
            fv.reshape(B, S, FOX_HEADS, HEAD_DIM), ff + fox_f_bias[l])

        rwkv_out = rwkv7_time_mix(p_rwkv, rwkv_mu[l], rwkv_w0[l], rwkv_w_up[l], rwkv_a0[l],
                                  rwkv_a_up[l], rwkv_g_up[l], rwkv_k_k[l], rwkv_k_a[l],
                                  rwkv_r_k[l], rwkv_gn_g[l], rwkv_gn_b[l])

        mem_kv = rmsnorm(mem, mem_norm_g[l]) @ w_mem_kv[l]
        mem_out = memory_cross_attention(p_memq, mem_kv)

        g_fox, g_rwkv, g_mem = _split(jax.nn.sigmoid(p_gate.astype(jnp.float32)), (D, D, D))
        merged = (g_fox * (fox_out @ w_fox_out[l])
                  + g_rwkv * (rwkv_out @ w_rwkv_out[l])
                  + g_mem * (mem_out @ w_mem_out[l]))
        y = merged @ w_o[l]
        h = h + rmsnorm(y, post1_g[l])

        u2 = rmsnorm(h, pre2_g[l])
        ffn = (jax.nn.silu(u2 @ w_ffn_gate[l]) * (u2 @ w_ffn_up[l])) @ w_ffn_down[l]
        h = h + rmsnorm(ffn, post2_g[l])
    return h.astype(x.dtype)
```

```cpp
#include <hip/hip_runtime.h>
#include <cstdio>
#include <cstdint>

#ifndef MK_N_LAUNCHES
#define MK_N_LAUNCHES 1
#endif

#define LAS __attribute__((address_space(3)))
#define GAS __attribute__((address_space(1)))
typedef unsigned short bf16_t;
typedef short bf16x8 __attribute__((ext_vector_type(8)));
typedef float f32x4 __attribute__((ext_vector_type(4)));
typedef float f32x2 __attribute__((ext_vector_type(2)));
typedef unsigned u32x4 __attribute__((ext_vector_type(4)));
typedef unsigned u32x2 __attribute__((ext_vector_type(2)));

constexpr int BATCH = 16, SEQ = 2048, DM = 1024, M = BATCH * SEQ;
constexpr int MEMLEN = 256, MMEM = BATCH * MEMLEN;
constexpr int DFF = 2816;
constexpr int INCOLS = 6920;
constexpr int PA = 3840;
constexpr int C_FQ = 0, C_FK = 512, C_FV = 1024, C_RR = 1536, C_RK = 2048, C_RV = 2560, C_MQ = 3072, C_WD = 3584, C_AD = 3648, C_GD = 3712;
constexpr float NORM_EPS = 1e-6f, GN_EPS = 64e-5f;
constexpr float LOG2E = 1.4426950408889634f;
constexpr float C2_FOX = 0.125f * LOG2E;
constexpr float C2_MEM = 0.08838834764831845f * LOG2E;

constexpr size_t MiB = 1u << 20;
constexpr size_t WS_CTL = 0, CTL_ZERO_BYTES = 1 * MiB;
constexpr size_t WS_WALL = 1 * MiB;
constexpr size_t WS_WBR = 17 * MiB;
constexpr size_t WS_WO = 20 * MiB;
constexpr size_t WS_WGU = 22 * MiB;
constexpr size_t WS_WDN = 33 * MiB;
constexpr size_t WS_LS = 39 * MiB;
constexpr size_t WS_XNALL = 41 * MiB;
constexpr size_t WS_PROJA = 113 * MiB;
constexpr size_t WS_G01 = 353 * MiB;
constexpr size_t WS_MEMKV = 481 * MiB;
constexpr size_t WS_END = 489 * MiB;
constexpr size_t WS_MERGED = WS_XNALL;
constexpr size_t WS_Y = WS_G01;
constexpr size_t WS_U2 = WS_PROJA;
constexpr size_t WS_HID = WS_PROJA + 64 * MiB;
constexpr size_t WS_FO = WS_G01;
static_assert(WS_HID + (size_t)M * DFF * 2 <= WS_G01, "HID overlay");

constexpr int CW_TMO = 0, CW_CODE = 1;
constexpr int CW_BAR = 4096;
constexpr int CW_QUEUE = 2048;

constexpr int RING_OFF = 0, RING_BYTES = 131072;
constexpr int LDSCTL_OFF = RING_BYTES, MISC_OFF = LDSCTL_OFF + 320;
constexpr int EXTRA_OFF = MISC_OFF + 128;
constexpr int LDS_BYTES = 147456;
constexpr int NWAVES = 8;

__device__ __forceinline__ unsigned f2bf(float f) { unsigned u = __builtin_bit_cast(unsigned, f); return (u + 0x7fffu + ((u >> 16) & 1u)) >> 16; }
__device__ __forceinline__ unsigned pk2(float lo, float hi) { return f2bf(lo) | (f2bf(hi) << 16); }
__device__ __forceinline__ float bflo(unsigned w) { return __builtin_bit_cast(float, w << 16); }
__device__ __forceinline__ float bfhi(unsigned w) { return __builtin_bit_cast(float, w & 0xffff0000u); }
__device__ __forceinline__ float sigm(float x) { return 1.0f / (1.0f + __expf(-x)); }
__device__ __forceinline__ float wave_sum(float v) {
#pragma unroll
    for (int o = 1; o < 64; o <<= 1) v += __shfl_xor(v, o);
    return v;
}
#define LDS_WAIT() asm volatile("s_waitcnt lgkmcnt(0)" ::: "memory")
#define VM_WAIT() asm volatile("s_waitcnt vmcnt(0)" ::: "memory")

namespace pg8 {
#define PG8_LAS __attribute__((address_space(3)))
constexpr int BM = 256, BK = 64, HALF = 128, HTB = HALF * BK * 2, STAGE_BYTES = 8 * HTB, NXCD = 8, WGM = 8;
__host__ __device__ __forceinline__ int lds_byte(int r, int c) { const int st = (r >> 4) * 2 + (c >> 5), rr = r & 15, cc = c & 31, ob = rr * 64 + cc * 2; return st * 1024 + (ob ^ (((ob >> 9) & 1) << 5)); }
__host__ __device__ __forceinline__ void stage_rc(int b, int& R, int& C) { const int st = b / 1024, sb = b % 1024, swz = sb ^ (((sb >> 9) & 1) << 5); R = (st >> 1) * 16 + swz / 64; C = (st & 1) * 32 + (swz % 64) / 2; }
__host__ __device__ __forceinline__ int perm32(int rho) { const int n = rho >> 4, i = rho & 15; return 8 * (i >> 2) + 4 * n + (i & 3); }

struct Unit { int pm, pn, tag; const char* a; const char* b; };
struct Gemm { int K, lda, ldb; };

__device__ __forceinline__ void tile_of(int L, int nM, int nN, int& pm, int& pn) {
    const int nwg = nM * nN; int wgid = L;
    { const int q = nwg / NXCD, r = nwg % NXCD, xcd = wgid % NXCD, off = wgid / NXCD; wgid = (xcd < r ? xcd * (q + 1) : r * (q + 1) + (xcd - r) * q) + off; }
    const int nig = WGM * nN, gid = wgid / nig, fm = gid * WGM, gsz = (nM - fm) < WGM ? (nM - fm) : WGM;
    pm = fm + ((wgid % nig) % gsz); pn = (wgid % nig) / gsz;
}

typedef __bf16 bf16x2_t __attribute__((ext_vector_type(2)));
__device__ __forceinline__ unsigned cvt_pk_bf16(float lo, float hi) { f32x2 v = {lo, hi}; bf16x2_t b = __builtin_convertvector(v, bf16x2_t); return __builtin_bit_cast(unsigned, b); }

template <class Epi, class Sched, bool ALIGN_EPI = false, bool SP2 = false>
__device__ __forceinline__ void gemm_phase(PG8_LAS unsigned char* lds, const Gemm g, const Sched& S, const Epi& E) {
    const int tid = threadIdx.x, wid = __builtin_amdgcn_readfirstlane(tid >> 6), lane = tid & 63, wr = wid >> 2, wc = wid & 3, fr = lane & 15, fq = lane >> 4;
    const int K = g.K, nt = K / BK;
    unsigned voffA[2], voffB[2];
#pragma unroll
    for (int i = 0; i < 2; ++i) { int R, C; stage_rc(tid * 16 + i * 8192, R, C); const int Rb = Epi::PERM ? ((R & ~31) + perm32(R & 31)) : R;
        voffA[i] = (unsigned)(R * g.lda + C) * 2u; voffB[i] = (unsigned)(Rb * g.ldb + C) * 2u; }
    const size_t kstep = (size_t)(BK * 2);
    const size_t hstepA = (size_t)HALF * g.lda * 2, hstepB = (size_t)HALF * g.ldb * 2;
    const unsigned ldsw = (unsigned)wid * 1024u;
    const int aoff = lds_byte(wr * 64 + fr, fq * 8), boff = lds_byte(wc * 32 + fr, fq * 8);
#define PG8_SA(b, h) (((b) * 2 + (h)) * HTB)
#define PG8_SB(b, h) ((4 + (b) * 2 + (h)) * HTB)
#define PG8_STAGE(bufoff, gbase, voff) do { _Pragma("unroll") for (int _i = 0; _i < 2; ++_i) \
        __builtin_amdgcn_global_load_lds((const unsigned*)((const char*)(gbase) + (voff)[_i]), (PG8_LAS unsigned*)(lds + (bufoff) + ldsw + _i * 8192), 16, 0, 0); } while (0)
#define PG8_LDA(dst, b, h) do { _Pragma("unroll") for (int m = 0; m < 4; ++m) _Pragma("unroll") for (int k = 0; k < 2; ++k) dst[m][k] = *(const PG8_LAS bf16x8*)(lds + PG8_SA(b, h) + aoff + m * 2048 + k * 1024); } while (0)
#define PG8_LDB(dst, b, h) do { _Pragma("unroll") for (int n = 0; n < 2; ++n) _Pragma("unroll") for (int k = 0; k < 2; ++k) dst[n][k] = *(const PG8_LAS bf16x8*)(lds + PG8_SB(b, h) + boff + n * 2048 + k * 1024); } while (0)
#define PG8_MMA(ai, bj, At, Bt) do { __builtin_amdgcn_s_setprio(1); _Pragma("unroll") for (int m = 0; m < 4; ++m) _Pragma("unroll") for (int n = 0; n < 2; ++n) _Pragma("unroll") for (int k = 0; k < 2; ++k) \
        acc[ai][bj][m][n] = __builtin_amdgcn_mfma_f32_16x16x32_bf16(Bt[n][k], At[m][k], acc[ai][bj][m][n], 0, 0, 0); __builtin_amdgcn_s_setprio(0); } while (0)
#define PG8_WAIT_V(n) asm volatile("s_waitcnt vmcnt(" #n ")" ::: "memory")
#define PG8_WAIT_L(n) asm volatile("s_waitcnt lgkmcnt(" #n ")" ::: "memory")
#define PG8_BAR __builtin_amdgcn_s_barrier()
#define PG8_SCHED __builtin_amdgcn_sched_barrier(0)
    Unit cur, nxt; int ui = 0;
    if (!S.next(0, cur)) return;
    f32x4 acc[2][2][4][2];
#pragma unroll
    for (int a = 0; a < 2; ++a)
#pragma unroll
        for (int b = 0; b < 2; ++b)
#pragma unroll
            for (int m = 0; m < 4; ++m)
#pragma unroll
                for (int n = 0; n < 2; ++n) acc[a][b][m][n] = (f32x4){0.f, 0.f, 0.f, 0.f};
    bf16x8 At[4][2], B0[2][2], B1[2][2];
    const char* cA = cur.a; const char* cB = cur.b;
    if constexpr (SP2) {
        PG8_STAGE(PG8_SB(0, 0), cB, voffB); PG8_STAGE(PG8_SB(0, 1), cB + hstepB, voffB); PG8_STAGE(PG8_SA(0, 0), cA, voffA); PG8_STAGE(PG8_SA(0, 1), cA + hstepA, voffA);
        if (wr == 1) PG8_BAR;
        PG8_WAIT_V(2); PG8_BAR;
        PG8_STAGE(PG8_SB(1, 0), cB + kstep, voffB); PG8_STAGE(PG8_SA(1, 0), cA + kstep, voffA); PG8_STAGE(PG8_SB(1, 1), cB + hstepB + kstep, voffB);
        PG8_WAIT_V(6); PG8_BAR;
    } else {
        PG8_STAGE(PG8_SB(0, 0), cB, voffB); PG8_STAGE(PG8_SA(0, 0), cA, voffA); PG8_STAGE(PG8_SB(0, 1), cB + hstepB, voffB); PG8_STAGE(PG8_SA(0, 1), cA + hstepA, voffA);
        if (wr == 1) PG8_BAR;
        PG8_WAIT_V(4); PG8_BAR;
        PG8_STAGE(PG8_SB(1, 0), cB + kstep, voffB); PG8_STAGE(PG8_SA(1, 0), cA + kstep, voffA); PG8_STAGE(PG8_SB(1, 1), cB + hstepB + kstep, voffB);
        PG8_WAIT_V(6); PG8_BAR;
    }
    for (;;) {
        const bool has_next = S.next(ui + 1, nxt);
        const char* nA = has_next ? nxt.a : cA; const char* nB = has_next ? nxt.b : cB;
        for (int t = 0; t < nt; t += 2) {
            const bool last = (t == nt - 2);
            const char* a1 = cA + (size_t)(t + 1) * kstep;
            const char* a2 = last ? nA : cA + (size_t)(t + 2) * kstep; const char* b2 = last ? nB : cB + (size_t)(t + 2) * kstep;
            const char* a3 = a2 + kstep; const char* b3 = b2 + kstep;
            if constexpr (SP2) {
            PG8_LDB(B0, 0, 0); PG8_LDB(B1, 0, 1); PG8_SCHED; PG8_LDA(At, 0, 0); PG8_STAGE(PG8_SA(1, 1), a1 + hstepA, voffA);
            PG8_WAIT_V(8); PG8_WAIT_L(0); PG8_BAR; PG8_MMA(0, 0, At, B0); PG8_MMA(0, 1, At, B1); PG8_BAR; PG8_SCHED;
            PG8_LDA(At, 0, 1); PG8_STAGE(PG8_SB(0, 0), b2, voffB); PG8_STAGE(PG8_SB(0, 1), b2 + hstepB, voffB); PG8_STAGE(PG8_SA(0, 0), a2, voffA);
            PG8_WAIT_V(8); PG8_WAIT_L(0); PG8_BAR; PG8_MMA(1, 0, At, B0); PG8_MMA(1, 1, At, B1); PG8_BAR; PG8_SCHED;
            PG8_LDB(B0, 1, 0); PG8_LDB(B1, 1, 1); PG8_SCHED; PG8_LDA(At, 1, 0); PG8_STAGE(PG8_SA(0, 1), a2 + hstepA, voffA);
            PG8_WAIT_V(8); PG8_WAIT_L(0); PG8_BAR; PG8_MMA(0, 0, At, B0); PG8_MMA(0, 1, At, B1); PG8_BAR; PG8_SCHED;
            PG8_LDA(At, 1, 1); PG8_STAGE(PG8_SB(1, 0), b3, voffB); PG8_STAGE(PG8_SB(1, 1), b3 + hstepB, voffB); PG8_STAGE(PG8_SA(1, 0), a3, voffA);
            PG8_WAIT_V(8); PG8_WAIT_L(0); PG8_BAR; PG8_MMA(1, 0, At, B0); PG8_MMA(1, 1, At, B1); PG8_BAR; PG8_SCHED;
            } else {
            PG8_LDB(B0, 0, 0); PG8_SCHED; PG8_LDA(At, 0, 0); PG8_STAGE(PG8_SA(1, 1), a1 + hstepA, voffA);
            PG8_WAIT_L(8); PG8_BAR; PG8_WAIT_L(0); PG8_MMA(0, 0, At, B0); PG8_BAR; PG8_SCHED;
            PG8_LDB(B1, 0, 1); PG8_STAGE(PG8_SB(0, 0), b2, voffB);
            PG8_BAR; PG8_WAIT_L(0); PG8_MMA(0, 1, At, B1); PG8_BAR;
            PG8_LDA(At, 0, 1); PG8_STAGE(PG8_SA(0, 0), a2, voffA);
            PG8_BAR; PG8_WAIT_L(0); PG8_MMA(1, 0, At, B0); PG8_BAR; PG8_SCHED;
            PG8_STAGE(PG8_SB(0, 1), b2 + hstepB, voffB);
            PG8_WAIT_V(6); PG8_BAR; PG8_MMA(1, 1, At, B1); PG8_BAR;
            PG8_LDB(B0, 1, 0); PG8_SCHED; PG8_LDA(At, 1, 0); PG8_STAGE(PG8_SA(0, 1), a2 + hstepA, voffA);
            PG8_WAIT_L(8); PG8_BAR; PG8_WAIT_L(0); PG8_MMA(0, 0, At, B0); PG8_BAR; PG8_SCHED;
            PG8_LDB(B1, 1, 1); PG8_STAGE(PG8_SB(1, 0), b3, voffB);
            PG8_BAR; PG8_WAIT_L(0); PG8_MMA(0, 1, At, B1); PG8_BAR;
            PG8_LDA(At, 1, 1); PG8_STAGE(PG8_SA(1, 0), a3, voffA);
            PG8_BAR; PG8_WAIT_L(0); PG8_MMA(1, 0, At, B0); PG8_BAR; PG8_SCHED;
            PG8_STAGE(PG8_SB(1, 1), b3 + hstepB, voffB);
            PG8_WAIT_V(6); PG8_BAR; PG8_MMA(1, 1, At, B1); PG8_BAR;
            }
        }
        if constexpr (ALIGN_EPI) { if (wr == 0) PG8_BAR; }
        if constexpr (!Epi::AFTER_DRAIN) { E(acc, cur, wr, wc, fr, fq); }
        if (!has_next) break;
#pragma unroll
        for (int a = 0; a < 2; ++a)
#pragma unroll
            for (int b = 0; b < 2; ++b)
#pragma unroll
                for (int m = 0; m < 4; ++m)
#pragma unroll
                    for (int n = 0; n < 2; ++n) acc[a][b][m][n] = (f32x4){0.f, 0.f, 0.f, 0.f};
        cur = nxt; cA = nA; cB = nB; ++ui;
        if constexpr (ALIGN_EPI) { if (wr == 1) PG8_BAR; }
    }
    PG8_WAIT_V(0);
    if constexpr (!ALIGN_EPI) { if (wr == 0) PG8_BAR; }
    PG8_BAR;
    if constexpr (Epi::AFTER_DRAIN) { E.fused(acc, cur, wr, wc, fr, fq, lds, wid, lane); }
#undef PG8_SA
#undef PG8_SB
#undef PG8_STAGE
#undef PG8_LDA
#undef PG8_LDB
#undef PG8_MMA
#undef PG8_WAIT_V
#undef PG8_WAIT_L
#undef PG8_BAR
#undef PG8_SCHED
}

#define PG8_FOR_GROUPS(acc, wr, wc, fr, fq, BODY) \
    _Pragma("unroll") for (int ai = 0; ai < 2; ++ai) _Pragma("unroll") for (int m = 0; m < 4; ++m) _Pragma("unroll") for (int bj = 0; bj < 2; ++bj) { \
        const int trow = ai * HALF + wr * 64 + m * 16 + fr, tcol = bj * HALF + wc * 32 + 8 * fq; f32x4 v0 = acc[ai][bj][m][0], v1 = acc[ai][bj][m][1]; BODY }

__device__ __forceinline__ u32x4 pack8(f32x4 v0, f32x4 v1) { u32x4 w; w.x = cvt_pk_bf16(v0[0], v0[1]); w.y = cvt_pk_bf16(v0[2], v0[3]); w.z = cvt_pk_bf16(v1[0], v1[1]); w.w = cvt_pk_bf16(v1[2], v1[3]); return w; }

struct EpiPlain {
    static constexpr bool PERM = true, AFTER_DRAIN = false;
    bf16_t* O; int ldc;
    __device__ __forceinline__ void operator()(const f32x4 (&acc)[2][2][4][2], const Unit& u, int wr, int wc, int fr, int fq) const {
        PG8_FOR_GROUPS(acc, wr, wc, fr, fq, { *(u32x4*)(O + (size_t)(u.pm * BM + trow) * ldc + u.pn * BM + tcol) = pack8(v0, v1); })
    }
};
struct EpiInProj {
    static constexpr bool PERM = true, AFTER_DRAIN = false;
    bf16_t* proja; bf16_t* g01; bf16_t* g2; bf16_t* memkv;
    __device__ __forceinline__ void operator()(const f32x4 (&acc)[2][2][4][2], const Unit& u, int wr, int wc, int fr, int fq) const {
        if (u.tag == 1) {
            PG8_FOR_GROUPS(acc, wr, wc, fr, fq, { *(u32x4*)(memkv + (size_t)((u.pm - 128) * BM + trow) * 1024 + (u.pn - 27) * BM + tcol) = pack8(v0, v1); })
        } else if (u.pn < 15) {
            const float sc = (u.pn < 2) ? C2_FOX : ((u.pn == 12 || u.pn == 13) ? C2_MEM : 1.0f);
            PG8_FOR_GROUPS(acc, wr, wc, fr, fq, { v0 = v0 * sc; v1 = v1 * sc; *(u32x4*)(proja + (size_t)(u.pm * BM + trow) * PA + u.pn * BM + tcol) = pack8(v0, v1); })
        } else {
            bf16_t* base; int ld, c0;
            if (u.pn < 23) { base = g01; ld = 2048; c0 = (u.pn - 15) * BM; } else { base = g2; ld = 1024; c0 = (u.pn - 23) * BM; }
            PG8_FOR_GROUPS(acc, wr, wc, fr, fq, {
                _Pragma("unroll") for (int e = 0; e < 4; ++e) { v0[e] = __builtin_amdgcn_rcpf(1.0f + __builtin_amdgcn_exp2f(-LOG2E * v0[e])); v1[e] = __builtin_amdgcn_rcpf(1.0f + __builtin_amdgcn_exp2f(-LOG2E * v1[e])); }
                *(u32x4*)(base + (size_t)(u.pm * BM + trow) * ld + c0 + tcol) = pack8(v0, v1); })
        }
    }
};
struct EpiMerge {
    static constexpr bool PERM = true, AFTER_DRAIN = false;
    const bf16_t* g01; const bf16_t* g2; bf16_t* merged;
    __device__ __forceinline__ void operator()(const f32x4 (&acc)[2][2][4][2], const Unit& u, int wr, int wc, int fr, int fq) const {
        const int b = u.tag;
        PG8_FOR_GROUPS(acc, wr, wc, fr, fq, {
            const size_t row = (size_t)(u.pm * BM + trow); const int col = u.pn * BM + tcol;
            const u32x4 gw = (b < 2) ? *(const u32x4*)(g01 + row * 2048 + b * 1024 + col) : *(const u32x4*)(g2 + row * 1024 + col);
            v0[0] *= bflo(gw.x); v0[1] *= bfhi(gw.x); v0[2] *= bflo(gw.y); v0[3] *= bfhi(gw.y); v1[0] *= bflo(gw.z); v1[1] *= bfhi(gw.z); v1[2] *= bflo(gw.w); v1[3] *= bfhi(gw.w);
            bf16_t* mp = merged + row * 1024 + col;
            if (b > 0) { const u32x4 mw = *(const u32x4*)mp;
                v0[0] += bflo(mw.x); v0[1] += bfhi(mw.x); v0[2] += bflo(mw.y); v0[3] += bfhi(mw.y); v1[0] += bflo(mw.z); v1[1] += bfhi(mw.z); v1[2] += bflo(mw.w); v1[3] += bfhi(mw.w); }
            *(u32x4*)mp = pack8(v0, v1); })
    }
};
struct EpiSwiGLU {
    static constexpr bool PERM = true, AFTER_DRAIN = false;
    bf16_t* hid;
    __device__ __forceinline__ void operator()(const f32x4 (&acc)[2][2][4][2], const Unit& u, int wr, int wc, int fr, int fq) const {
#pragma unroll
        for (int ai = 0; ai < 2; ++ai)
#pragma unroll
            for (int m = 0; m < 4; ++m) {
                const int trow = ai * HALF + wr * 64 + m * 16 + fr, tcol = wc * 32 + 8 * fq;
                f32x4 g0 = acc[ai][0][m][0], g1 = acc[ai][0][m][1]; const f32x4 u0 = acc[ai][1][m][0], u1 = acc[ai][1][m][1];
#pragma unroll
                for (int e = 0; e < 4; ++e) { g0[e] = g0[e] * __builtin_amdgcn_rcpf(1.0f + __builtin_amdgcn_exp2f(-LOG2E * g0[e])) * u0[e]; g1[e] = g1[e] * __builtin_amdgcn_rcpf(1.0f + __builtin_amdgcn_exp2f(-LOG2E * g1[e])) * u1[e]; }
                *(u32x4*)(hid + (size_t)(u.pm * BM + trow) * DFF + u.pn * HALF + tcol) = pack8(g0, g1);
            }
    }
};
}

typedef GAS unsigned gu32;
#define RLX_AGENT __ATOMIC_RELAXED, __HIP_MEMORY_SCOPE_AGENT
#define XB_TMO      128
#define XB_XCNT(j)  (256  + 64 * (j))
#define XB_XSUB(j)  (1280 + 64 * (j))
#define XB_XGEN(j)  (2304 + 64 * (j))
#define XB_TOP      3328
#define XB_TOPGEN   3392
#define XCD_BAR_WORDS 3456
#define XB_SPIN_CAP (1u << 18)
__device__ __forceinline__ unsigned xb_ld(unsigned* p)              { return __hip_atomic_load(p, __ATOMIC_RELAXED, __HIP_MEMORY_SCOPE_AGENT); }
__device__ __forceinline__ unsigned xb_add(unsigned* p, unsigned v) { return __hip_atomic_fetch_add(p, v, __ATOMIC_RELAXED, __HIP_MEMORY_SCOPE_AGENT); }
__device__ __forceinline__ unsigned xb_xcc_id() { return (unsigned)__builtin_amdgcn_s_getreg((3 << 11) | 20) & 0xFu; }
#define XB_SPIN(cond, bar) do { unsigned _sp = 0; while (cond) { __builtin_amdgcn_s_sleep(1); \
    if ((++_sp & 255u) == 0u) { if (xb_ld(&(bar)[XB_TMO])) break; if (_sp > XB_SPIN_CAP) { atomicAdd(&(bar)[XB_TMO], 1u); break; } } } } while (0)
struct XcdBarrier { unsigned* bar; unsigned x; volatile LAS unsigned* st; };
__device__ __forceinline__ XcdBarrier xcd_barrier_post(unsigned* bar, volatile LAS unsigned* st) {
    XcdBarrier b; b.bar = bar; b.x = xb_xcc_id(); b.st = st;
    if (threadIdx.x == 0) (void)xb_add(&bar[XB_XCNT(b.x)], 1u);
    return b;
}
__device__ __forceinline__ void xcd_barrier_complete(unsigned* bar, unsigned x, unsigned& nloc, unsigned& nx) {
    const unsigned G = gridDim.x * gridDim.y * gridDim.z;
    unsigned sum, cnt, mine, sp = 0u;
    for (;;) {
        sum = 0u; cnt = 0u; mine = 0u;
#pragma unroll
        for (unsigned j = 0; j < 16; ++j) { const unsigned c = xb_ld(&bar[XB_XCNT(j)]); sum += c; cnt += (c > 0u) ? 1u : 0u; mine = (j == x) ? c : mine; }
        if (sum == G) break;
        __builtin_amdgcn_s_sleep(1);
        if ((++sp & 255u) == 0u) { if (xb_ld(&bar[XB_TMO])) break; if (sp > XB_SPIN_CAP) { atomicAdd(&bar[XB_TMO], 1u); break; } }
    }
    nloc = mine > 0u ? mine : 1u; nx = cnt > 0u ? cnt : 1u;
}
__device__ __forceinline__ void xcd_barrier(const XcdBarrier& b) {
    asm volatile("s_waitcnt vmcnt(0)" ::: "memory");
    __syncthreads();
    if (threadIdx.x == 0) {
        unsigned* bar = b.bar;
        __builtin_amdgcn_s_waitcnt(0);
        unsigned nloc = b.st[0], nx = b.st[1];
        if (nloc == 0u) { xcd_barrier_complete(bar, b.x, nloc, nx); b.st[0] = nloc; b.st[1] = nx; }
        const unsigned old = xb_add(&bar[XB_XSUB(b.x)], 1u);
        const unsigned gen = old / nloc;
        if (old + 1u == (gen + 1u) * nloc) {
            __builtin_amdgcn_fence(__ATOMIC_RELEASE, "agent");
            asm volatile("s_waitcnt vmcnt(0)" ::: "memory");
            const unsigned og = xb_add(&bar[XB_TOP], 1u);
            const unsigned tg = og / nx;
            if (og + 1u == (tg + 1u) * nx) xb_add(&bar[XB_TOPGEN], 1u);
            else XB_SPIN(xb_ld(&bar[XB_TOPGEN]) == tg, bar);
            __builtin_amdgcn_fence(__ATOMIC_ACQUIRE, "agent");
            xb_add(&bar[XB_XGEN(b.x)], 1u);
            asm volatile("s_waitcnt vmcnt(0)" ::: "memory");
        } else {
            XB_SPIN(xb_ld(&bar[XB_XGEN(b.x)]) == gen, bar);
            __builtin_amdgcn_fence(__ATOMIC_ACQUIRE, "agent");
            asm volatile("s_waitcnt vmcnt(0)" ::: "memory");
        }
    }
    __syncthreads();
}

struct Frame {
    LAS unsigned char* lds;
    volatile LAS unsigned* MISC;
    gu32* ctl;
    int tid, lane, wave;
    int vcu, G;
    const float* in[28];
    float* out; unsigned char* ws;
};
enum { I_X = 0, I_MEM, I_PRE1, I_POST1, I_PRE2, I_POST2, I_MEMG, I_WIN, I_FBIAS, I_MU, I_W0, I_WUP, I_A0, I_AUP, I_GUP, I_KK, I_KA, I_RK, I_GNG, I_GNB,
       I_WMEMKV, I_WFOX, I_WRWKV, I_WMEMO, I_WO, I_WG, I_WU, I_WD };

__device__ __forceinline__ void p0_transpose_item(const float* src, int ldsrc, int K, bf16_t* WT, int drow0, int k0, LAS float* scr, int lane) {
#pragma unroll 8
    for (int i = 0; i < 32; ++i) { const int kk = 2 * i + (lane >> 5); scr[kk * 33 + (lane & 31)] = src[(size_t)(k0 + kk) * ldsrc + (lane & 31)]; }
    LDS_WAIT(); asm volatile("" ::: "memory");
    const int c = lane & 7;
#pragma unroll
    for (int j = 0; j < 4; ++j) { const int n = (lane >> 3) + 8 * j; const LAS float* s = scr + (8 * c) * 33 + n;
        u32x4 o; o.x = pk2(s[0 * 33], s[1 * 33]); o.y = pk2(s[2 * 33], s[3 * 33]); o.z = pk2(s[4 * 33], s[5 * 33]); o.w = pk2(s[6 * 33], s[7 * 33]);
        *(GAS u32x4*)(WT + (size_t)(drow0 + n) * K + k0 + 8 * c) = o; }
    LDS_WAIT(); asm volatile("" ::: "memory");
}
struct TJob { int src_in; int ldsrc; int K; int scol; int ncols; size_t dst_off; int drow; int mode; };
static constexpr TJob kJobs[21] = {
    {I_WIN, INCOLS, 1024, 0,    512, WS_WALL, 0,    0},
    {I_WIN, INCOLS, 1024, 512,  512, WS_WALL, 512,  0},
    {I_WIN, INCOLS, 1024, 1024, 512, WS_WALL, 1024, 0},
    {I_WIN, INCOLS, 1024, 1544, 512, WS_WALL, 1536, 0},
    {I_WIN, INCOLS, 1024, 2056, 512, WS_WALL, 2048, 0},
    {I_WIN, INCOLS, 1024, 2568, 512, WS_WALL, 2560, 0},
    {I_WIN, INCOLS, 1024, 3336, 512, WS_WALL, 3072, 0},
    {I_WIN, INCOLS, 1024, 3080, 64,  WS_WALL, 3584, 0},
    {I_WIN, INCOLS, 1024, 3144, 64,  WS_WALL, 3648, 0},
    {I_WIN, INCOLS, 1024, 3208, 128, WS_WALL, 3712, 0},
    {I_WIN, INCOLS, 1024, 3848, 1024, WS_WALL, 3840, 0},
    {I_WIN, INCOLS, 1024, 4872, 1024, WS_WALL, 4864, 0},
    {I_WIN, INCOLS, 1024, 5896, 1024, WS_WALL, 5888, 0},
    {I_WMEMKV, 1024, 1024, 0, 1024, WS_WALL, 6912, 0},
    {I_WFOX,  1024, 512, 0, 1024, WS_WBR, 0,    0},
    {I_WRWKV, 1024, 512, 0, 1024, WS_WBR, 1024, 0},
    {I_WMEMO, 1024, 512, 0, 1024, WS_WBR, 2048, 0},
    {I_WO, 1024, 1024, 0, 1024, WS_WO, 0, 0},
    {I_WG, DFF, 1024, 0, DFF, WS_WGU, 0,   1},
    {I_WU, DFF, 1024, 0, DFF, WS_WGU, 128, 1},
    {I_WD, 1024, DFF, 0, 1024, WS_WDN, 0, 0}};
__device__ __forceinline__ void p0_prologue(Frame& F) {
    LAS float* scr = (LAS float*)(F.lds + RING_OFF + F.wave * 16384);
    const int gw = F.vcu * NWAVES + F.wave, NGW = F.G * NWAVES;
    int base = 0;
#pragma unroll
    for (int j = 0; j < 21; ++j) {
        const TJob jb = kJobs[j]; const int nblk = jb.ncols / 32, nitem = (jb.K / 64) * nblk;
        int it = gw - (base % NGW); if (it < 0) it += NGW;
        const float* srcp = F.in[jb.src_in] + jb.scol; bf16_t* dstp = (bf16_t*)(F.ws + jb.dst_off);
#pragma unroll 1
        for (; it < nitem; it += NGW) {
            const int kb = it / nblk, nb = it % nblk, n0 = nb * 32;
            const int drow0 = (jb.mode == 0) ? (jb.drow + n0) : (256 * (n0 / 128) + jb.drow + (n0 % 128));
            p0_transpose_item(srcp + n0, jb.ldsrc, jb.K, dstp, drow0, 64 * kb, scr, F.lane);
        }
        base += nitem;
    }
    {
        const float* win = F.in[I_WIN]; const float* g1 = F.in[I_PRE1]; const float* fb = F.in[I_FBIAS];
        bf16_t* XN = (bf16_t*)(F.ws + WS_XNALL); float* LS = (float*)(F.ws + WS_LS);
        f32x4 gv[4];
#pragma unroll
        for (int j = 0; j < 4; ++j) gv[j] = *(const f32x4*)(g1 + 4 * F.lane + 256 * j);
        for (int m = gw; m < M; m += NGW) {
            const GAS f32x4* xr = (const GAS f32x4*)(F.in[I_X] + (size_t)m * DM) + F.lane;
            f32x4 v[4]; float s = 0.f;
#pragma unroll
            for (int j = 0; j < 4; ++j) { v[j] = xr[64 * j]; s += (v[j].x * v[j].x + v[j].y * v[j].y) + (v[j].z * v[j].z + v[j].w * v[j].w); }
            const float rn = 1.0f / sqrtf(wave_sum(s) * (1.f / DM) + NORM_EPS);
            float fa[8];
#pragma unroll
            for (int h = 0; h < 8; ++h) fa[h] = 0.f;
#pragma unroll
            for (int j = 0; j < 4; ++j) { v[j] = v[j] * rn * gv[j];
#pragma unroll
                for (int e = 0; e < 4; ++e) { const float* wp = win + (size_t)(4 * F.lane + 256 * j + e) * INCOLS + 1536; const f32x4 w0 = *(const f32x4*)wp, w1 = *(const f32x4*)(wp + 4);
                    const float u = v[j][e]; fa[0] += u * w0.x; fa[1] += u * w0.y; fa[2] += u * w0.z; fa[3] += u * w0.w; fa[4] += u * w1.x; fa[5] += u * w1.y; fa[6] += u * w1.z; fa[7] += u * w1.w; } }
            GAS unsigned long long* o8 = (GAS unsigned long long*)(XN + (size_t)m * DM) + F.lane;
#pragma unroll
            for (int j = 0; j < 4; ++j) o8[64 * j] = (unsigned long long)pk2(v[j].x, v[j].y) | ((unsigned long long)pk2(v[j].z, v[j].w) << 32);
#pragma unroll
            for (int h = 0; h < 8; ++h) fa[h] = wave_sum(fa[h]);
            if (F.lane < 8) { float f = fa[0];
#pragma unroll
                for (int h = 1; h < 8; ++h) f = (F.lane == h) ? fa[h] : f;
                f += fb[F.lane];
                const float ls = fminf(f, 0.f) - log1pf(__expf(-fabsf(f)));
                LS[(size_t)m * 8 + F.lane] = ls; }
        }
    }
    {
        const float* g1 = F.in[I_MEMG]; bf16_t* XN = (bf16_t*)(F.ws + WS_XNALL) + (size_t)M * DM;
        f32x4 gv[4];
#pragma unroll
        for (int j = 0; j < 4; ++j) gv[j] = *(const f32x4*)(g1 + 4 * F.lane + 256 * j);
        for (int m = gw; m < MMEM; m += NGW) {
            const GAS f32x4* xr = (const GAS f32x4*)(F.in[I_MEM] + (size_t)m * DM) + F.lane;
            f32x4 v[4]; float s = 0.f;
#pragma unroll
            for (int j = 0; j < 4; ++j) { v[j] = xr[64 * j]; s += (v[j].x * v[j].x + v[j].y * v[j].y) + (v[j].z * v[j].z + v[j].w * v[j].w); }
            const float rn = 1.0f / sqrtf(wave_sum(s) * (1.f / DM) + NORM_EPS);
            GAS unsigned long long* o8 = (GAS unsigned long long*)(XN + (size_t)m * DM) + F.lane;
#pragma unroll
            for (int j = 0; j < 4; ++j) { v[j] = v[j] * rn * gv[j]; o8[64 * j] = (unsigned long long)pk2(v[j].x, v[j].y) | ((unsigned long long)pk2(v[j].z, v[j].w) << 32); }
        }
    }
}

__device__ __forceinline__ void load_row_bf16(const bf16_t* p, int lane, f32x4 (&v)[4]) {
#pragma unroll
    for (int j = 0; j < 4; ++j) { const u32x2 w = *(const u32x2*)(p + 4 * lane + 256 * j); v[j] = (f32x4){bflo(w.x), bfhi(w.x), bflo(w.y), bfhi(w.y)}; }
}
__device__ __forceinline__ void p3c_rows(Frame& F) {
    const int gw = F.vcu * NWAVES + F.wave, NGW = F.G * NWAVES;
    const bf16_t* Y = (const bf16_t*)(F.ws + WS_Y); bf16_t* U2 = (bf16_t*)(F.ws + WS_U2);
    f32x4 g1[4], g2[4];
#pragma unroll
    for (int j = 0; j < 4; ++j) { g1[j] = *(const f32x4*)(F.in[I_POST1] + 4 * F.lane + 256 * j); g2[j] = *(const f32x4*)(F.in[I_PRE2] + 4 * F.lane + 256 * j); }
    for (int m = gw; m < M; m += NGW) {
        f32x4 y[4]; load_row_bf16(Y + (size_t)m * DM, F.lane, y);
        float s = 0.f;
#pragma unroll
        for (int j = 0; j < 4; ++j) s += (y[j].x * y[j].x + y[j].y * y[j].y) + (y[j].z * y[j].z + y[j].w * y[j].w);
        const float rn = 1.0f / sqrtf(wave_sum(s) * (1.f / DM) + NORM_EPS);
        const GAS f32x4* xr = (const GAS f32x4*)(F.in[I_X] + (size_t)m * DM) + F.lane;
        GAS f32x4* hr = (GAS f32x4*)(F.out + (size_t)m * DM) + F.lane;
        float s2 = 0.f;
#pragma unroll
        for (int j = 0; j < 4; ++j) { y[j] = xr[64 * j] + y[j] * rn * g1[j]; hr[64 * j] = y[j]; s2 += (y[j].x * y[j].x + y[j].y * y[j].y) + (y[j].z * y[j].z + y[j].w * y[j].w); }
        const float rn2 = 1.0f / sqrtf(wave_sum(s2) * (1.f / DM) + NORM_EPS);
        GAS unsigned long long* o8 = (GAS unsigned long long*)(U2 + (size_t)m * DM) + F.lane;
#pragma unroll
        for (int j = 0; j < 4; ++j) { const f32x4 u = y[j] * rn2 * g2[j]; o8[64 * j] = (unsigned long long)pk2(u.x, u.y) | ((unsigned long long)pk2(u.z, u.w) << 32); }
    }
}
__device__ __forceinline__ void p5c_rows(Frame& F) {
    const int gw = F.vcu * NWAVES + F.wave, NGW = F.G * NWAVES;
    const bf16_t* FO = (const bf16_t*)(F.ws + WS_FO);
    f32x4 g1[4];
#pragma unroll
    for (int j = 0; j < 4; ++j) g1[j] = *(const f32x4*)(F.in[I_POST2] + 4 * F.lane + 256 * j);
    for (int m = gw; m < M; m += NGW) {
        f32x4 y[4]; load_row_bf16(FO + (size_t)m * DM, F.lane, y);
        float s = 0.f;
#pragma unroll
        for (int j = 0; j < 4; ++j) s += (y[j].x * y[j].x + y[j].y * y[j].y) + (y[j].z * y[j].z + y[j].w * y[j].w);
        const float rn = 1.0f / sqrtf(wave_sum(s) * (1.f / DM) + NORM_EPS);
        GAS f32x4* hr = (GAS f32x4*)(F.out + (size_t)m * DM) + F.lane;
#pragma unroll
        for (int j = 0; j < 4; ++j) hr[64 * j] = hr[64 * j] + y[j] * rn * g1[j];
    }
}

__device__ __forceinline__ void fox_simple_unit(Frame& F, int b, int h, int qb) {
    const int tid = F.tid, lane = F.lane, wave = F.wave;
    LAS float* cs = (LAS float*)(F.lds);
    LAS bf16_t* Kt = (LAS bf16_t*)(F.lds + 8192);
    LAS bf16_t* Vt = (LAS bf16_t*)(F.lds + 16384);
    LAS float* wt = (LAS float*)(F.lds + 24576);
    const bf16_t* PJ = (const bf16_t*)(F.ws + WS_PROJA);
    __syncthreads();
    {
        const float* ls = (const float*)(F.ws + WS_LS) + (size_t)b * SEQ * 8 + h;
        const float e0 = ls[(4 * tid + 0) * 8], e1 = ls[(4 * tid + 1) * 8], e2 = ls[(4 * tid + 2) * 8], e3 = ls[(4 * tid + 3) * 8];
        const float s = (e0 + e1) + (e2 + e3); float inc = s;
#pragma unroll
        for (int o = 1; o < 64; o <<= 1) { const float n = __shfl_up(inc, o); if (lane >= o) inc += n; }
        if (lane == 63) wt[wave] = inc;
        __syncthreads();
        float base = 0.f;
        for (int w = 0; w < wave; ++w) base += wt[w];
        float c = base + inc - s;
        c += e0; cs[4 * tid + 0] = c * LOG2E; c += e1; cs[4 * tid + 1] = c * LOG2E; c += e2; cs[4 * tid + 2] = c * LOG2E; c += e3; cs[4 * tid + 3] = c * LOG2E;
    }
    const int q = qb * 512 + tid; const size_t row = (size_t)b * SEQ + q;
    float qf[64], o[64];
#pragma unroll
    for (int c = 0; c < 8; ++c) { const u32x4 w = *(const u32x4*)(PJ + row * PA + C_FQ + h * 64 + c * 8);
        qf[8 * c + 0] = bflo(w.x); qf[8 * c + 1] = bfhi(w.x); qf[8 * c + 2] = bflo(w.y); qf[8 * c + 3] = bfhi(w.y); qf[8 * c + 4] = bflo(w.z); qf[8 * c + 5] = bfhi(w.z); qf[8 * c + 6] = bflo(w.w); qf[8 * c + 7] = bfhi(w.w); }
#pragma unroll
    for (int d = 0; d < 64; ++d) o[d] = 0.f;
    float mrun = -1e30f, l = 0.f;
    const int ntile = (qb + 1) * 8; const int qwmax = qb * 512 + wave * 64 + 63;
    for (int kt = 0; kt < ntile; ++kt) {
        __syncthreads();
        { const size_t krow = (size_t)b * SEQ + kt * 64 + (tid >> 3);
          const u32x4 kv = *(const u32x4*)(PJ + krow * PA + C_FK + h * 64 + (tid & 7) * 8);
          const u32x4 vv = *(const u32x4*)(PJ + krow * PA + C_FV + h * 64 + (tid & 7) * 8);
          *(LAS u32x4*)(Kt + (tid >> 3) * 64 + (tid & 7) * 8) = kv; *(LAS u32x4*)(Vt + (tid >> 3) * 64 + (tid & 7) * 8) = vv; }
        __syncthreads();
        const int kbase = kt * 64;
        if (kbase <= qwmax) {
#pragma unroll 1
            for (int kk = 0; kk < 64; ++kk) {
                const int kidx = kbase + kk;
                float s0 = 0.f, s1 = 0.f;
#pragma unroll
                for (int c = 0; c < 8; ++c) { const u32x4 w = *(const LAS u32x4*)(Kt + kk * 64 + c * 8);
                    s0 += qf[8 * c + 0] * bflo(w.x) + qf[8 * c + 2] * bflo(w.y) + qf[8 * c + 4] * bflo(w.z) + qf[8 * c + 6] * bflo(w.w);
                    s1 += qf[8 * c + 1] * bfhi(w.x) + qf[8 * c + 3] * bfhi(w.y) + qf[8 * c + 5] * bfhi(w.z) + qf[8 * c + 7] * bfhi(w.w); }
                const bool ok = kidx <= q;
                const float s = ok ? (s0 + s1 - cs[kidx]) : -1e30f;
                const float mn = fmaxf(mrun, s); const float al = __builtin_amdgcn_exp2f(mrun - mn); const float p = ok ? __builtin_amdgcn_exp2f(s - mn) : 0.f;
                l = l * al + p; mrun = mn;
#pragma unroll
                for (int c = 0; c < 8; ++c) { const u32x4 w = *(const LAS u32x4*)(Vt + kk * 64 + c * 8);
                    o[8 * c + 0] = o[8 * c + 0] * al + p * bflo(w.x); o[8 * c + 1] = o[8 * c + 1] * al + p * bfhi(w.x); o[8 * c + 2] = o[8 * c + 2] * al + p * bflo(w.y); o[8 * c + 3] = o[8 * c + 3] * al + p * bfhi(w.y);
                    o[8 * c + 4] = o[8 * c + 4] * al + p * bflo(w.z); o[8 * c + 5] = o[8 * c + 5] * al + p * bfhi(w.z); o[8 * c + 6] = o[8 * c + 6] * al + p * bflo(w.w); o[8 * c + 7] = o[8 * c + 7] * al + p * bfhi(w.w); }
            }
        }
    }
    const float rl = 1.0f / l;
    bf16_t* op = (bf16_t*)(F.ws + WS_PROJA) + row * PA + C_FQ + h * 64;
#pragma unroll
    for (int c = 0; c < 8; ++c) { u32x4 w; w.x = pk2(o[8 * c + 0] * rl, o[8 * c + 1] * rl); w.y = pk2(o[8 * c + 2] * rl, o[8 * c + 3] * rl); w.z = pk2(o[8 * c + 4] * rl, o[8 * c + 5] * rl); w.w = pk2(o[8 * c + 6] * rl, o[8 * c + 7] * rl);
        *(u32x4*)(op + c * 8) = w; }
}

__device__ __forceinline__ void mem_simple_unit(Frame& F, int b, int hd, int qb) {
    const int tid = F.tid;
    LAS bf16_t* Kt = (LAS bf16_t*)(F.lds);
    LAS bf16_t* Vt = (LAS bf16_t*)(F.lds + 16384);
    const bf16_t* PJ = (const bf16_t*)(F.ws + WS_PROJA); const bf16_t* KV = (const bf16_t*)(F.ws + WS_MEMKV);
    const int q = qb * 256 + (tid >> 1), half = tid & 1; const size_t row = (size_t)b * SEQ + q;
    float qf[64], o[64];
#pragma unroll
    for (int c = 0; c < 8; ++c) { const u32x4 w = *(const u32x4*)(PJ + row * PA + C_MQ + hd * 128 + half * 64 + c * 8);
        qf[8 * c + 0] = bflo(w.x); qf[8 * c + 1] = bfhi(w.x); qf[8 * c + 2] = bflo(w.y); qf[8 * c + 3] = bfhi(w.y); qf[8 * c + 4] = bflo(w.z); qf[8 * c + 5] = bfhi(w.z); qf[8 * c + 6] = bflo(w.w); qf[8 * c + 7] = bfhi(w.w); }
#pragma unroll
    for (int d = 0; d < 64; ++d) o[d] = 0.f;
    float mrun = -1e30f, l = 0.f;
    for (int kt = 0; kt < 4; ++kt) {
        __syncthreads();
#pragma unroll
        for (int i = 0; i < 2; ++i) { const int idx = tid + 512 * i, r = idx >> 4, ch = idx & 15;
            const size_t krow = (size_t)b * MEMLEN + kt * 64 + r;
            *(LAS u32x4*)(Kt + r * 128 + ch * 8) = *(const u32x4*)(KV + krow * 1024 + hd * 128 + ch * 8);
            *(LAS u32x4*)(Vt + r * 128 + ch * 8) = *(const u32x4*)(KV + krow * 1024 + 512 + hd * 128 + ch * 8); }
        __syncthreads();
#pragma unroll 1
        for (int kk = 0; kk < 64; ++kk) {
            float s0 = 0.f, s1 = 0.f;
#pragma unroll
            for (int c = 0; c < 8; ++c) { const u32x4 w = *(const LAS u32x4*)(Kt + kk * 128 + half * 64 + c * 8);
                s0 += qf[8 * c + 0] * bflo(w.x) + qf[8 * c + 2] * bflo(w.y) + qf[8 * c + 4] * bflo(w.z) + qf[8 * c + 6] * bflo(w.w);
                s1 += qf[8 * c + 1] * bfhi(w.x) + qf[8 * c + 3] * bfhi(w.y) + qf[8 * c + 5] * bfhi(w.z) + qf[8 * c + 7] * bfhi(w.w); }
            float s = s0 + s1; s += __shfl_xor(s, 1);
            const float mn = fmaxf(mrun, s); const float al = __builtin_amdgcn_exp2f(mrun - mn); const float p = __builtin_amdgcn_exp2f(s - mn);
            l = l * al + p; mrun = mn;
#pragma unroll
            for (int c = 0; c < 8; ++c) { const u32x4 w = *(const LAS u32x4*)(Vt + kk * 128 + half * 64 + c * 8);
                o[8 * c + 0] = o[8 * c + 0] * al + p * bflo(w.x); o[8 * c + 1] = o[8 * c + 1] * al + p * bfhi(w.x); o[8 * c + 2] = o[8 * c + 2] * al + p * bflo(w.y); o[8 * c + 3] = o[8 * c + 3] * al + p * bfhi(w.y);
                o[8 * c + 4] = o[8 * c + 4] * al + p * bflo(w.z); o[8 * c + 5] = o[8 * c + 5] * al + p * bfhi(w.z); o[8 * c + 6] = o[8 * c + 6] * al + p * bflo(w.w); o[8 * c + 7] = o[8 * c + 7] * al + p * bfhi(w.w); }
        }
    }
    const float rl = 1.0f / l;
    bf16_t* op = (bf16_t*)(F.ws + WS_PROJA) + row * PA + C_MQ + hd * 128 + half * 64;
#pragma unroll
    for (int c = 0; c < 8; ++c) { u32x4 w; w.x = pk2(o[8 * c + 0] * rl, o[8 * c + 1] * rl); w.y = pk2(o[8 * c + 2] * rl, o[8 * c + 3] * rl); w.z = pk2(o[8 * c + 4] * rl, o[8 * c + 5] * rl); w.w = pk2(o[8 * c + 6] * rl, o[8 * c + 7] * rl);
        *(u32x4*)(op + c * 8) = w; }
    __syncthreads();
}

__device__ __forceinline__ void unpack8(const u32x4 w, float (&f)[8]) { f[0] = bflo(w.x); f[1] = bfhi(w.x); f[2] = bflo(w.y); f[3] = bfhi(w.y); f[4] = bflo(w.z); f[5] = bfhi(w.z); f[6] = bflo(w.w); f[7] = bfhi(w.w); }
__device__ __forceinline__ void rwkv_simple_unit(Frame& F, int b, int h) {
    const int tid = F.tid;
    LAS float* Rr = (LAS float*)(F.lds + 0 * 16384); LAS float* Ww = (LAS float*)(F.lds + 1 * 16384); LAS float* Kk = (LAS float*)(F.lds + 2 * 16384); LAS float* Vv = (LAS float*)(F.lds + 3 * 16384);
    LAS float* Aa = (LAS float*)(F.lds + 4 * 16384); LAS float* Bb = (LAS float*)(F.lds + 5 * 16384); LAS float* Gg = (LAS float*)(F.lds + 6 * 16384); LAS float* Yy = (LAS float*)(F.lds + 7 * 16384);
    LAS float* T1 = Ww; LAS float* T2 = Aa; LAS float* T3 = Bb;
    LAS float* prevr = (LAS float*)(F.lds + EXTRA_OFF);
    bf16_t* PJ = (bf16_t*)(F.ws + WS_PROJA);
    const float* mu = F.in[I_MU]; const float* w0 = F.in[I_W0]; const float* wup = F.in[I_WUP]; const float* a0 = F.in[I_A0]; const float* aup = F.in[I_AUP]; const float* gup = F.in[I_GUP];
    const float* kkp = F.in[I_KK]; const float* kap = F.in[I_KA]; const float* rkp = F.in[I_RK]; const float* gng = F.in[I_GNG]; const float* gnb = F.in[I_GNB];
    const int t = tid >> 3, cg = tid & 7, c0 = 8 * cg, hc = h * 64 + c0;
    float St[8];
#pragma unroll
    for (int e = 0; e < 8; ++e) St[e] = 0.f;
    __syncthreads();
#pragma unroll 1
    for (int bt = 0; bt < SEQ / 64; ++bt) {
        const int tt0 = bt * 64; const size_t row = (size_t)b * SEQ + tt0 + t; const bool has_prev = (tt0 + t) > 0;
        float rs[8], ks[8], vs[8];
        {
            float cur[8], prv[8];
            const bf16_t* rp = PJ + row * PA; const bf16_t* pp = rp - PA;
            unpack8(*(const u32x4*)(rp + C_RR + hc), cur);
            if (t == 63) {
#pragma unroll
                for (int e = 0; e < 8; ++e) prevr[((bt + 1) & 1) * 64 + c0 + e] = cur[e]; }
            if (t > 0) unpack8(*(const u32x4*)(pp + C_RR + hc), prv);
            else {
#pragma unroll
                for (int e = 0; e < 8; ++e) prv[e] = (bt > 0) ? prevr[(bt & 1) * 64 + c0 + e] : 0.f; }
#pragma unroll
            for (int e = 0; e < 8; ++e) rs[e] = cur[e] + (prv[e] - cur[e]) * mu[hc + e];
            unpack8(*(const u32x4*)(rp + C_RK + hc), cur);
            if (has_prev) unpack8(*(const u32x4*)(pp + C_RK + hc), prv); else {
#pragma unroll
                for (int e = 0; e < 8; ++e) prv[e] = 0.f; }
#pragma unroll
            for (int e = 0; e < 8; ++e) ks[e] = cur[e] + (prv[e] - cur[e]) * mu[512 + hc + e];
            unpack8(*(const u32x4*)(rp + C_RV + hc), cur);
            if (has_prev) unpack8(*(const u32x4*)(pp + C_RV + hc), prv); else {
#pragma unroll
                for (int e = 0; e < 8; ++e) prv[e] = 0.f; }
#pragma unroll
            for (int e = 0; e < 8; ++e) vs[e] = cur[e] + (prv[e] - cur[e]) * mu[1024 + hc + e];
            unpack8(*(const u32x4*)(rp + C_WD + c0), cur);
            if (has_prev) unpack8(*(const u32x4*)(pp + C_WD + c0), prv); else {
#pragma unroll
                for (int e = 0; e < 8; ++e) prv[e] = 0.f; }
#pragma unroll
            for (int e = 0; e < 8; ++e) { const float x = cur[e] + (prv[e] - cur[e]) * mu[1536 + c0 + e]; T1[t * 64 + c0 + e] = 1.0f - 2.0f / (1.0f + __expf(2.0f * x)); }
            unpack8(*(const u32x4*)(rp + C_AD + c0), cur);
            if (has_prev) unpack8(*(const u32x4*)(pp + C_AD + c0), prv); else {
#pragma unroll
                for (int e = 0; e < 8; ++e) prv[e] = 0.f; }
#pragma unroll
            for (int e = 0; e < 8; ++e) T2[t * 64 + c0 + e] = cur[e] + (prv[e] - cur[e]) * mu[1600 + c0 + e];
#pragma unroll
            for (int hh = 0; hh < 2; ++hh) {
                unpack8(*(const u32x4*)(rp + C_GD + 16 * cg + 8 * hh), cur);
                if (has_prev) unpack8(*(const u32x4*)(pp + C_GD + 16 * cg + 8 * hh), prv); else {
#pragma unroll
                    for (int e = 0; e < 8; ++e) prv[e] = 0.f; }
#pragma unroll
                for (int e = 0; e < 8; ++e) { const float x = cur[e] + (prv[e] - cur[e]) * mu[1664 + 16 * cg + 8 * hh + e]; T3[t * 128 + 16 * cg + 8 * hh + e] = sigm(x); }
            }
#pragma unroll
            for (int e = 0; e < 8; ++e) { Rr[t * 64 + c0 + e] = rs[e]; Vv[t * 64 + c0 + e] = vs[e]; }
        }
        __syncthreads();
        float zw[8], za[8], gg[8];
        {
#pragma unroll
            for (int e = 0; e < 8; ++e) { zw[e] = w0[hc + e]; za[e] = a0[hc + e]; gg[e] = 0.f; }
#pragma unroll 4
            for (int i = 0; i < 64; ++i) { const float x1 = T1[t * 64 + i], x2 = T2[t * 64 + i];
                const f32x4 wa = *(const f32x4*)(wup + (size_t)i * 512 + hc), wb = *(const f32x4*)(wup + (size_t)i * 512 + hc + 4);
                const f32x4 aa = *(const f32x4*)(aup + (size_t)i * 512 + hc), ab = *(const f32x4*)(aup + (size_t)i * 512 + hc + 4);
#pragma unroll
                for (int e = 0; e < 4; ++e) { zw[e] += x1 * wa[e]; zw[4 + e] += x1 * wb[e]; za[e] += x2 * aa[e]; za[4 + e] += x2 * ab[e]; } }
#pragma unroll 4
            for (int i = 0; i < 128; ++i) { const float x3 = T3[t * 128 + i];
                const f32x4 ga = *(const f32x4*)(gup + (size_t)i * 512 + hc), gb = *(const f32x4*)(gup + (size_t)i * 512 + hc + 4);
#pragma unroll
                for (int e = 0; e < 4; ++e) { gg[e] += x3 * ga[e]; gg[4 + e] += x3 * gb[e]; } }
        }
        __syncthreads();
        {
            float kk[8], ss = 0.f;
#pragma unroll
            for (int e = 0; e < 8; ++e) { kk[e] = ks[e] * kkp[hc + e]; ss += kk[e] * kk[e]; }
            ss += __shfl_xor(ss, 1); ss += __shfl_xor(ss, 2); ss += __shfl_xor(ss, 4);
            const float rn = 1.0f / sqrtf(fmaxf(ss, 1e-24f));
#pragma unroll
            for (int e = 0; e < 8; ++e) { const float a = sigm(za[e]); const float w = __expf(-0.6065306597126334f * sigm(zw[e])); const float kn = kk[e] * rn;
                Ww[t * 64 + c0 + e] = w; Kk[t * 64 + c0 + e] = ks[e] * (1.0f + (a - 1.0f) * kap[hc + e]); Aa[t * 64 + c0 + e] = -kn; Bb[t * 64 + c0 + e] = kn * a; Gg[t * 64 + c0 + e] = gg[e]; }
        }
        __syncthreads();
        {
#pragma unroll 1
            for (int tt = 0; tt < 64; ++tt) {
                const f32x4 a0v = *(const LAS f32x4*)(Aa + tt * 64 + c0), a1v = *(const LAS f32x4*)(Aa + tt * 64 + c0 + 4);
                float sa = St[0] * a0v[0] + St[1] * a0v[1] + St[2] * a0v[2] + St[3] * a0v[3] + St[4] * a1v[0] + St[5] * a1v[1] + St[6] * a1v[2] + St[7] * a1v[3];
                sa += __shfl_xor(sa, 1); sa += __shfl_xor(sa, 2); sa += __shfl_xor(sa, 4);
                const f32x4 w0v = *(const LAS f32x4*)(Ww + tt * 64 + c0), w1v = *(const LAS f32x4*)(Ww + tt * 64 + c0 + 4);
                const f32x4 b0v = *(const LAS f32x4*)(Bb + tt * 64 + c0), b1v = *(const LAS f32x4*)(Bb + tt * 64 + c0 + 4);
                const f32x4 k0v = *(const LAS f32x4*)(Kk + tt * 64 + c0), k1v = *(const LAS f32x4*)(Kk + tt * 64 + c0 + 4);
                const f32x4 r0v = *(const LAS f32x4*)(Rr + tt * 64 + c0), r1v = *(const LAS f32x4*)(Rr + tt * 64 + c0 + 4);
                const float vi = Vv[tt * 64 + t];
                float y = 0.f;
#pragma unroll
                for (int e = 0; e < 4; ++e) { St[e] = St[e] * w0v[e] + sa * b0v[e] + vi * k0v[e]; St[4 + e] = St[4 + e] * w1v[e] + sa * b1v[e] + vi * k1v[e]; y += St[e] * r0v[e] + St[4 + e] * r1v[e]; }
                y += __shfl_xor(y, 1); y += __shfl_xor(y, 2); y += __shfl_xor(y, 4);
                if (cg == 0) Yy[tt * 64 + t] = y;
            }
        }
        __syncthreads();
        {
            float y[8], s = 0.f, sb = 0.f;
#pragma unroll
            for (int e = 0; e < 8; ++e) { y[e] = Yy[t * 64 + c0 + e]; s += y[e]; sb += Rr[t * 64 + c0 + e] * Kk[t * 64 + c0 + e] * rkp[hc + e]; }
            s += __shfl_xor(s, 1); s += __shfl_xor(s, 2); s += __shfl_xor(s, 4);
            sb += __shfl_xor(sb, 1); sb += __shfl_xor(sb, 2); sb += __shfl_xor(sb, 4);
            const float mean = s * (1.0f / 64.0f); float var = 0.f;
#pragma unroll
            for (int e = 0; e < 8; ++e) { y[e] -= mean; var += y[e] * y[e]; }
            var += __shfl_xor(var, 1); var += __shfl_xor(var, 2); var += __shfl_xor(var, 4);
            const float rstd = 1.0f / sqrtf(var * (1.0f / 64.0f) + GN_EPS);
            float ov[8];
#pragma unroll
            for (int e = 0; e < 8; ++e) ov[e] = (y[e] * rstd * gng[hc + e] + gnb[hc + e] + sb * Vv[t * 64 + c0 + e]) * Gg[t * 64 + c0 + e];
            u32x4 w; w.x = pk2(ov[0], ov[1]); w.y = pk2(ov[2], ov[3]); w.z = pk2(ov[4], ov[5]); w.w = pk2(ov[6], ov[7]);
            *(u32x4*)(PJ + row * PA + C_RR + hc) = w;
        }
        __syncthreads();
    }
}

struct SchedInProj {
    int G, c; const char* A; const char* B;
    __device__ __forceinline__ bool next(int i, pg8::Unit& u) const {
        const int L = i * G + c; const size_t ts = (size_t)256 * 1024 * 2;
        if (L < 3456) { pg8::tile_of(L, 128, 27, u.pm, u.pn); u.tag = 0; }
        else if (L < 3456 + 64) { const int j = L - 3456; u.pm = 128 + (j & 15); u.pn = 27 + (j >> 4); u.tag = 1; }
        else return false;
        u.a = A + (size_t)u.pm * ts; u.b = B + (size_t)u.pn * ts; return true;
    }
};
struct SchedMerge {
    int G, c; const char* A; const char* B;
    __device__ __forceinline__ bool next(int i, pg8::Unit& u) const {
        const int br = i % 3, L = (i / 3) * G + c; if (L >= 512) return false;
        pg8::tile_of(L, 128, 4, u.pm, u.pn); u.tag = br;
        const int coff = (br == 0) ? C_FQ : ((br == 1) ? C_RR : C_MQ);
        u.a = A + ((size_t)u.pm * 256 * PA + coff) * 2; u.b = B + ((size_t)(br * 1024 + u.pn * 256) * 512) * 2; return true;
    }
};
struct SchedPlain {
    int G, c, nM, nN; const char* A; const char* B; size_t tsA, tsB;
    __device__ __forceinline__ bool next(int i, pg8::Unit& u) const {
        const int L = i * G + c; if (L >= nM * nN) return false;
        pg8::tile_of(L, nM, nN, u.pm, u.pn); u.tag = 0; u.a = A + (size_t)u.pm * tsA; u.b = B + (size_t)u.pn * tsB; return true;
    }
};

constexpr int N_PHASES = 9;
struct Args { const float* in[28]; float* out; unsigned char* ws; int ph_lo, ph_hi, li, pad; };
__global__ void __launch_bounds__(NWAVES * 64, 2) hyb_fwd(Args args) {
    extern __shared__ __attribute__((aligned(16))) unsigned char lds[];
    Frame F;
    F.lds = (LAS unsigned char*)lds;
    F.MISC = (volatile LAS unsigned*)(F.lds + MISC_OFF);
    F.tid = threadIdx.x; F.lane = F.tid & 63; F.wave = __builtin_amdgcn_readfirstlane(F.tid >> 6);
    F.G = gridDim.x; { const int bx = blockIdx.x; F.vcu = (F.G % 8 == 0) ? (bx % 8) * (F.G / 8) + bx / 8 : bx; }
    F.ws = args.ws; F.out = args.out; F.ctl = (gu32*)(args.ws + WS_CTL);
#pragma unroll
    for (int i = 0; i < 28; ++i) F.in[i] = args.in[i];
    for (int u = F.tid; u < (LDS_BYTES - LDSCTL_OFF) / 4; u += NWAVES * 64) ((LAS unsigned*)(F.lds + LDSCTL_OFF))[u] = 0u;
    __syncthreads();
    XcdBarrier bar; bar.bar = (unsigned*)(F.ctl + CW_BAR); bar.x = 0; bar.st = nullptr;
    if (MK_N_LAUNCHES == 1) bar = xcd_barrier_post((unsigned*)(F.ctl + CW_BAR), F.MISC + 8);
    const int lo = args.ph_lo, hi = args.ph_hi;
#define IN(k) (lo <= (k) && (k) < hi)
#define SEAM(k) do { if (IN(k) && IN((k) + 1)) xcd_barrier(bar); } while (0)
    unsigned char* ws = args.ws;

    if (IN(0)) { p0_prologue(F); SEAM(0); }

    if (IN(1)) {
        pg8::Gemm g{1024, 1024, 1024};
        SchedInProj S{F.G, (int)blockIdx.x, (const char*)(ws + WS_XNALL), (const char*)(ws + WS_WALL)};
        pg8::EpiInProj E{(bf16_t*)(ws + WS_PROJA), (bf16_t*)(ws + WS_G01), (bf16_t*)args.out, (bf16_t*)(ws + WS_MEMKV)};
        pg8::gemm_phase<pg8::EpiInProj, SchedInProj, true, true>(F.lds + RING_OFF, g, S, E);
        SEAM(1);
    }

    if (IN(2)) {
        for (int u = blockIdx.x; u < 128 + 512 + 512; u += F.G) {
            if (u < 128) rwkv_simple_unit(F, u >> 3, u & 7);
            else if (u < 640) { const int j = u - 128; fox_simple_unit(F, j >> 5, (j >> 2) & 7, 3 - (j & 3)); }
            else { const int j = u - 640; mem_simple_unit(F, j >> 5, (j >> 3) & 3, j & 7); }
        }
        SEAM(2);
    }

    if (IN(3)) {
        pg8::Gemm g{512, PA, 512};
        SchedMerge S{F.G, (int)blockIdx.x, (const char*)(ws + WS_PROJA), (const char*)(ws + WS_WBR)};
        pg8::EpiMerge E{(const bf16_t*)(ws + WS_G01), (const bf16_t*)args.out, (bf16_t*)(ws + WS_MERGED)};
        pg8::gemm_phase<pg8::EpiMerge, SchedMerge, true, true>(F.lds + RING_OFF, g, S, E);
        SEAM(3);
    }

    if (IN(4)) {
        pg8::Gemm g{1024, 1024, 1024};
        SchedPlain S{F.G, (int)blockIdx.x, 128, 4, (const char*)(ws + WS_MERGED), (const char*)(ws + WS_WO), (size_t)256 * 1024 * 2, (size_t)256 * 1024 * 2};
        pg8::EpiPlain E{(bf16_t*)(ws + WS_Y), 1024};
        pg8::gemm_phase<pg8::EpiPlain, SchedPlain, true, true>(F.lds + RING_OFF, g, S, E);
        SEAM(4);
    }

    if (IN(5)) { p3c_rows(F); SEAM(5); }

    if (IN(6)) {
        pg8::Gemm g{1024, 1024, 1024};
        SchedPlain S{F.G, (int)blockIdx.x, 128, 22, (const char*)(ws + WS_U2), (const char*)(ws + WS_WGU), (size_t)256 * 1024 * 2, (size_t)256 * 1024 * 2};
        pg8::EpiSwiGLU E{(bf16_t*)(ws + WS_HID)};
        pg8::gemm_phase<pg8::EpiSwiGLU, SchedPlain, true, true>(F.lds + RING_OFF, g, S, E);
        SEAM(6);
    }

    if (IN(7)) {
        pg8::Gemm g{DFF, DFF, DFF};
        SchedPlain S{F.G, (int)blockIdx.x, 128, 4, (const char*)(ws + WS_HID), (const char*)(ws + WS_WDN), (size_t)256 * DFF * 2, (size_t)256 * DFF * 2};
        pg8::EpiPlain E{(bf16_t*)(ws + WS_FO), 1024};
        pg8::gemm_phase<pg8::EpiPlain, SchedPlain, true, true>(F.lds + RING_OFF, g, S, E);
        SEAM(7);
    }

    if (IN(8)) { p5c_rows(F); }
#undef IN
#undef SEAM
}

extern "C" void kernel_launch(void* const* d_in, const int* in_sizes, int n_in, void* d_out, int out_size, void* d_ws, size_t ws_size, hipStream_t stream) {
    static int grid = 0;
    if (grid == 0) {
        if (n_in != 28 || in_sizes[0] != M * DM || out_size != M * DM || ws_size < WS_END) { fprintf(stderr, "kernel_launch: unexpected shapes (n_in %d, in0 %d, out %d, ws %zu)\n", n_in, n_in > 0 ? in_sizes[0] : -1, out_size, ws_size); grid = -1; return; }
        int dev = 0, cus = 0, per_cu = 0;
        if (hipGetDevice(&dev) != hipSuccess || hipDeviceGetAttribute(&cus, hipDeviceAttributeMultiprocessorCount, dev) != hipSuccess) { grid = -1; return; }
        if (hipFuncSetAttribute((const void*)hyb_fwd, hipFuncAttributeMaxDynamicSharedMemorySize, LDS_BYTES) != hipSuccess) { fprintf(stderr, "kernel_launch: hipFuncSetAttribute failed\n"); grid = -1; return; }
        if (hipOccupancyMaxActiveBlocksPerMultiprocessor(&per_cu, (const void*)hyb_fwd, NWAVES * 64, LDS_BYTES) != hipSuccess || per_cu < 1) { fprintf(stderr, "kernel_launch: occupancy query says %d blocks per CU\n", per_cu); (void)hipGetLastError(); grid = -1; return; }
        grid = cus;
    }
    if (grid < 0) return;
    if (hipMemsetAsync((char*)d_ws + WS_CTL, 0, CTL_ZERO_BYTES, stream) != hipSuccess) return;
    Args a{};
    for (int i = 0; i < 28; ++i) a.in[i] = (const float*)d_in[i];
    a.out = (float*)d_out; a.ws = (unsigned char*)d_ws;
    if (MK_N_LAUNCHES == 1) { a.ph_lo = 0; a.ph_hi = N_PHASES; a.li = 0; hipLaunchKernelGGL(hyb_fwd, dim3(grid), dim3(NWAVES * 64), LDS_BYTES, stream, a); }
    else for (int li = 0; li < N_PHASES; ++li) { a.ph_lo = li; a.ph_hi = li + 1; a.li = li; hipLaunchKernelGGL(hyb_fwd, dim3(grid), dim3(NWAVES * 64), LDS_BYTES, stream, a); }
}
```

```cpp
#include <hip/hip_runtime.h>
#include <cstdio>
#include <cstdint>

#ifndef MK_N_LAUNCHES
#define MK_N_LAUNCHES 1
#endif

#define LAS __attribute__((address_space(3)))
#define GAS __attribute__((address_space(1)))
typedef unsigned short bf16_t;
typedef short bf16x8 __attribute__((ext_vector_type(8)));
typedef float f32x4 __attribute__((ext_vector_type(4)));
typedef float f32x2 __attribute__((ext_vector_type(2)));
typedef unsigned u32x4 __attribute__((ext_vector_type(4)));
typedef unsigned u32x2 __attribute__((ext_vector_type(2)));

constexpr int BATCH = 16, SEQ = 2048, DM = 1024, M = BATCH * SEQ;
constexpr int MEMLEN = 256, MMEM = BATCH * MEMLEN;
constexpr int DFF = 2816;
constexpr int INCOLS = 6920;
constexpr int PA = 3840;
constexpr int C_FQ = 0, C_FK = 512, C_FV = 1024, C_RR = 1536, C_RK = 2048, C_RV = 2560, C_MQ = 3072, C_WD = 3584, C_AD = 3648, C_GD = 3712;
constexpr float NORM_EPS = 1e-6f, GN_EPS = 64e-5f;
constexpr float LOG2E = 1.4426950408889634f;
constexpr float C2_FOX = 0.125f * LOG2E;
constexpr float C2_MEM = 0.08838834764831845f * LOG2E;

constexpr size_t MiB = 1u << 20;
constexpr size_t WS_CTL = 0, CTL_ZERO_BYTES = 1 * MiB;
constexpr size_t WS_WALL = 1 * MiB;
constexpr size_t WS_WBR = 17 * MiB;
constexpr size_t WS_WO = 20 * MiB;
constexpr size_t WS_WGU = 22 * MiB;
constexpr size_t WS_WDN = 33 * MiB;
constexpr size_t WS_LS = 39 * MiB;
constexpr size_t WS_XNALL = 41 * MiB;
constexpr size_t WS_PROJA = 113 * MiB;
constexpr size_t WS_G01 = 353 * MiB;
constexpr size_t WS_MEMKV = 481 * MiB;
constexpr size_t WS_END = 489 * MiB;
constexpr size_t WS_MERGED = WS_XNALL;
constexpr size_t WS_Y = WS_G01;
constexpr size_t WS_U2 = WS_PROJA;
constexpr size_t WS_HID = WS_PROJA + 64 * MiB;
constexpr size_t WS_FO = WS_G01;
static_assert(WS_HID + (size_t)M * DFF * 2 <= WS_G01, "HID overlay");

constexpr int CW_TMO = 0, CW_CODE = 1;
constexpr int CW_BAR = 4096;
constexpr int CW_QUEUE = 2048;

constexpr int RING_OFF = 0, RING_BYTES = 131072;
constexpr int LDSCTL_OFF = RING_BYTES, MISC_OFF = LDSCTL_OFF + 320;
constexpr int EXTRA_OFF = MISC_OFF + 128;
constexpr int LDS_BYTES = 147456;
constexpr int NWAVES = 8;

__device__ __forceinline__ unsigned f2bf(float f) { unsigned u = __builtin_bit_cast(unsigned, f); return (u + 0x7fffu + ((u >> 16) & 1u)) >> 16; }
__device__ __forceinline__ unsigned pk2(float lo, float hi) { return f2bf(lo) | (f2bf(hi) << 16); }
__device__ __forceinline__ float bflo(unsigned w) { return __builtin_bit_cast(float, w << 16); }
__device__ __forceinline__ float bfhi(unsigned w) { return __builtin_bit_cast(float, w & 0xffff0000u); }
__device__ __forceinline__ float sigm(float x) { return 1.0f / (1.0f + __expf(-x)); }
__device__ __forceinline__ float wave_sum(float v) {
#pragma unroll
    for (int o = 1; o < 64; o <<= 1) v += __shfl_xor(v, o);
    return v;
}
#define LDS_WAIT() asm volatile("s_waitcnt lgkmcnt(0)" ::: "memory")
#define VM_WAIT() asm volatile("s_waitcnt vmcnt(0)" ::: "memory")

namespace pg8 {
#define PG8_LAS __attribute__((address_space(3)))
constexpr int BM = 256, BK = 64, HALF = 128, HTB = HALF * BK * 2, STAGE_BYTES = 8 * HTB, NXCD = 8, WGM = 8;
__host__ __device__ __forceinline__ int lds_byte(int r, int c) { const int st = (r >> 4) * 2 + (c >> 5), rr = r & 15, cc = c & 31, ob = rr * 64 + cc * 2; return st * 1024 + (ob ^ (((ob >> 9) & 1) << 5)); }
__host__ __device__ __forceinline__ void stage_rc(int b, int& R, int& C) { const int st = b / 1024, sb = b % 1024, swz = sb ^ (((sb >> 9) & 1) << 5); R = (st >> 1) * 16 + swz / 64; C = (st & 1) * 32 + (swz % 64) / 2; }
__host__ __device__ __forceinline__ int perm32(int rho) { const int n = rho >> 4, i = rho & 15; return 8 * (i >> 2) + 4 * n + (i & 3); }

struct Unit { int pm, pn, tag; const char* a; const char* b; };
struct Gemm { int K, lda, ldb; };

__device__ __forceinline__ void tile_of(int L, int nM, int nN, int& pm, int& pn) {
    const int nwg = nM * nN; int wgid = L;
    { const int q = nwg / NXCD, r = nwg % NXCD, xcd = wgid % NXCD, off = wgid / NXCD; wgid = (xcd < r ? xcd * (q + 1) : r * (q + 1) + (xcd - r) * q) + off; }
    const int nig = WGM * nN, gid = wgid / nig, fm = gid * WGM, gsz = (nM - fm) < WGM ? (nM - fm) : WGM;
    pm = fm + ((wgid % nig) % gsz); pn = (wgid % nig) / gsz;
}

typedef __bf16 bf16x2_t __attribute__((ext_vector_type(2)));
__device__ __forceinline__ unsigned cvt_pk_bf16(float lo, float hi) { f32x2 v = {lo, hi}; bf16x2_t b = __builtin_convertvector(v, bf16x2_t); return __builtin_bit_cast(unsigned, b); }

template <class Epi, class Sched, bool ALIGN_EPI = false, bool SP2 = false>
__device__ __forceinline__ void gemm_phase(PG8_LAS unsigned char* lds, const Gemm g, const Sched& S, const Epi& E) {
    const int tid = threadIdx.x, wid = __builtin_amdgcn_readfirstlane(tid >> 6), lane = tid & 63, wr = wid >> 2, wc = wid & 3, fr = lane & 15, fq = lane >> 4;
    const int K = g.K, nt = K / BK;
    unsigned voffA[2], voffB[2];
#pragma unroll
    for (int i = 0; i < 2; ++i) { int R, C; stage_rc(tid * 16 + i * 8192, R, C); const int Rb = Epi::PERM ? ((R & ~31) + perm32(R & 31)) : R;
        voffA[i] = (unsigned)(R * g.lda + C) * 2u; voffB[i] = (unsigned)(Rb * g.ldb + C) * 2u; }
    const size_t kstep = (size_t)(BK * 2);
    const size_t hstepA = (size_t)HALF * g.lda * 2, hstepB = (size_t)HALF * g.ldb * 2;
    const unsigned ldsw = (unsigned)wid * 1024u;
    const int aoff = lds_byte(wr * 64 + fr, fq * 8), boff = lds_byte(wc * 32 + fr, fq * 8);
#define PG8_SA(b, h) (((b) * 2 + (h)) * HTB)
#define PG8_SB(b, h) ((4 + (b) * 2 + (h)) * HTB)
#define PG8_STAGE(bufoff, gbase, voff) do { _Pragma("unroll") for (int _i = 0; _i < 2; ++_i) \
        __builtin_amdgcn_global_load_lds((const unsigned*)((const char*)(gbase) + (voff)[_i]), (PG8_LAS unsigned*)(lds + (bufoff) + ldsw + _i * 8192), 16, 0, 0); } while (0)
#define PG8_LDA(dst, b, h) do { _Pragma("unroll") for (int m = 0; m < 4; ++m) _Pragma("unroll") for (int k = 0; k < 2; ++k) dst[m][k] = *(const PG8_LAS bf16x8*)(lds + PG8_SA(b, h) + aoff + m * 2048 + k * 1024); } while (0)
#define PG8_LDB(dst, b, h) do { _Pragma("unroll") for (int n = 0; n < 2; ++n) _Pragma("unroll") for (int k = 0; k < 2; ++k) dst[n][k] = *(const PG8_LAS bf16x8*)(lds + PG8_SB(b, h) + boff + n * 2048 + k * 1024); } while (0)
#define PG8_MMA(ai, bj, At, Bt) do { __builtin_amdgcn_s_setprio(1); _Pragma("unroll") for (int m = 0; m < 4; ++m) _Pragma("unroll") for (int n = 0; n < 2; ++n) _Pragma("unroll") for (int k = 0; k < 2; ++k) \
        acc[ai][bj][m][n] = __builtin_amdgcn_mfma_f32_16x16x32_bf16(Bt[n][k], At[m][k], acc[ai][bj][m][n], 0, 0, 0); __builtin_amdgcn_s_setprio(0); } while (0)
#define PG8_WAIT_V(n) asm volatile("s_waitcnt vmcnt(" #n ")" ::: "memory")
#define PG8_WAIT_L(n) asm volatile("s_waitcnt lgkmcnt(" #n ")" ::: "memory")
#define PG8_BAR __builtin_amdgcn_s_barrier()
#define PG8_SCHED __builtin_amdgcn_sched_barrier(0)
    Unit cur, nxt; int ui = 0;
    if (!S.next(0, cur)) return;
    f32x4 acc[2][2][4][2];
#pragma unroll
    for (int a = 0; a < 2; ++a)
#pragma unroll
        for (int b = 0; b < 2; ++b)
#pragma unroll
            for (int m = 0; m < 4; ++m)
#pragma unroll
                for (int n = 0; n < 2; ++n) acc[a][b][m][n] = (f32x4){0.f, 0.f, 0.f, 0.f};
    bf16x8 At[4][2], B0[2][2], B1[2][2];
    const char* cA = cur.a; const char* cB = cur.b;
    if constexpr (SP2) {
        PG8_STAGE(PG8_SB(0, 0), cB, voffB); PG8_STAGE(PG8_SB(0, 1), cB + hstepB, voffB); PG8_STAGE(PG8_SA(0, 0), cA, voffA); PG8_STAGE(PG8_SA(0, 1), cA + hstepA, voffA);
        if (wr == 1) PG8_BAR;
        PG8_WAIT_V(2); PG8_BAR;
        PG8_STAGE(PG8_SB(1, 0), cB + kstep, voffB); PG8_STAGE(PG8_SA(1, 0), cA + kstep, voffA); PG8_STAGE(PG8_SB(1, 1), cB + hstepB + kstep, voffB);
        PG8_WAIT_V(6); PG8_BAR;
    } else {
        PG8_STAGE(PG8_SB(0, 0), cB, voffB); PG8_STAGE(PG8_SA(0, 0), cA, voffA); PG8_STAGE(PG8_SB(0, 1), cB + hstepB, voffB); PG8_STAGE(PG8_SA(0, 1), cA + hstepA, voffA);
        if (wr == 1) PG8_BAR;
        PG8_WAIT_V(4); PG8_BAR;
        PG8_STAGE(PG8_SB(1, 0), cB + kstep, voffB); PG8_STAGE(PG8_SA(1, 0), cA + kstep, voffA); PG8_STAGE(PG8_SB(1, 1), cB + hstepB + kstep, voffB);
        PG8_WAIT_V(6); PG8_BAR;
    }
    for (;;) {
        const bool has_next = S.next(ui + 1, nxt);
        const char* nA = has_next ? nxt.a : cA; const char* nB = has_next ? nxt.b : cB;
        for (int t = 0; t < nt; t += 2) {
            const bool last = (t == nt - 2);
            const char* a1 = cA + (size_t)(t + 1) * kstep;
            const char* a2 = last ? nA : cA + (size_t)(t + 2) * kstep; const char* b2 = last ? nB : cB + (size_t)(t + 2) * kstep;
            const char* a3 = a2 + kstep; const char* b3 = b2 + kstep;
            if constexpr (SP2) {
            PG8_LDB(B0, 0, 0); PG8_LDB(B1, 0, 1); PG8_SCHED; PG8_LDA(At, 0, 0); PG8_STAGE(PG8_SA(1, 1), a1 + hstepA, voffA);
            PG8_WAIT_V(8); PG8_WAIT_L(0); PG8_BAR; PG8_MMA(0, 0, At, B0); PG8_MMA(0, 1, At, B1); PG8_BAR; PG8_SCHED;
            PG8_LDA(At, 0, 1); PG8_STAGE(PG8_SB(0, 0), b2, voffB); PG8_STAGE(PG8_SB(0, 1), b2 + hstepB, voffB); PG8_STAGE(PG8_SA(0, 0), a2, voffA);
            PG8_WAIT_V(8); PG8_WAIT_L(0); PG8_BAR; PG8_MMA(1, 0, At, B0); PG8_MMA(1, 1, At, B1); PG8_BAR; PG8_SCHED;
            PG8_LDB(B0, 1, 0); PG8_LDB(B1, 1, 1); PG8_SCHED; PG8_LDA(At, 1, 0); PG8_STAGE(PG8_SA(0, 1), a2 + hstepA, voffA);
            PG8_WAIT_V(8); PG8_WAIT_L(0); PG8_BAR; PG8_MMA(0, 0, At, B0); PG8_MMA(0, 1, At, B1); PG8_BAR; PG8_SCHED;
            PG8_LDA(At, 1, 1); PG8_STAGE(PG8_SB(1, 0), b3, voffB); PG8_STAGE(PG8_SB(1, 1), b3 + hstepB, voffB); PG8_STAGE(PG8_SA(1, 0), a3, voffA);
            PG8_WAIT_V(8); PG8_WAIT_L(0); PG8_BAR; PG8_MMA(1, 0, At, B0); PG8_MMA(1, 1, At, B1); PG8_BAR; PG8_SCHED;
            } else {
            PG8_LDB(B0, 0, 0); PG8_SCHED; PG8_LDA(At, 0, 0); PG8_STAGE(PG8_SA(1, 1), a1 + hstepA, voffA);
            PG8_WAIT_L(8); PG8_BAR; PG8_WAIT_L(0); PG8_MMA(0, 0, At, B0); PG8_BAR; PG8_SCHED;
            PG8_LDB(B1, 0, 1); PG8_STAGE(PG8_SB(0, 0), b2, voffB);
            PG8_BAR; PG8_WAIT_L(0); PG8_MMA(0, 1, At, B1); PG8_BAR;
            PG8_LDA(At, 0, 1); PG8_STAGE(PG8_SA(0, 0), a2, voffA);
            PG8_BAR; PG8_WAIT_L(0); PG8_MMA(1, 0, At, B0); PG8_BAR; PG8_SCHED;
            PG8_STAGE(PG8_SB(0, 1), b2 + hstepB, voffB);
            PG8_WAIT_V(6); PG8_BAR; PG8_MMA(1, 1, At, B1); PG8_BAR;
            PG8_LDB(B0, 1, 0); PG8_SCHED; PG8_LDA(At, 1, 0); PG8_STAGE(PG8_SA(0, 1), a2 + hstepA, voffA);
            PG8_WAIT_L(8); PG8_BAR; PG8_WAIT_L(0); PG8_MMA(0, 0, At, B0); PG8_BAR; PG8_SCHED;
            PG8_LDB(B1, 1, 1); PG8_STAGE(PG8_SB(1, 0), b3, voffB);
            PG8_BAR; PG8_WAIT_L(0); PG8_MMA(0, 1, At, B1); PG8_BAR;
            PG8_LDA(At, 1, 1); PG8_STAGE(PG8_SA(1, 0), a3, voffA);
            PG8_BAR; PG8_WAIT_L(0); PG8_MMA(1, 0, At, B0); PG8_BAR; PG8_SCHED;
            PG8_STAGE(PG8_SB(1, 1), b3 + hstepB, voffB);
            PG8_WAIT_V(6); PG8_BAR; PG8_MMA(1, 1, At, B1); PG8_BAR;
            }
        }
        if constexpr (ALIGN_EPI) { if (wr == 0) PG8_BAR; }
        if constexpr (!Epi::AFTER_DRAIN) { E(acc, cur, wr, wc, fr, fq); }
        if (!has_next) break;
#pragma unroll
        for (int a = 0; a < 2; ++a)
#pragma unroll
            for (int b = 0; b < 2; ++b)
#pragma unroll
                for (int m = 0; m < 4; ++m)
#pragma unroll
                    for (int n = 0; n < 2; ++n) acc[a][b][m][n] = (f32x4){0.f, 0.f, 0.f, 0.f};
        cur = nxt; cA = nA; cB = nB; ++ui;
        if constexpr (ALIGN_EPI) { if (wr == 1) PG8_BAR; }
    }
    PG8_WAIT_V(0);
    if constexpr (!ALIGN_EPI) { if (wr == 0) PG8_BAR; }
    PG8_BAR;
    if constexpr (Epi::AFTER_DRAIN) { E.fused(acc, cur, wr, wc, fr, fq, lds, wid, lane); }
#undef PG8_SA
#undef PG8_SB
#undef PG8_STAGE
#undef PG8_LDA
#undef PG8_LDB
#undef PG8_MMA
#undef PG8_WAIT_V
#undef PG8_WAIT_L
#undef PG8_BAR
#undef PG8_SCHED
}

#define PG8_FOR_GROUPS(acc, wr, wc, fr, fq, BODY) \
    _Pragma("unroll") for (int ai = 0; ai < 2; ++ai) _Pragma("unroll") for (int m = 0; m < 4; ++m) _Pragma("unroll") for (int bj = 0; bj < 2; ++bj) { \
        const int trow = ai * HALF + wr * 64 + m * 16 + fr, tcol = bj * HALF + wc * 32 + 8 * fq; f32x4 v0 = acc[ai][bj][m][0], v1 = acc[ai][bj][m][1]; BODY }

__device__ __forceinline__ u32x4 pack8(f32x4 v0, f32x4 v1) { u32x4 w; w.x = cvt_pk_bf16(v0[0], v0[1]); w.y = cvt_pk_bf16(v0[2], v0[3]); w.z = cvt_pk_bf16(v1[0], v1[1]); w.w = cvt_pk_bf16(v1[2], v1[3]); return w; }

struct EpiPlain {
    static constexpr bool PERM = true, AFTER_DRAIN = false;
    bf16_t* O; int ldc;
    __device__ __forceinline__ void operator()(const f32x4 (&acc)[2][2][4][2], const Unit& u, int wr, int wc, int fr, int fq) const {
        PG8_FOR_GROUPS(acc, wr, wc, fr, fq, { *(u32x4*)(O + (size_t)(u.pm * BM + trow) * ldc + u.pn * BM + tcol) = pack8(v0, v1); })
    }
};
struct EpiInProj {
    static constexpr bool PERM = true, AFTER_DRAIN = false;
    bf16_t* proja; bf16_t* g01; bf16_t* g2; bf16_t* memkv;
    __device__ __forceinline__ void operator()(const f32x4 (&acc)[2][2][4][2], const Unit& u, int wr, int wc, int fr, int fq) const {
        if (u.tag == 1) {
            PG8_FOR_GROUPS(acc, wr, wc, fr, fq, { *(u32x4*)(memkv + (size_t)((u.pm - 128) * BM + trow) * 1024 + (u.pn - 27) * BM + tcol) = pack8(v0, v1); })
        } else if (u.pn < 15) {
            const float sc = (u.pn < 2) ? C2_FOX : ((u.pn == 12 || u.pn == 13) ? C2_MEM : 1.0f);
            PG8_FOR_GROUPS(acc, wr, wc, fr, fq, { v0 = v0 * sc; v1 = v1 * sc; *(u32x4*)(proja + (size_t)(u.pm * BM + trow) * PA + u.pn * BM + tcol) = pack8(v0, v1); })
        } else {
            bf16_t* base; int ld, c0;
            if (u.pn < 23) { base = g01; ld = 2048; c0 = (u.pn - 15) * BM; } else { base = g2; ld = 1024; c0 = (u.pn - 23) * BM; }
            PG8_FOR_GROUPS(acc, wr, wc, fr, fq, {
                _Pragma("unroll") for (int e = 0; e < 4; ++e) { v0[e] = __builtin_amdgcn_rcpf(1.0f + __builtin_amdgcn_exp2f(-LOG2E * v0[e])); v1[e] = __builtin_amdgcn_rcpf(1.0f + __builtin_amdgcn_exp2f(-LOG2E * v1[e])); }
                *(u32x4*)(base + (size_t)(u.pm * BM + trow) * ld + c0 + tcol) = pack8(v0, v1); })
        }
    }
};
struct EpiMerge {
    static constexpr bool PERM = true, AFTER_DRAIN = false;
    const bf16_t* g01; const bf16_t* g2; bf16_t* merged;
    __device__ __forceinline__ void operator()(const f32x4 (&acc)[2][2][4][2], const Unit& u, int wr, int wc, int fr, int fq) const {
        const int b = u.tag;
        PG8_FOR_GROUPS(acc, wr, wc, fr, fq, {
            const size_t row = (size_t)(u.pm * BM + trow); const int col = u.pn * BM + tcol;
            const u32x4 gw = (b < 2) ? *(const u32x4*)(g01 + row * 2048 + b * 1024 + col) : *(const u32x4*)(g2 + row * 1024 + col);
            v0[0] *= bflo(gw.x); v0[1] *= bfhi(gw.x); v0[2] *= bflo(gw.y); v0[3] *= bfhi(gw.y); v1[0] *= bflo(gw.z); v1[1] *= bfhi(gw.z); v1[2] *= bflo(gw.w); v1[3] *= bfhi(gw.w);
            bf16_t* mp = merged + row * 1024 + col;
            if (b > 0) { const u32x4 mw = *(const u32x4*)mp;
                v0[0] += bflo(mw.x); v0[1] += bfhi(mw.x); v0[2] += bflo(mw.y); v0[3] += bfhi(mw.y); v1[0] += bflo(mw.z); v1[1] += bfhi(mw.z); v1[2] += bflo(mw.w); v1[3] += bfhi(mw.w); }
            *(u32x4*)mp = pack8(v0, v1); })
    }
};
struct EpiSwiGLU {
    static constexpr bool PERM = true, AFTER_DRAIN = false;
    bf16_t* hid;
    __device__ __forceinline__ void operator()(const f32x4 (&acc)[2][2][4][2], const Unit& u, int wr, int wc, int fr, int fq) const {
#pragma unroll
        for (int ai = 0; ai < 2; ++ai)
#pragma unroll
            for (int m = 0; m < 4; ++m) {
                const int trow = ai * HALF + wr * 64 + m * 16 + fr, tcol = wc * 32 + 8 * fq;
                f32x4 g0 = acc[ai][0][m][0], g1 = acc[ai][0][m][1]; const f32x4 u0 = acc[ai][1][m][0], u1 = acc[ai][1][m][1];
#pragma unroll
                for (int e = 0; e < 4; ++e) { g0[e] = g0[e] * __builtin_amdgcn_rcpf(1.0f + __builtin_amdgcn_exp2f(-LOG2E * g0[e])) * u0[e]; g1[e] = g1[e] * __builtin_amdgcn_rcpf(1.0f + __builtin_amdgcn_exp2f(-LOG2E * g1[e])) * u1[e]; }
                *(u32x4*)(hid + (size_t)(u.pm * BM + trow) * DFF + u.pn * HALF + tcol) = pack8(g0, g1);
            }
    }
};
}

typedef GAS unsigned gu32;
#define RLX_AGENT __ATOMIC_RELAXED, __HIP_MEMORY_SCOPE_AGENT
#define XB_TMO      128
#define XB_XCNT(j)  (256  + 64 * (j))
#define XB_XSUB(j)  (1280 + 64 * (j))
#define XB_XGEN(j)  (2304 + 64 * (j))
#define XB_TOP      3328
#define XB_TOPGEN   3392
#define XCD_BAR_WORDS 3456
#define XB_SPIN_CAP (1u << 18)
__device__ __forceinline__ unsigned xb_ld(unsigned* p)              { return __hip_atomic_load(p, __ATOMIC_RELAXED, __HIP_MEMORY_SCOPE_AGENT); }
__device__ __forceinline__ unsigned xb_add(unsigned* p, unsigned v) { return __hip_atomic_fetch_add(p, v, __ATOMIC_RELAXED, __HIP_MEMORY_SCOPE_AGENT); }
__device__ __forceinline__ unsigned xb_xcc_id() { return (unsigned)__builtin_amdgcn_s_getreg((3 << 11) | 20) & 0xFu; }
#define XB_SPIN(cond, bar) do { unsigned _sp = 0; while (cond) { __builtin_amdgcn_s_sleep(1); \
    if ((++_sp & 255u) == 0u) { if (xb_ld(&(bar)[XB_TMO])) break; if (_sp > XB_SPIN_CAP) { atomicAdd(&(bar)[XB_TMO], 1u); break; } } } } while (0)
struct XcdBarrier { unsigned* bar; unsigned x; volatile LAS unsigned* st; };
__device__ __forceinline__ XcdBarrier xcd_barrier_post(unsigned* bar, volatile LAS unsigned* st) {
    XcdBarrier b; b.bar = bar; b.x = xb_xcc_id(); b.st = st;
    if (threadIdx.x == 0) (void)xb_add(&bar[XB_XCNT(b.x)], 1u);
    return b;
}
__device__ __forceinline__ void xcd_barrier_complete(unsigned* bar, unsigned x, unsigned& nloc, unsigned& nx) {
    const unsigned G = gridDim.x * gridDim.y * gridDim.z;
    unsigned sum, cnt, mine, sp = 0u;
    for (;;) {
        sum = 0u; cnt = 0u; mine = 0u;
#pragma unroll
        for (unsigned j = 0; j < 16; ++j) { const unsigned c = xb_ld(&bar[XB_XCNT(j)]); sum += c; cnt += (c > 0u) ? 1u : 0u; mine = (j == x) ? c : mine; }
        if (sum == G) break;
        __builtin_amdgcn_s_sleep(1);
        if ((++sp & 255u) == 0u) { if (xb_ld(&bar[XB_TMO])) break; if (sp > XB_SPIN_CAP) { atomicAdd(&bar[XB_TMO], 1u); break; } }
    }
    nloc = mine > 0u ? mine : 1u; nx = cnt > 0u ? cnt : 1u;
}
__device__ __forceinline__ void xcd_barrier(const XcdBarrier& b) {
    asm volatile("s_waitcnt vmcnt(0)" ::: "memory");
    __syncthreads();
    if (threadIdx.x == 0) {
        unsigned* bar = b.bar;
        __builtin_amdgcn_s_waitcnt(0);
        unsigned nloc = b.st[0], nx = b.st[1];
        if (nloc == 0u) { xcd_barrier_complete(bar, b.x, nloc, nx); b.st[0] = nloc; b.st[1] = nx; }
        const unsigned old = xb_add(&bar[XB_XSUB(b.x)], 1u);
        const unsigned gen = old / nloc;
        if (old + 1u == (gen + 1u) * nloc) {
            __builtin_amdgcn_fence(__ATOMIC_RELEASE, "agent");
            asm volatile("s_waitcnt vmcnt(0)" ::: "memory");
            const unsigned og = xb_add(&bar[XB_TOP], 1u);
            const unsigned tg = og / nx;
            if (og + 1u == (tg + 1u) * nx) xb_add(&bar[XB_TOPGEN], 1u);
            else XB_SPIN(xb_ld(&bar[XB_TOPGEN]) == tg, bar);
            __builtin_amdgcn_fence(__ATOMIC_ACQUIRE, "agent");
            xb_add(&bar[XB_XGEN(b.x)], 1u);
            asm volatile("s_waitcnt vmcnt(0)" ::: "memory");
        } else {
            XB_SPIN(xb_ld(&bar[XB_XGEN(b.x)]) == gen, bar);
            __builtin_amdgcn_fence(__ATOMIC_ACQUIRE, "agent");
            asm volatile("s_waitcnt vmcnt(0)" ::: "memory");
        }
    }
    __syncthreads();
}

struct Frame {
    LAS unsigned char* lds;
    volatile LAS unsigned* MISC;
    gu32* ctl;
    int tid, lane, wave;
    int vcu, G;
    const float* in[28];
    float* out; unsigned char* ws;
};
enum { I_X = 0, I_MEM, I_PRE1, I_POST1, I_PRE2, I_POST2, I_MEMG, I_WIN, I_FBIAS, I_MU, I_W0, I_WUP, I_A0, I_AUP, I_GUP, I_KK, I_KA, I_RK, I_GNG, I_GNB,
       I_WMEMKV, I_WFOX, I_WRWKV, I_WMEMO, I_WO, I_WG, I_WU, I_WD };

__device__ __forceinline__ void p0_transpose_item(const float* src, int ldsrc, int K, bf16_t* WT, int drow0, int k0, LAS float* scr, int lane) {
#pragma unroll 8
    for (int i = 0; i < 32; ++i) { const int kk = 2 * i + (lane >> 5); scr[kk * 33 + (lane & 31)] = src[(size_t)(k0 + kk) * ldsrc + (lane & 31)]; }
    LDS_WAIT(); asm volatile("" ::: "memory");
    const int c = lane & 7;
#pragma unroll
    for (int j = 0; j < 4; ++j) { const int n = (lane >> 3) + 8 * j; const LAS float* s = scr + (8 * c) * 33 + n;
        u32x4 o; o.x = pk2(s[0 * 33], s[1 * 33]); o.y = pk2(s[2 * 33], s[3 * 33]); o.z = pk2(s[4 * 33], s[5 * 33]); o.w = pk2(s[6 * 33], s[7 * 33]);
        *(GAS u32x4*)(WT + (size_t)(drow0 + n) * K + k0 + 8 * c) = o; }
    LDS_WAIT(); asm volatile("" ::: "memory");
}
struct TJob { int src_in; int ldsrc; int K; int scol; int ncols; size_t dst_off; int drow; int mode; };
static constexpr TJob kJobs[21] = {
    {I_WIN, INCOLS, 1024, 0,    512, WS_WALL, 0,    0},
    {I_WIN, INCOLS, 1024, 512,  512, WS_WALL, 512,  0},
    {I_WIN, INCOLS, 1024, 1024, 512, WS_WALL, 1024, 0},
    {I_WIN, INCOLS, 1024, 1544, 512, WS_WALL, 1536, 0},
    {I_WIN, INCOLS, 1024, 2056, 512, WS_WALL, 2048, 0},
    {I_WIN, INCOLS, 1024, 2568, 512, WS_WALL, 2560, 0},
    {I_WIN, INCOLS, 1024, 3336, 512, WS_WALL, 3072, 0},
    {I_WIN, INCOLS, 1024, 3080, 64,  WS_WALL, 3584, 0},
    {I_WIN, INCOLS, 1024, 3144, 64,  WS_WALL, 3648, 0},
    {I_WIN, INCOLS, 1024, 3208, 128, WS_WALL, 3712, 0},
    {I_WIN, INCOLS, 1024, 3848, 1024, WS_WALL, 3840, 0},
    {I_WIN, INCOLS, 1024, 4872, 1024, WS_WALL, 4864, 0},
    {I_WIN, INCOLS, 1024, 5896, 1024, WS_WALL, 5888, 0},
    {I_WMEMKV, 1024, 1024, 0, 1024, WS_WALL, 6912, 0},
    {I_WFOX,  1024, 512, 0, 1024, WS_WBR, 0,    0},
    {I_WRWKV, 1024, 512, 0, 1024, WS_WBR, 1024, 0},
    {I_WMEMO, 1024, 512, 0, 1024, WS_WBR, 2048, 0},
    {I_WO, 1024, 1024, 0, 1024, WS_WO, 0, 0},
    {I_WG, DFF, 1024, 0, DFF, WS_WGU, 0,   1},
    {I_WU, DFF, 1024, 0, DFF, WS_WGU, 128, 1},
    {I_WD, 1024, DFF, 0, 1024, WS_WDN, 0, 0}};
__device__ __forceinline__ void p0_prologue(Frame& F) {
    LAS float* scr = (LAS float*)(F.lds + RING_OFF + F.wave * 16384);
    const int gw = F.vcu * NWAVES + F.wave, NGW = F.G * NWAVES;
    int base = 0;
#pragma unroll
    for (int j = 0; j < 21; ++j) {
        const TJob jb = kJobs[j]; const int nblk = jb.ncols / 32, nitem = (jb.K / 64) * nblk;
        int it = gw - (base % NGW); if (it < 0) it += NGW;
        const float* srcp = F.in[jb.src_in] + jb.scol; bf16_t* dstp = (bf16_t*)(F.ws + jb.dst_off);
#pragma unroll 1
        for (; it < nitem; it += NGW) {
            const int kb = it / nblk, nb = it % nblk, n0 = nb * 32;
            const int drow0 = (jb.mode == 0) ? (jb.drow + n0) : (256 * (n0 / 128) + jb.drow + (n0 % 128));
            p0_transpose_item(srcp + n0, jb.ldsrc, jb.K, dstp, drow0, 64 * kb, scr, F.lane);
        }
        base += nitem;
    }
    {
        const float* win = F.in[I_WIN]; const float* g1 = F.in[I_PRE1]; const float* fb = F.in[I_FBIAS];
        bf16_t* XN = (bf16_t*)(F.ws + WS_XNALL); float* LS = (float*)(F.ws + WS_LS);
        f32x4 gv[4];
#pragma unroll
        for (int j = 0; j < 4; ++j) gv[j] = *(const f32x4*)(g1 + 4 * F.lane + 256 * j);
        for (int m = gw; m < M; m += NGW) {
            const GAS f32x4* xr = (const GAS f32x4*)(F.in[I_X] + (size_t)m * DM) + F.lane;
            f32x4 v[4]; float s = 0.f;
#pragma unroll
            for (int j = 0; j < 4; ++j) { v[j] = xr[64 * j]; s += (v[j].x * v[j].x + v[j].y * v[j].y) + (v[j].z * v[j].z + v[j].w * v[j].w); }
            const float rn = 1.0f / sqrtf(wave_sum(s) * (1.f / DM) + NORM_EPS);
            float fa[8];
#pragma unroll
            for (int h = 0; h < 8; ++h) fa[h] = 0.f;
#pragma unroll
            for (int j = 0; j < 4; ++j) { v[j] = v[j] * rn * gv[j];
#pragma unroll
                for (int e = 0; e < 4; ++e) { const float* wp = win + (size_t)(4 * F.lane + 256 * j + e) * INCOLS + 1536; const f32x4 w0 = *(const f32x4*)wp, w1 = *(const f32x4*)(wp + 4);
                    const float u = v[j][e]; fa[0] += u * w0.x; fa[1] += u * w0.y; fa[2] += u * w0.z; fa[3] += u * w0.w; fa[4] += u * w1.x; fa[5] += u * w1.y; fa[6] += u * w1.z; fa[7] += u * w1.w; } }
            GAS unsigned long long* o8 = (GAS unsigned long long*)(XN + (size_t)m * DM) + F.lane;
#pragma unroll
            for (int j = 0; j < 4; ++j) o8[64 * j] = (unsigned long long)pk2(v[j].x, v[j].y) | ((unsigned long long)pk2(v[j].z, v[j].w) << 32);
#pragma unroll
            for (int h = 0; h < 8; ++h) fa[h] = wave_sum(fa[h]);
            if (F.lane < 8) { float f = fa[0];
#pragma unroll
                for (int h = 1; h < 8; ++h) f = (F.lane == h) ? fa[h] : f;
                f += fb[F.lane];
                const float ls = fminf(f, 0.f) - log1pf(__expf(-fabsf(f)));
                LS[(size_t)m * 8 + F.lane] = ls; }
        }
    }
    {
        const float* g1 = F.in[I_MEMG]; bf16_t* XN = (bf16_t*)(F.ws + WS_XNALL) + (size_t)M * DM;
        f32x4 gv[4];
#pragma unroll
        for (int j = 0; j < 4; ++j) gv[j] = *(const f32x4*)(g1 + 4 * F.lane + 256 * j);
        for (int m = gw; m < MMEM; m += NGW) {
            const GAS f32x4* xr = (const GAS f32x4*)(F.in[I_MEM] + (size_t)m * DM) + F.lane;
            f32x4 v[4]; float s = 0.f;
#pragma unroll
            for (int j = 0; j < 4; ++j) { v[j] = xr[64 * j]; s += (v[j].x * v[j].x + v[j].y * v[j].y) + (v[j].z * v[j].z + v[j].w * v[j].w); }
            const float rn = 1.0f / sqrtf(wave_sum(s) * (1.f / DM) + NORM_EPS);
            GAS unsigned long long* o8 = (GAS unsigned long long*)(XN + (size_t)m * DM) + F.lane;
#pragma unroll
            for (int j = 0; j < 4; ++j) { v[j] = v[j] * rn * gv[j]; o8[64 * j] = (unsigned long long)pk2(v[j].x, v[j].y) | ((unsigned long long)pk2(v[j].z, v[j].w) << 32); }
        }
    }
}

__device__ __forceinline__ void load_row_bf16(const bf16_t* p, int lane, f32x4 (&v)[4]) {
#pragma unroll
    for (int j = 0; j < 4; ++j) { const u32x2 w = *(const u32x2*)(p + 4 * lane + 256 * j); v[j] = (f32x4){bflo(w.x), bfhi(w.x), bflo(w.y), bfhi(w.y)}; }
}
__device__ __forceinline__ void p3c_rows(Frame& F) {
    const int gw = F.vcu * NWAVES + F.wave, NGW = F.G * NWAVES;
    const bf16_t* Y = (const bf16_t*)(F.ws + WS_Y); bf16_t* U2 = (bf16_t*)(F.ws + WS_U2);
    f32x4 g1[4], g2[4];
#pragma unroll
    for (int j = 0; j < 4; ++j) { g1[j] = *(const f32x4*)(F.in[I_POST1] + 4 * F.lane + 256 * j); g2[j] = *(const f32x4*)(F.in[I_PRE2] + 4 * F.lane + 256 * j); }
    for (int m = gw; m < M; m += NGW) {
        f32x4 y[4]; load_row_bf16(Y + (size_t)m * DM, F.lane, y);
        float s = 0.f;
#pragma unroll
        for (int j = 0; j < 4; ++j) s += (y[j].x * y[j].x + y[j].y * y[j].y) + (y[j].z * y[j].z + y[j].w * y[j].w);
        const float rn = 1.0f / sqrtf(wave_sum(s) * (1.f / DM) + NORM_EPS);
        const GAS f32x4* xr = (const GAS f32x4*)(F.in[I_X] + (size_t)m * DM) + F.lane;
        GAS f32x4* hr = (GAS f32x4*)(F.out + (size_t)m * DM) + F.lane;
        float s2 = 0.f;
#pragma unroll
        for (int j = 0; j < 4; ++j) { y[j] = xr[64 * j] + y[j] * rn * g1[j]; hr[64 * j] = y[j]; s2 += (y[j].x * y[j].x + y[j].y * y[j].y) + (y[j].z * y[j].z + y[j].w * y[j].w); }
        const float rn2 = 1.0f / sqrtf(wave_sum(s2) * (1.f / DM) + NORM_EPS);
        GAS unsigned long long* o8 = (GAS unsigned long long*)(U2 + (size_t)m * DM) + F.lane;
#pragma unroll
        for (int j = 0; j < 4; ++j) { const f32x4 u = y[j] * rn2 * g2[j]; o8[64 * j] = (unsigned long long)pk2(u.x, u.y) | ((unsigned long long)pk2(u.z, u.w) << 32); }
    }
}
__device__ __forceinline__ void p5c_rows(Frame& F) {
    const int gw = F.vcu * NWAVES + F.wave, NGW = F.G * NWAVES;
    const bf16_t* FO = (const bf16_t*)(F.ws + WS_FO);
    f32x4 g1[4];
#pragma unroll
    for (int j = 0; j < 4; ++j) g1[j] = *(const f32x4*)(F.in[I_POST2] + 4 * F.lane + 256 * j);
    for (int m = gw; m < M; m += NGW) {
        f32x4 y[4]; load_row_bf16(FO + (size_t)m * DM, F.lane, y);
        float s = 0.f;
#pragma unroll
        for (int j = 0; j < 4; ++j) s += (y[j].x * y[j].x + y[j].y * y[j].y) + (y[j].z * y[j].z + y[j].w * y[j].w);
        const float rn = 1.0f / sqrtf(wave_sum(s) * (1.f / DM) + NORM_EPS);
        GAS f32x4* hr = (GAS f32x4*)(F.out + (size_t)m * DM) + F.lane;
#pragma unroll
        for (int j = 0; j < 4; ++j) hr[64 * j] = hr[64 * j] + y[j] * rn * g1[j];
    }
}

__device__ __forceinline__ void fox_simple_unit(Frame& F, int b, int h, int qb) {
    const int tid = F.tid, lane = F.lane, wave = F.wave;
    LAS float* cs = (LAS float*)(F.lds);
    LAS bf16_t* Kt = (LAS bf16_t*)(F.lds + 8192);
    LAS bf16_t* Vt = (LAS bf16_t*)(F.lds + 16384);
    LAS float* wt = (LAS float*)(F.lds + 24576);
    const bf16_t* PJ = (const bf16_t*)(F.ws + WS_PROJA);
    __syncthreads();
    {
        const float* ls = (const float*)(F.ws + WS_LS) + (size_t)b * SEQ * 8 + h;
        const float e0 = ls[(4 * tid + 0) * 8], e1 = ls[(4 * tid + 1) * 8], e2 = ls[(4 * tid + 2) * 8], e3 = ls[(4 * tid + 3) * 8];
        const float s = (e0 + e1) + (e2 + e3); float inc = s;
#pragma unroll
        for (int o = 1; o < 64; o <<= 1) { const float n = __shfl_up(inc, o); if (lane >= o) inc += n; }
        if (lane == 63) wt[wave] = inc;
        __syncthreads();
        float base = 0.f;
        for (int w = 0; w < wave; ++w) base += wt[w];
        float c = base + inc - s;
        c += e0; cs[4 * tid + 0] = c * LOG2E; c += e1; cs[4 * tid + 1] = c * LOG2E; c += e2; cs[4 * tid + 2] = c * LOG2E; c += e3; cs[4 * tid + 3] = c * LOG2E;
    }
    const int q = qb * 512 + tid; const size_t row = (size_t)b * SEQ + q;
    float qf[64], o[64];
#pragma unroll
    for (int c = 0; c < 8; ++c) { const u32x4 w = *(const u32x4*)(PJ + row * PA + C_FQ + h * 64 + c * 8);
        qf[8 * c + 0] = bflo(w.x); qf[8 * c + 1] = bfhi(w.x); qf[8 * c + 2] = bflo(w.y); qf[8 * c + 3] = bfhi(w.y); qf[8 * c + 4] = bflo(w.z); qf[8 * c + 5] = bfhi(w.z); qf[8 * c + 6] = bflo(w.w); qf[8 * c + 7] = bfhi(w.w); }
#pragma unroll
    for (int d = 0; d < 64; ++d) o[d] = 0.f;
    float mrun = -1e30f, l = 0.f;
    const int ntile = (qb + 1) * 8; const int qwmax = qb * 512 + wave * 64 + 63;
    for (int kt = 0; kt < ntile; ++kt) {
        __syncthreads();
        { const size_t krow = (size_t)b * SEQ + kt * 64 + (tid >> 3);
          const u32x4 kv = *(const u32x4*)(PJ + krow * PA + C_FK + h * 64 + (tid & 7) * 8);
          const u32x4 vv = *(const u32x4*)(PJ + krow * PA + C_FV + h * 64 + (tid & 7) * 8);
          *(LAS u32x4*)(Kt + (tid >> 3) * 64 + (tid & 7) * 8) = kv; *(LAS u32x4*)(Vt + (tid >> 3) * 64 + (tid & 7) * 8) = vv; }
        __syncthreads();
        const int kbase = kt * 64;
        if (kbase <= qwmax) {
#pragma unroll 1
            for (int kk = 0; kk < 64; ++kk) {
                const int kidx = kbase + kk;
                float s0 = 0.f, s1 = 0.f;
#pragma unroll
                for (int c = 0; c < 8; ++c) { const u32x4 w = *(const LAS u32x4*)(Kt + kk * 64 + c * 8);
                    s0 += qf[8 * c + 0] * bflo(w.x) + qf[8 * c + 2] * bflo(w.y) + qf[8 * c + 4] * bflo(w.z) + qf[8 * c + 6] * bflo(w.w);
                    s1 += qf[8 * c + 1] * bfhi(w.x) + qf[8 * c + 3] * bfhi(w.y) + qf[8 * c + 5] * bfhi(w.z) + qf[8 * c + 7] * bfhi(w.w); }
                const bool ok = kidx <= q;
                const float s = ok ? (s0 + s1 - cs[kidx]) : -1e30f;
                const float mn = fmaxf(mrun, s); const float al = __builtin_amdgcn_exp2f(mrun - mn); const float p = ok ? __builtin_amdgcn_exp2f(s - mn) : 0.f;
                l = l * al + p; mrun = mn;
#pragma unroll
                for (int c = 0; c < 8; ++c) { const u32x4 w = *(const LAS u32x4*)(Vt + kk * 64 + c * 8);
                    o[8 * c + 0] = o[8 * c + 0] * al + p * bflo(w.x); o[8 * c + 1] = o[8 * c + 1] * al + p * bfhi(w.x); o[8 * c + 2] = o[8 * c + 2] * al + p * bflo(w.y); o[8 * c + 3] = o[8 * c + 3] * al + p * bfhi(w.y);
                    o[8 * c + 4] = o[8 * c + 4] * al + p * bflo(w.z); o[8 * c + 5] = o[8 * c + 5] * al + p * bfhi(w.z); o[8 * c + 6] = o[8 * c + 6] * al + p * bflo(w.w); o[8 * c + 7] = o[8 * c + 7] * al + p * bfhi(w.w); }
            }
        }
    }
    const float rl = 1.0f / l;
    bf16_t* op = (bf16_t*)(F.ws + WS_PROJA) + row * PA + C_FQ + h * 64;
#pragma unroll
    for (int c = 0; c < 8; ++c) { u32x4 w; w.x = pk2(o[8 * c + 0] * rl, o[8 * c + 1] * rl); w.y = pk2(o[8 * c + 2] * rl, o[8 * c + 3] * rl); w.z = pk2(o[8 * c + 4] * rl, o[8 * c + 5] * rl); w.w = pk2(o[8 * c + 6] * rl, o[8 * c + 7] * rl);
        *(u32x4*)(op + c * 8) = w; }
}


namespace fox {
using s16x4=__attribute__((ext_vector_type(4)))short;
using f32x16=__attribute__((ext_vector_type(16)))float;
constexpr int D=64;
constexpr int NW=8,QBLK=32,QB=QBLK*NW,KVBLK=64,NQB=SEQ/QB;
__device__ __forceinline__ int crow(int r,int hi){return (r&3)+8*(r>>2)+4*hi;}
#define SBAR() __builtin_amdgcn_sched_barrier(0)
__device__ __forceinline__ void cmask(f32x16&p0,f32x16&p1,int jb,int qrel,int hi){
  const float NEG=-INFINITY; int kb=64*jb+4*hi;
  #pragma unroll
  for(int r=0;r<16;++r){int kv=kb+(r&3)+8*(r>>2); if(kv>qrel)p0[r]=NEG; if(kv+32>qrel)p1[r]=NEG;}
}
constexpr int NSLOT=3, SLOTB=8192;
constexpr int LDS_K=0, LDS_V=NSLOT*SLOTB, LDS_WS=2*NSLOT*SLOTB, LDS_OST=LDS_WS+NW*64*4, LDS_CB=LDS_OST+NW*4096, LDS_SCAN=LDS_CB+8192, LDS_BYTES_=LDS_SCAN+64;
__device__ __forceinline__ void glds16(const void*gsrc,unsigned lds_dst){unsigned keep;
  asm volatile("s_mov_b32 %0, m0\n\ts_mov_b32 m0, %2\n\ts_nop 0\n\tglobal_load_lds_dwordx4 %1, off\n\ts_mov_b32 m0, %0":"=&s"(keep):"v"(gsrc),"s"(lds_dst):"memory");}
__device__ __forceinline__ float max3f(float a,float b,float c){float r;asm("v_max3_f32 %0, %1, %2, %3":"=v"(r):"v"(a),"v"(b),"v"(c));return r;}
__device__ __forceinline__ float max2f(float a,float b){float r;asm("v_max_f32_e32 %0, %1, %2":"=v"(r):"v"(a),"v"(b));return r;}
__device__ __forceinline__ float fadd_s(float a,float b){float r;asm("v_add_f32_e32 %0, %1, %2":"=v"(r):"v"(a),"v"(b));return r;}
__device__ __forceinline__ float fsub_s(float a,float b){float r;asm("v_sub_f32_e32 %0, %1, %2":"=v"(r):"v"(a),"v"(b));return r;}
typedef float f32x2_t __attribute__((ext_vector_type(2))); typedef __bf16 bf16x2v_t __attribute__((ext_vector_type(2)));
__device__ __forceinline__ unsigned cvtpk_s(float lo,float hi){f32x2_t v={lo,hi};bf16x2v_t b=__builtin_convertvector(v,bf16x2v_t);return __builtin_bit_cast(unsigned,b);}
#define WAIT_BAR(N) asm volatile("s_waitcnt vmcnt(" #N ") lgkmcnt(0)\n\ts_barrier":::"memory")
#define KBF(w) (kbw[0]=(w),kbw)

__device__ __forceinline__ void qkt(f32x16&p0,f32x16&p1,const char*Kslot,const bf16x8*qr,int r32,int hi,u32x4 kb0,u32x4 kb1,bf16x8 qr4){
  const char*kb=Kslot+hi*1024+r32*16;
  #pragma unroll
  for(int d0=0;d0<4;++d0){
    const bf16x8 b0=*reinterpret_cast<const bf16x8*>(kb+d0*2048);
    const bf16x8 b1=*reinterpret_cast<const bf16x8*>(kb+d0*2048+512);
    if(d0==0){p0=__builtin_amdgcn_mfma_f32_32x32x16_bf16(b0,qr[0],f32x16{},0,0,0);p1=__builtin_amdgcn_mfma_f32_32x32x16_bf16(b1,qr[0],f32x16{},0,0,0);}
    else{p0=__builtin_amdgcn_mfma_f32_32x32x16_bf16(b0,qr[d0],p0,0,0,0);p1=__builtin_amdgcn_mfma_f32_32x32x16_bf16(b1,qr[d0],p1,0,0,0);}}
  p0=__builtin_amdgcn_mfma_f32_32x32x16_bf16(__builtin_bit_cast(bf16x8,kb0),qr4,p0,0,0,0);p1=__builtin_amdgcn_mfma_f32_32x32x16_bf16(__builtin_bit_cast(bf16x8,kb1),qr4,p1,0,0,0);
}
typedef __attribute__((address_space(3))) const char* lds_cptr;
typedef short v4i16_t __attribute__((ext_vector_type(4)));
__device__ __forceinline__ void kload8(bf16x8*kf,lds_cptr kp){
  kf[0]=*(const __attribute__((address_space(3))) bf16x8*)(kp);      kf[1]=*(const __attribute__((address_space(3))) bf16x8*)(kp+512);
  kf[2]=*(const __attribute__((address_space(3))) bf16x8*)(kp+2048); kf[3]=*(const __attribute__((address_space(3))) bf16x8*)(kp+2560);
  kf[4]=*(const __attribute__((address_space(3))) bf16x8*)(kp+4096); kf[5]=*(const __attribute__((address_space(3))) bf16x8*)(kp+4608);
  kf[6]=*(const __attribute__((address_space(3))) bf16x8*)(kp+6144); kf[7]=*(const __attribute__((address_space(3))) bf16x8*)(kp+6656);
}
__device__ __forceinline__ void kload2(bf16x8*kf,lds_cptr kp,int j){ kf[2*j]=*(const __attribute__((address_space(3))) bf16x8*)(kp+j*2048); kf[2*j+1]=*(const __attribute__((address_space(3))) bf16x8*)(kp+j*2048+512); }
__device__ __forceinline__ s16x4 vtr(lds_cptr p){ return __builtin_bit_cast(s16x4,__builtin_amdgcn_ds_read_tr16_b64_v4i16((__attribute__((address_space(3))) v4i16_t*)p)); }
__device__ __forceinline__ float rowmax(const f32x16&p0,const f32x16&p1){
  float a=max3f(p0[0],p0[1],p1[0]),b=max3f(p0[2],p0[3],p1[1]);a=max3f(a,p1[2],p1[3]);
  #pragma unroll
  for(int r=4;r<16;r+=4){a=max3f(a,p0[r],p0[r+1]);b=max3f(b,p0[r+2],p0[r+3]);a=max3f(a,p1[r],p1[r+1]);b=max3f(b,p1[r+2],p1[r+3]);}
  const float m=max2f(a,b);
  auto rr=__builtin_amdgcn_permlane32_swap(__float_as_uint(m),__float_as_uint(m),false,false);
  return max2f(__uint_as_float(rr[0]),__uint_as_float(rr[1]));
}
__device__ __forceinline__ void pv(f32x16*o,int vb,bf16x8 pa0,bf16x8 pa1,bf16x8 pa2,bf16x8 pa3){
  #pragma unroll
  for(int d0=0;d0<2;++d0){s16x4 lo[4],hi[4];
    #pragma unroll
    for(int ks=0;ks<4;++ks){
      asm volatile("ds_read_b64_tr_b16 %0,%1 offset:%c2":"=&v"(lo[ks]):"v"(vb),"i"(d0*4096+ks*1024):"memory");
      asm volatile("ds_read_b64_tr_b16 %0,%1 offset:%c2":"=&v"(hi[ks]):"v"(vb),"i"(d0*4096+ks*1024+512):"memory");}
    asm volatile("s_waitcnt lgkmcnt(0)":::"memory");SBAR();
    #define PK(k) (bf16x8){lo[k][0],lo[k][1],lo[k][2],lo[k][3],hi[k][0],hi[k][1],hi[k][2],hi[k][3]}
    o[d0]=__builtin_amdgcn_mfma_f32_32x32x16_bf16(pa0,PK(0),o[d0],0,0,0);
    o[d0]=__builtin_amdgcn_mfma_f32_32x32x16_bf16(pa1,PK(1),o[d0],0,0,0);
    o[d0]=__builtin_amdgcn_mfma_f32_32x32x16_bf16(pa2,PK(2),o[d0],0,0,0);
    o[d0]=__builtin_amdgcn_mfma_f32_32x32x16_bf16(pa3,PK(3),o[d0],0,0,0);
    #undef PK
  }
}
#define ATTN_STORE16(p,v) (*(u32x4*)(p)=(v))
template<int THRL> __device__ __forceinline__ void attn_unit(int b,int h,int qb,bf16_t*PJ,const float*LS,char*shm){
  int tid=threadIdx.x; asm volatile("":"+v"(tid));
  const int lane=tid&63,r32=lane&31,hi=lane>>5; const int wid=__builtin_amdgcn_readfirstlane(tid>>6);
  const long rowbase=(long)b*SEQ; const int q0=qb*QB;
  { float*cs=(float*)(shm+LDS_CB); float*wt=(float*)(shm+LDS_SCAN);
    const float*ls=LS+(size_t)rowbase*8+h;
    const float e0=ls[(4*tid+0)*8],e1=ls[(4*tid+1)*8],e2=ls[(4*tid+2)*8],e3=ls[(4*tid+3)*8];
    const float s=(e0+e1)+(e2+e3); float inc=s;
    #pragma unroll
    for(int o=1;o<64;o<<=1){const float n=__shfl_up(inc,o); if(lane>=o)inc+=n;}
    if(lane==63)wt[wid]=inc;
    __syncthreads();
    float base=0.f; for(int w=0;w<wid;++w)base+=wt[w];
    float c=base+inc-s; c+=e0; const float c0=c; c+=e1; const float c1=c; c+=e2; const float c2=c; c+=e3; const float c3=c;
    cs[4*tid+0]=c0;cs[4*tid+1]=c1;cs[4*tid+2]=c2;cs[4*tid+3]=c3;
    __syncthreads();
    const float cref=cs[q0+QB-1];
    __syncthreads();
    unsigned*cbw=(unsigned*)cs; const float cc[4]={c0,c1,c2,c3};
    #pragma unroll
    for(int e=0;e<4;++e){ const float bv=(cref-cc[e])*LOG2E; const unsigned bh=f2bf(bv); const float res=bv-__builtin_bit_cast(float,bh<<16); cbw[4*tid+e]=bh|(f2bf(res)<<16); }
    __syncthreads();
  }
  const bf16_t*Qw=PJ+(rowbase+q0+wid*QBLK)*PA+C_FQ+h*D;
  const bf16_t*Kh=PJ+rowbase*PA+C_FK+h*D,*Vh=PJ+rowbase*PA+C_FV+h*D;
  const unsigned lds0=(unsigned)(uintptr_t)shm;
  float*wsf=(float*)(shm+LDS_WS)+wid*64;
  const bf16_t*ksrc=Kh+(long)lane*PA+wid*8;
  const bf16_t*vsrc=Vh+(long)(16*(wid&3)+(lane>>2))*PA+(wid>>2)*32+(lane&3)*8;
  const unsigned kdst=lds0+LDS_K+wid*1024, vdst=lds0+LDS_V+wid*1024;
  #define DMA_K(t,slot) glds16(ksrc+(long)(t)*KVBLK*PA,(unsigned)__builtin_amdgcn_readfirstlane(kdst+(slot)))
  #define DMA_V(t,slot) glds16(vsrc+(long)(t)*KVBLK*PA,(unsigned)__builtin_amdgcn_readfirstlane(vdst+(slot)))
  const int vb0=(int)(lds0+LDS_V)+((lane>>4)&1)*32+(lane&3)*8+(4*hi+((lane&15)>>2))*64;
  const char*Kbase=shm+LDS_K; bf16x8 kf[8];
  const lds_cptr shm3=(lds_cptr)shm; const lds_cptr kp0=shm3+LDS_K+hi*1024+r32*16; const lds_cptr vp0=shm3+LDS_V+((lane>>4)&1)*32+(lane&3)*8+(4*hi+((lane&15)>>2))*64;
  const __attribute__((address_space(3))) unsigned* cbp=(const __attribute__((address_space(3))) unsigned*)(shm3+LDS_CB)+r32;
  const unsigned kone1=hi?0u:0x3F803F80u, kone2=hi?0u:0x00003F80u;
  u32x4 kbw=(u32x4){0u,kone1,kone2,0u};
  u32x4 q4w=(u32x4){kone1,0u,0u,0u};
  #define QR4 __builtin_bit_cast(bf16x8,q4w)
  #define SETM() do{ const float nm_=-mhat; const unsigned h1_=f2bf(nm_); const float r1_=nm_-__builtin_bit_cast(float,h1_<<16); const unsigned h2_=f2bf(r1_); const float r2_=r1_-__builtin_bit_cast(float,h2_<<16); \
      q4w[1]=hi?0u:(h1_|(h2_<<16)); q4w[2]=hi?0u:f2bf(r2_); }while(0)
  #define BW(t,half) (hi?0u:cbp[(t)*64+(half)*32])
  const int NT=(q0+QB)/KVBLK;
  DMA_K(0,0);DMA_V(0,0);DMA_K(1,SLOTB);
  bf16x8 qr[4];
  #pragma unroll
  for(int d0=0;d0<4;++d0)qr[d0]=*reinterpret_cast<const bf16x8*>(&Qw[(long)r32*PA+d0*16+hi*8]);
  float mhat=0.f,l_reg=0.f;f32x16 o[2];o[0]=f32x16{};o[1]=f32x16{};
  const int qrel=wid*QBLK+r32;
  #define CMASK(P0,P1,t) do{int jb_=(t)-(NT-4); if(jb_>=0)cmask(P0,P1,jb_,qrel,hi);}while(0)
  bool resc=false;
  #define START(P0,P1) do{ const float rm=rowmax(P0,P1); resc=false; \
    { const float dl=rm; mhat=fadd_s(mhat,dl); \
      _Pragma("unroll") for(int r=0;r<16;++r){P0[r]=fsub_s(P0[r],dl);P1[r]=fsub_s(P1[r],dl);} \
      SETM(); } \
    _Pragma("unroll") for(int r=0;r<16;++r)P0[r]=__builtin_amdgcn_exp2f(P0[r]); }while(0)
  #define RESC() do{ if(resc){ asm volatile("s_waitcnt lgkmcnt(0)":::"memory"); \
      _Pragma("unroll") for(int d_=0;d_<2;++d_) _Pragma("unroll") for(int r=0;r<16;++r)o[d_][r]*=wsf[crow(r,hi)]; } }while(0)
  f32x16 pA0,pA1,pB0,pB1;
  int sl_prev=0,sl_cur=0,sl_next=SLOTB;
  #define ROT() do{sl_prev=sl_cur;sl_cur=sl_next;sl_next=(sl_next==(NSLOT-1)*SLOTB)?0:sl_next+SLOTB;}while(0)
  DMA_K(2,2*SLOTB);
  WAIT_BAR(3);
  { const unsigned bw0=BW(0,0),bw1=BW(0,1);
    u32x4 k0_=kbw; k0_[0]=bw0; u32x4 k1_=kbw; k1_[0]=bw1; qkt(pA0,pA1,Kbase,qr,r32,hi,k0_,k1_,QR4);asm volatile("s_nop 15\n\ts_nop 7":"+v"(pA0),"+v"(pA1));CMASK(pA0,pA1,0); }
  START(pA0,pA1);
  _Pragma("unroll") for(int r=0;r<16;++r)pA1[r]=__builtin_amdgcn_exp2f(pA1[r]);
  WAIT_BAR(0);
  DMA_K(3,0);DMA_V(1,SLOTB);
  ROT();
  kload8(kf,kp0+sl_cur);
  WAIT_BAR(2);
  s16x4 vlo[8],vhi[8]; u32x4 pw0,pw1,pw2,pw3;
  #define PKW(P,B) cvtpk_s(P[B],P[B+1])
  #define PAF(k) __builtin_bit_cast(bf16x8,pw##k)
  #define VFR(i) (bf16x8){vlo[i][0],vlo[i][1],vlo[i][2],vlo[i][3],vhi[i][0],vhi[i][1],vhi[i][2],vhi[i][3]}
  #define PIN(x) asm volatile("":"+v"(x))
  #define MX3(a,b,c) __builtin_fmaxf(__builtin_fmaxf((a),(b)),(c))
  #define GAPA(MF,A0,A1,A2,A3,W0,W1,PW) do{ MF; sacc+=A0; sacc+=A1; sacc+=A2; sacc+=A3; PIN(sacc); W0; W1; PIN(PW); SBAR(); }while(0)
  #define EX(v) __builtin_amdgcn_exp2f(v)
  #define GAPB(MF,X,B) do{ MF; X[B]=EX(X[B]); X[B+1]=EX(X[B+1]); X[B+2]=EX(X[B+2]); X[B+3]=EX(X[B+3]); PIN(X); SBAR(); }while(0)
  #define VRD(i) do{ vlo[i]=vtr(vp_+(((i)>>2)*4096+((i)&3)*1024)); vhi[i]=vtr(vp_+(((i)>>2)*4096+((i)&3)*1024+512)); }while(0)
  #define KRD(G,j) do{ if(G){ kload2(kf,kp0+sl_next,j); SBAR(); } }while(0)
  #define STEP(C0,C1,P0,P1,t,GK,GV,GL) do{ SBAR(); \
    const lds_cptr vp_=vp0+sl_prev; const unsigned bw0_=BW(t,0),bw1_=BW(t,1); \
    VRD(0); SBAR(); float sacc=(P0[0]+P0[1]); \
    GAPA(C0=__builtin_amdgcn_mfma_f32_32x32x16_bf16(kf[0],qr[0],f32x16{},0,0,0), P0[2],P0[3],P0[4],P0[5],     pw0[0]=PKW(P0,0), pw0[1]=PKW(P0,2), pw0); \
    VRD(4); SBAR(); GAPA(C1=__builtin_amdgcn_mfma_f32_32x32x16_bf16(kf[1],qr[0],f32x16{},0,0,0), P0[6],P0[7],P0[8],P0[9],     pw0[2]=PKW(P0,4), pw0[3]=PKW(P0,6), pw0); \
    VRD(1); SBAR(); GAPA(C0=__builtin_amdgcn_mfma_f32_32x32x16_bf16(kf[2],qr[1],C0,0,0,0),   P0[10],P0[11],P0[12],P0[13], pw1[0]=PKW(P0,8), pw1[1]=PKW(P0,10), pw1); \
    VRD(5); SBAR(); GAPA(C1=__builtin_amdgcn_mfma_f32_32x32x16_bf16(kf[3],qr[1],C1,0,0,0),   P0[14],P0[15],P1[0],P1[1],   pw1[2]=PKW(P0,12),pw1[3]=PKW(P0,14), pw1); \
    VRD(2); SBAR(); GAPA(C0=__builtin_amdgcn_mfma_f32_32x32x16_bf16(kf[4],qr[2],C0,0,0,0),   P1[2],P1[3],P1[4],P1[5],     pw2[0]=PKW(P1,0), pw2[1]=PKW(P1,2), pw2); \
    VRD(6); SBAR(); GAPA(C1=__builtin_amdgcn_mfma_f32_32x32x16_bf16(kf[5],qr[2],C1,0,0,0),   P1[6],P1[7],P1[8],P1[9],     pw2[2]=PKW(P1,4), pw2[3]=PKW(P1,6), pw2); \
    VRD(3); SBAR(); GAPA(C0=__builtin_amdgcn_mfma_f32_32x32x16_bf16(kf[6],qr[3],C0,0,0,0),   P1[10],P1[11],P1[12],P1[13], pw3[0]=PKW(P1,8), pw3[1]=PKW(P1,10), pw3); \
    VRD(7); SBAR(); GAPA(C1=__builtin_amdgcn_mfma_f32_32x32x16_bf16(kf[7],qr[3],C1,0,0,0),   P1[14],P1[15],0.f,0.f,       pw3[2]=PKW(P1,12),pw3[3]=PKW(P1,14), pw3); \
    C0=__builtin_amdgcn_mfma_f32_32x32x16_bf16(__builtin_bit_cast(bf16x8,KBF(bw0_)),QR4,C0,0,0,0); C1=__builtin_amdgcn_mfma_f32_32x32x16_bf16(__builtin_bit_cast(bf16x8,KBF(bw1_)),QR4,C1,0,0,0); SBAR(); \
    l_reg+=sacc; \
    if(GK){DMA_K((t)+3,sl_cur);} if(GV){DMA_V((t)+1,sl_next);} \
    CMASK(C0,C1,t); \
    { float a=MX3(C0[0],C0[1],C1[0]),b=MX3(C0[2],C0[3],C1[1]); a=MX3(a,C1[2],C1[3]); \
      _Pragma("unroll") for(int r=4;r<16;r+=4){a=MX3(a,C0[r],C0[r+1]);b=MX3(b,C0[r+2],C0[r+3]);a=MX3(a,C1[r],C1[r+1]);b=MX3(b,C1[r+2],C1[r+3]);} \
      float rm=__builtin_fmaxf(a,b); { auto rr=__builtin_amdgcn_permlane32_swap(__float_as_uint(rm),__float_as_uint(rm),false,false); rm=__builtin_fmaxf(__uint_as_float(rr[0]),__uint_as_float(rr[1])); } \
      resc=false; \
      if(__builtin_expect(__any(rm>(float)THRL),0)){ const float dl=__builtin_fmaxf(rm,0.f); mhat+=dl; \
        _Pragma("unroll") for(int r=0;r<16;++r){C0[r]-=dl;C1[r]-=dl;} \
        SETM(); \
        const float f=__builtin_amdgcn_exp2f(-dl); l_reg*=f; if(hi==0)wsf[r32]=f; resc=true; } } \
    SBAR(); \
    GAPB(o[0]=__builtin_amdgcn_mfma_f32_32x32x16_bf16(PAF(0),VFR(0),o[0],0,0,0), C0,0); \
    GAPB(o[1]=__builtin_amdgcn_mfma_f32_32x32x16_bf16(PAF(0),VFR(4),o[1],0,0,0), C0,4); \
    KRD(GL,0); GAPB(o[0]=__builtin_amdgcn_mfma_f32_32x32x16_bf16(PAF(1),VFR(1),o[0],0,0,0), C0,8); \
    KRD(GL,1); GAPB(o[1]=__builtin_amdgcn_mfma_f32_32x32x16_bf16(PAF(1),VFR(5),o[1],0,0,0), C0,12); \
    KRD(GL,2); GAPB(o[0]=__builtin_amdgcn_mfma_f32_32x32x16_bf16(PAF(2),VFR(2),o[0],0,0,0), C1,0); \
    KRD(GL,3); GAPB(o[1]=__builtin_amdgcn_mfma_f32_32x32x16_bf16(PAF(2),VFR(6),o[1],0,0,0), C1,4); \
    GAPB(o[0]=__builtin_amdgcn_mfma_f32_32x32x16_bf16(PAF(3),VFR(3),o[0],0,0,0), C1,8); \
    GAPB(o[1]=__builtin_amdgcn_mfma_f32_32x32x16_bf16(PAF(3),VFR(7),o[1],0,0,0), C1,12); \
    }while(0)
  int t=1;
  #undef CMASK
  #define CMASK(P0,P1,t) do{}while(0)
  for(;t+5<NT;t+=2){
    STEP(pB0,pB1,pA0,pA1,t,true,true,true);     WAIT_BAR(2); RESC(); ROT();
    STEP(pA0,pA1,pB0,pB1,t+1,true,true,true);   WAIT_BAR(2); RESC(); ROT();
  }
  #undef CMASK
  #define CMASK(P0,P1,t) do{int jb_=(t)-(NT-4); if(jb_>=0)cmask(P0,P1,jb_,qrel,hi);}while(0)
  #define ENDW(tt) do{ if((tt)+3<NT){WAIT_BAR(2);} else if((tt)+2<NT){WAIT_BAR(1);} else {WAIT_BAR(0);} }while(0)
  for(;t+1<NT;t+=2){
    STEP(pB0,pB1,pA0,pA1,t,(t+3<NT),(t+1<NT),(t+1<NT));       ENDW(t);   RESC(); ROT();
    STEP(pA0,pA1,pB0,pB1,t+1,(t+4<NT),(t+2<NT),(t+2<NT));     ENDW(t+1); RESC(); ROT();
  }
  STEP(pB0,pB1,pA0,pA1,NT-1,false,false,false); RESC();
  { float sacc=pB0[0]+pB0[1]; _Pragma("unroll") for(int r=2;r<16;++r)sacc+=pB0[r]; _Pragma("unroll") for(int r=0;r<16;++r)sacc+=pB1[r]; l_reg+=sacc;
    pw0=(u32x4){PKW(pB0,0),PKW(pB0,2),PKW(pB0,4),PKW(pB0,6)};pw1=(u32x4){PKW(pB0,8),PKW(pB0,10),PKW(pB0,12),PKW(pB0,14)};pw2=(u32x4){PKW(pB1,0),PKW(pB1,2),PKW(pB1,4),PKW(pB1,6)};pw3=(u32x4){PKW(pB1,8),PKW(pB1,10),PKW(pB1,12),PKW(pB1,14)};
    SBAR(); pv(o,vb0+sl_cur,PAF(0),PAF(1),PAF(2),PAF(3)); }
  #undef PKW
  #undef PAF
  #undef VFR
  #undef PIN
  #undef MX3
  #undef GAPA
  #undef GAPB
  #undef EX
  #undef VRD
  #undef KRD
  #undef STEP
  #undef ENDW
  {auto rr=__builtin_amdgcn_permlane32_swap(__float_as_uint(l_reg),__float_as_uint(l_reg),false,false);l_reg=__uint_as_float(rr[0])+__uint_as_float(rr[1]);}
  if(hi==0)wsf[32+r32]=l_reg;asm volatile("s_waitcnt lgkmcnt(0)":::"memory");
  float rli[16];
  #pragma unroll
  for(int r=0;r<16;++r)rli[r]=__builtin_amdgcn_rcpf(wsf[32+crow(r,hi)]);
  bf16_t*Ow=PJ+(rowbase+q0+wid*QBLK)*PA+C_FQ+h*D;
  { bf16_t*stg=(bf16_t*)(shm+LDS_OST)+wid*2048;
    #pragma unroll
    for(int r=0;r<16;++r){const int orow=crow(r,hi);
      #pragma unroll
      for(int d0=0;d0<2;++d0)stg[orow*64+d0*32+r32]=(bf16_t)f2bf(o[d0][r]*rli[r]);}
    asm volatile("s_waitcnt lgkmcnt(0)":::"memory");
    #pragma unroll
    for(int i=0;i<4;++i){const int row=i*8+(lane>>3),ch=lane&7; const u32x4 v=*(const u32x4*)(stg+row*64+ch*8); ATTN_STORE16(Ow+(long)row*PA+ch*8,v);} }
  asm volatile("s_waitcnt lgkmcnt(0)\n\ts_barrier":::"memory");
  #undef DMA_K
  #undef DMA_V
  #undef CMASK
  #undef START
  #undef RESC
  #undef ROT
  #undef BW
  #undef QR4
  #undef SETM
}
#undef SBAR
#undef WAIT_BAR
#undef KBF
}

__device__ __forceinline__ void mem_simple_unit(Frame& F, int b, int hd, int qb) {
    const int tid = F.tid;
    LAS bf16_t* Kt = (LAS bf16_t*)(F.lds);
    LAS bf16_t* Vt = (LAS bf16_t*)(F.lds + 16384);
    const bf16_t* PJ = (const bf16_t*)(F.ws + WS_PROJA); const bf16_t* KV = (const bf16_t*)(F.ws + WS_MEMKV);
    const int q = qb * 256 + (tid >> 1), half = tid & 1; const size_t row = (size_t)b * SEQ + q;
    float qf[64], o[64];
#pragma unroll
    for (int c = 0; c < 8; ++c) { const u32x4 w = *(const u32x4*)(PJ + row * PA + C_MQ + hd * 128 + half * 64 + c * 8);
        qf[8 * c + 0] = bflo(w.x); qf[8 * c + 1] = bfhi(w.x); qf[8 * c + 2] = bflo(w.y); qf[8 * c + 3] = bfhi(w.y); qf[8 * c + 4] = bflo(w.z); qf[8 * c + 5] = bfhi(w.z); qf[8 * c + 6] = bflo(w.w); qf[8 * c + 7] = bfhi(w.w); }
#pragma unroll
    for (int d = 0; d < 64; ++d) o[d] = 0.f;
    float mrun = -1e30f, l = 0.f;
    for (int kt = 0; kt < 4; ++kt) {
        __syncthreads();
#pragma unroll
        for (int i = 0; i < 2; ++i) { const int idx = tid + 512 * i, r = idx >> 4, ch = idx & 15;
            const size_t krow = (size_t)b * MEMLEN + kt * 64 + r;
            *(LAS u32x4*)(Kt + r * 128 + ch * 8) = *(const u32x4*)(KV + krow * 1024 + hd * 128 + ch * 8);
            *(LAS u32x4*)(Vt + r * 128 + ch * 8) = *(const u32x4*)(KV + krow * 1024 + 512 + hd * 128 + ch * 8); }
        __syncthreads();
#pragma unroll 1
        for (int kk = 0; kk < 64; ++kk) {
            float s0 = 0.f, s1 = 0.f;
#pragma unroll
            for (int c = 0; c < 8; ++c) { const u32x4 w = *(const LAS u32x4*)(Kt + kk * 128 + half * 64 + c * 8);
                s0 += qf[8 * c + 0] * bflo(w.x) + qf[8 * c + 2] * bflo(w.y) + qf[8 * c + 4] * bflo(w.z) + qf[8 * c + 6] * bflo(w.w);
                s1 += qf[8 * c + 1] * bfhi(w.x) + qf[8 * c + 3] * bfhi(w.y) + qf[8 * c + 5] * bfhi(w.z) + qf[8 * c + 7] * bfhi(w.w); }
            float s = s0 + s1; s += __shfl_xor(s, 1);
            const float mn = fmaxf(mrun, s); const float al = __builtin_amdgcn_exp2f(mrun - mn); const float p = __builtin_amdgcn_exp2f(s - mn);
            l = l * al + p; mrun = mn;
#pragma unroll
            for (int c = 0; c < 8; ++c) { const u32x4 w = *(const LAS u32x4*)(Vt + kk * 128 + half * 64 + c * 8);
                o[8 * c + 0] = o[8 * c + 0] * al + p * bflo(w.x); o[8 * c + 1] = o[8 * c + 1] * al + p * bfhi(w.x); o[8 * c + 2] = o[8 * c + 2] * al + p * bflo(w.y); o[8 * c + 3] = o[8 * c + 3] * al + p * bfhi(w.y);
                o[8 * c + 4] = o[8 * c + 4] * al + p * bflo(w.z); o[8 * c + 5] = o[8 * c + 5] * al + p * bfhi(w.z); o[8 * c + 6] = o[8 * c + 6] * al + p * bflo(w.w); o[8 * c + 7] = o[8 * c + 7] * al + p * bfhi(w.w); }
        }
    }
    const float rl = 1.0f / l;
    bf16_t* op = (bf16_t*)(F.ws + WS_PROJA) + row * PA + C_MQ + hd * 128 + half * 64;
#pragma unroll
    for (int c = 0; c < 8; ++c) { u32x4 w; w.x = pk2(o[8 * c + 0] * rl, o[8 * c + 1] * rl); w.y = pk2(o[8 * c + 2] * rl, o[8 * c + 3] * rl); w.z = pk2(o[8 * c + 4] * rl, o[8 * c + 5] * rl); w.w = pk2(o[8 * c + 6] * rl, o[8 * c + 7] * rl);
        *(u32x4*)(op + c * 8) = w; }
    __syncthreads();
}

__device__ __forceinline__ void unpack8(const u32x4 w, float (&f)[8]) { f[0] = bflo(w.x); f[1] = bfhi(w.x); f[2] = bflo(w.y); f[3] = bfhi(w.y); f[4] = bflo(w.z); f[5] = bfhi(w.z); f[6] = bflo(w.w); f[7] = bfhi(w.w); }
__device__ __forceinline__ void rwkv_simple_unit(Frame& F, int b, int h) {
    const int tid = F.tid;
    LAS float* Rr = (LAS float*)(F.lds + 0 * 16384); LAS float* Ww = (LAS float*)(F.lds + 1 * 16384); LAS float* Kk = (LAS float*)(F.lds + 2 * 16384); LAS float* Vv = (LAS float*)(F.lds + 3 * 16384);
    LAS float* Aa = (LAS float*)(F.lds + 4 * 16384); LAS float* Bb = (LAS float*)(F.lds + 5 * 16384); LAS float* Gg = (LAS float*)(F.lds + 6 * 16384); LAS float* Yy = (LAS float*)(F.lds + 7 * 16384);
    LAS float* T1 = Ww; LAS float* T2 = Aa; LAS float* T3 = Bb;
    LAS float* prevr = (LAS float*)(F.lds + EXTRA_OFF);
    bf16_t* PJ = (bf16_t*)(F.ws + WS_PROJA);
    const float* mu = F.in[I_MU]; const float* w0 = F.in[I_W0]; const float* wup = F.in[I_WUP]; const float* a0 = F.in[I_A0]; const float* aup = F.in[I_AUP]; const float* gup = F.in[I_GUP];
    const float* kkp = F.in[I_KK]; const float* kap = F.in[I_KA]; const float* rkp = F.in[I_RK]; const float* gng = F.in[I_GNG]; const float* gnb = F.in[I_GNB];
    const int t = tid >> 3, cg = tid & 7, c0 = 8 * cg, hc = h * 64 + c0;
    float St[8];
#pragma unroll
    for (int e = 0; e < 8; ++e) St[e] = 0.f;
    __syncthreads();
#pragma unroll 1
    for (int bt = 0; bt < SEQ / 64; ++bt) {
        const int tt0 = bt * 64; const size_t row = (size_t)b * SEQ + tt0 + t; const bool has_prev = (tt0 + t) > 0;
        float rs[8], ks[8], vs[8];
        {
            float cur[8], prv[8];
            const bf16_t* rp = PJ + row * PA; const bf16_t* pp = rp - PA;
            unpack8(*(const u32x4*)(rp + C_RR + hc), cur);
            if (t == 63) {
#pragma unroll
                for (int e = 0; e < 8; ++e) prevr[((bt + 1) & 1) * 64 + c0 + e] = cur[e]; }
            if (t > 0) unpack8(*(const u32x4*)(pp + C_RR + hc), prv);
            else {
#pragma unroll
                for (int e = 0; e < 8; ++e) prv[e] = (bt > 0) ? prevr[(bt & 1) * 64 + c0 + e] : 0.f; }
#pragma unroll
            for (int e = 0; e < 8; ++e) rs[e] = cur[e] + (prv[e] - cur[e]) * mu[hc + e];
            unpack8(*(const u32x4*)(rp + C_RK + hc), cur);
            if (has_prev) unpack8(*(const u32x4*)(pp + C_RK + hc), prv); else {
#pragma unroll
                for (int e = 0; e < 8; ++e) prv[e] = 0.f; }
#pragma unroll
            for (int e = 0; e < 8; ++e) ks[e] = cur[e] + (prv[e] - cur[e]) * mu[512 + hc + e];
            unpack8(*(const u32x4*)(rp + C_RV + hc), cur);
            if (has_prev) unpack8(*(const u32x4*)(pp + C_RV + hc), prv); else {
#pragma unroll
                for (int e = 0; e < 8; ++e) prv[e] = 0.f; }
#pragma unroll
            for (int e = 0; e < 8; ++e) vs[e] = cur[e] + (prv[e] - cur[e]) * mu[1024 + hc + e];
            unpack8(*(const u32x4*)(rp + C_WD + c0), cur);
            if (has_prev) unpack8(*(const u32x4*)(pp + C_WD + c0), prv); else {
#pragma unroll
                for (int e = 0; e < 8; ++e) prv[e] = 0.f; }
#pragma unroll
            for (int e = 0; e < 8; ++e) { const float x = cur[e] + (prv[e] - cur[e]) * mu[1536 + c0 + e]; T1[t * 64 + c0 + e] = 1.0f - 2.0f / (1.0f + __expf(2.0f * x)); }
            unpack8(*(const u32x4*)(rp + C_AD + c0), cur);
            if (has_prev) unpack8(*(const u32x4*)(pp + C_AD + c0), prv); else {
#pragma unroll
                for (int e = 0; e < 8; ++e) prv[e] = 0.f; }
#pragma unroll
            for (int e = 0; e < 8; ++e) T2[t * 64 + c0 + e] = cur[e] + (prv[e] - cur[e]) * mu[1600 + c0 + e];
#pragma unroll
            for (int hh = 0; hh < 2; ++hh) {
                unpack8(*(const u32x4*)(rp + C_GD + 16 * cg + 8 * hh), cur);
                if (has_prev) unpack8(*(const u32x4*)(pp + C_GD + 16 * cg + 8 * hh), prv); else {
#pragma unroll
                    for (int e = 0; e < 8; ++e) prv[e] = 0.f; }
#pragma unroll
                for (int e = 0; e < 8; ++e) { const float x = cur[e] + (prv[e] - cur[e]) * mu[1664 + 16 * cg + 8 * hh + e]; T3[t * 128 + 16 * cg + 8 * hh + e] = sigm(x); }
            }
#pragma unroll
            for (int e = 0; e < 8; ++e) { Rr[t * 64 + c0 + e] = rs[e]; Vv[t * 64 + c0 + e] = vs[e]; }
        }
        __syncthreads();
        float zw[8], za[8], gg[8];
        {
#pragma unroll
            for (int e = 0; e < 8; ++e) { zw[e] = w0[hc + e]; za[e] = a0[hc + e]; gg[e] = 0.f; }
#pragma unroll 4
            for (int i = 0; i < 64; ++i) { const float x1 = T1[t * 64 + i], x2 = T2[t * 64 + i];
                const f32x4 wa = *(const f32x4*)(wup + (size_t)i * 512 + hc), wb = *(const f32x4*)(wup + (size_t)i * 512 + hc + 4);
                const f32x4 aa = *(const f32x4*)(aup + (size_t)i * 512 + hc), ab = *(const f32x4*)(aup + (size_t)i * 512 + hc + 4);
#pragma unroll
                for (int e = 0; e < 4; ++e) { zw[e] += x1 * wa[e]; zw[4 + e] += x1 * wb[e]; za[e] += x2 * aa[e]; za[4 + e] += x2 * ab[e]; } }
#pragma unroll 4
            for (int i = 0; i < 128; ++i) { const float x3 = T3[t * 128 + i];
                const f32x4 ga = *(const f32x4*)(gup + (size_t)i * 512 + hc), gb = *(const f32x4*)(gup + (size_t)i * 512 + hc + 4);
#pragma unroll
                for (int e = 0; e < 4; ++e) { gg[e] += x3 * ga[e]; gg[4 + e] += x3 * gb[e]; } }
        }
        __syncthreads();
        {
            float kk[8], ss = 0.f;
#pragma unroll
            for (int e = 0; e < 8; ++e) { kk[e] = ks[e] * kkp[hc + e]; ss += kk[e] * kk[e]; }
            ss += __shfl_xor(ss, 1); ss += __shfl_xor(ss, 2); ss += __shfl_xor(ss, 4);
            const float rn = 1.0f / sqrtf(fmaxf(ss, 1e-24f));
#pragma unroll
            for (int e = 0; e < 8; ++e) { const float a = sigm(za[e]); const float w = __expf(-0.6065306597126334f * sigm(zw[e])); const float kn = kk[e] * rn;
                Ww[t * 64 + c0 + e] = w; Kk[t * 64 + c0 + e] = ks[e] * (1.0f + (a - 1.0f) * kap[hc + e]); Aa[t * 64 + c0 + e] = -kn; Bb[t * 64 + c0 + e] = kn * a; Gg[t * 64 + c0 + e] = gg[e]; }
        }
        __syncthreads();
        {
#pragma unroll 1
            for (int tt = 0; tt < 64; ++tt) {
                const f32x4 a0v = *(const LAS f32x4*)(Aa + tt * 64 + c0), a1v = *(const LAS f32x4*)(Aa + tt * 64 + c0 + 4);
                float sa = St[0] * a0v[0] + St[1] * a0v[1] + St[2] * a0v[2] + St[3] * a0v[3] + St[4] * a1v[0] + St[5] * a1v[1] + St[6] * a1v[2] + St[7] * a1v[3];
                sa += __shfl_xor(sa, 1); sa += __shfl_xor(sa, 2); sa += __shfl_xor(sa, 4);
                const f32x4 w0v = *(const LAS f32x4*)(Ww + tt * 64 + c0), w1v = *(const LAS f32x4*)(Ww + tt * 64 + c0 + 4);
                const f32x4 b0v = *(const LAS f32x4*)(Bb + tt * 64 + c0), b1v = *(const LAS f32x4*)(Bb + tt * 64 + c0 + 4);
                const f32x4 k0v = *(const LAS f32x4*)(Kk + tt * 64 + c0), k1v = *(const LAS f32x4*)(Kk + tt * 64 + c0 + 4);
                const f32x4 r0v = *(const LAS f32x4*)(Rr + tt * 64 + c0), r1v = *(const LAS f32x4*)(Rr + tt * 64 + c0 + 4);
                const float vi = Vv[tt * 64 + t];
                float y = 0.f;
#pragma unroll
                for (int e = 0; e < 4; ++e) { St[e] = St[e] * w0v[e] + sa * b0v[e] + vi * k0v[e]; St[4 + e] = St[4 + e] * w1v[e] + sa * b1v[e] + vi * k1v[e]; y += St[e] * r0v[e] + St[4 + e] * r1v[e]; }
                y += __shfl_xor(y, 1); y += __shfl_xor(y, 2); y += __shfl_xor(y, 4);
                if (cg == 0) Yy[tt * 64 + t] = y;
            }
        }
        __syncthreads();
        {
            float y[8], s = 0.f, sb = 0.f;
#pragma unroll
            for (int e = 0; e < 8; ++e) { y[e] = Yy[t * 64 + c0 + e]; s += y[e]; sb += Rr[t * 64 + c0 + e] * Kk[t * 64 + c0 + e] * rkp[hc + e]; }
            s += __shfl_xor(s, 1); s += __shfl_xor(s, 2); s += __shfl_xor(s, 4);
            sb += __shfl_xor(sb, 1); sb += __shfl_xor(sb, 2); sb += __shfl_xor(sb, 4);
            const float mean = s * (1.0f / 64.0f); float var = 0.f;
#pragma unroll
            for (int e = 0; e < 8; ++e) { y[e] -= mean; var += y[e] * y[e]; }
            var += __shfl_xor(var, 1); var += __shfl_xor(var, 2); var += __shfl_xor(var, 4);
            const float rstd = 1.0f / sqrtf(var * (1.0f / 64.0f) + GN_EPS);
            float ov[8];
#pragma unroll
            for (int e = 0; e < 8; ++e) ov[e] = (y[e] * rstd * gng[hc + e] + gnb[hc + e] + sb * Vv[t * 64 + c0 + e]) * Gg[t * 64 + c0 + e];
            u32x4 w; w.x = pk2(ov[0], ov[1]); w.y = pk2(ov[2], ov[3]); w.z = pk2(ov[4], ov[5]); w.w = pk2(ov[6], ov[7]);
            *(u32x4*)(PJ + row * PA + C_RR + hc) = w;
        }
        __syncthreads();
    }
}

struct SchedInProj {
    int G, c; const char* A; const char* B;
    __device__ __forceinline__ bool next(int i, pg8::Unit& u) const {
        const int L = i * G + c; const size_t ts = (size_t)256 * 1024 * 2;
        if (L < 3456) { pg8::tile_of(L, 128, 27, u.pm, u.pn); u.tag = 0; }
        else if (L < 3456 + 64) { const int j = L - 3456; u.pm = 128 + (j & 15); u.pn = 27 + (j >> 4); u.tag = 1; }
        else return false;
        u.a = A + (size_t)u.pm * ts; u.b = B + (size_t)u.pn * ts; return true;
    }
};
struct SchedMerge {
    int G, c; const char* A; const char* B;
    __device__ __forceinline__ bool next(int i, pg8::Unit& u) const {
        const int br = i % 3, L = (i / 3) * G + c; if (L >= 512) return false;
        pg8::tile_of(L, 128, 4, u.pm, u.pn); u.tag = br;
        const int coff = (br == 0) ? C_FQ : ((br == 1) ? C_RR : C_MQ);
        u.a = A + ((size_t)u.pm * 256 * PA + coff) * 2; u.b = B + ((size_t)(br * 1024 + u.pn * 256) * 512) * 2; return true;
    }
};
struct SchedPlain {
    int G, c, nM, nN; const char* A; const char* B; size_t tsA, tsB;
    __device__ __forceinline__ bool next(int i, pg8::Unit& u) const {
        const int L = i * G + c; if (L >= nM * nN) return false;
        pg8::tile_of(L, nM, nN, u.pm, u.pn); u.tag = 0; u.a = A + (size_t)u.pm * tsA; u.b = B + (size_t)u.pn * tsB; return true;
    }
};

constexpr int N_PHASES = 9;
struct Args { const float* in[28]; float* out; unsigned char* ws; int ph_lo, ph_hi, li, pad; };
__global__ void __launch_bounds__(NWAVES * 64, 2) hyb_fwd(Args args) {
    extern __shared__ __attribute__((aligned(16))) unsigned char lds[];
    Frame F;
    F.lds = (LAS unsigned char*)lds;
    F.MISC = (volatile LAS unsigned*)(F.lds + MISC_OFF);
    F.tid = threadIdx.x; F.lane = F.tid & 63; F.wave = __builtin_amdgcn_readfirstlane(F.tid >> 6);
    F.G = gridDim.x; { const int bx = blockIdx.x; F.vcu = (F.G % 8 == 0) ? (bx % 8) * (F.G / 8) + bx / 8 : bx; }
    F.ws = args.ws; F.out = args.out; F.ctl = (gu32*)(args.ws + WS_CTL);
#pragma unroll
    for (int i = 0; i < 28; ++i) F.in[i] = args.in[i];
    for (int u = F.tid; u < (LDS_BYTES - LDSCTL_OFF) / 4; u += NWAVES * 64) ((LAS unsigned*)(F.lds + LDSCTL_OFF))[u] = 0u;
    __syncthreads();
    XcdBarrier bar; bar.bar = (unsigned*)(F.ctl + CW_BAR); bar.x = 0; bar.st = nullptr;
    if (MK_N_LAUNCHES == 1) bar = xcd_barrier_post((unsigned*)(F.ctl + CW_BAR), F.MISC + 8);
    const int lo = args.ph_lo, hi = args.ph_hi;
#define IN(k) (lo <= (k) && (k) < hi)
#define SEAM(k) do { if (IN(k) && IN((k) + 1)) xcd_barrier(bar); } while (0)
    unsigned char* ws = args.ws;

    if (IN(0)) { p0_prologue(F); SEAM(0); }

    if (IN(1)) {
        pg8::Gemm g{1024, 1024, 1024};
        SchedInProj S{F.G, (int)blockIdx.x, (const char*)(ws + WS_XNALL), (const char*)(ws + WS_WALL)};
        pg8::EpiInProj E{(bf16_t*)(ws + WS_PROJA), (bf16_t*)(ws + WS_G01), (bf16_t*)args.out, (bf16_t*)(ws + WS_MEMKV)};
        pg8::gemm_phase<pg8::EpiInProj, SchedInProj, true, true>(F.lds + RING_OFF, g, S, E);
        SEAM(1);
    }

    if (IN(2)) {
        for (int u = blockIdx.x; u < 128; u += F.G) rwkv_simple_unit(F, u >> 3, u & 7);
        __syncthreads();
        for (int p = F.vcu; p < 512; p += F.G) {
            const int bh = p >> 2, sidx = p & 3;
            fox::attn_unit<8>(bh >> 3, bh & 7, 7 - sidx, (bf16_t*)(ws + WS_PROJA), (const float*)(ws + WS_LS), (char*)lds + RING_OFF);
            fox::attn_unit<8>(bh >> 3, bh & 7, sidx, (bf16_t*)(ws + WS_PROJA), (const float*)(ws + WS_LS), (char*)lds + RING_OFF);
        }
        __syncthreads();
        for (int u = blockIdx.x; u < 512; u += F.G) mem_simple_unit(F, u >> 5, (u >> 3) & 3, u & 7);
        SEAM(2);
    }

    if (IN(3)) {
        pg8::Gemm g{512, PA, 512};
        SchedMerge S{F.G, (int)blockIdx.x, (const char*)(ws + WS_PROJA), (const char*)(ws + WS_WBR)};
        pg8::EpiMerge E{(const bf16_t*)(ws + WS_G01), (const bf16_t*)args.out, (bf16_t*)(ws + WS_MERGED)};
        pg8::gemm_phase<pg8::EpiMerge, SchedMerge, true, true>(F.lds + RING_OFF, g, S, E);
        SEAM(3);
    }

    if (IN(4)) {
        pg8::Gemm g{1024, 1024, 1024};
        SchedPlain S{F.G, (int)blockIdx.x, 128, 4, (const char*)(ws + WS_MERGED), (const char*)(ws + WS_WO), (size_t)256 * 1024 * 2, (size_t)256 * 1024 * 2};
        pg8::EpiPlain E{(bf16_t*)(ws + WS_Y), 1024};
        pg8::gemm_phase<pg8::EpiPlain, SchedPlain, true, true>(F.lds + RING_OFF, g, S, E);
        SEAM(4);
    }

    if (IN(5)) { p3c_rows(F); SEAM(5); }

    if (IN(6)) {
        pg8::Gemm g{1024, 1024, 1024};
        SchedPlain S{F.G, (int)blockIdx.x, 128, 22, (const char*)(ws + WS_U2), (const char*)(ws + WS_WGU), (size_t)256 * 1024 * 2, (size_t)256 * 1024 * 2};
        pg8::EpiSwiGLU E{(bf16_t*)(ws + WS_HID)};
        pg8::gemm_phase<pg8::EpiSwiGLU, SchedPlain, true, true>(F.lds + RING_OFF, g, S, E);
        SEAM(6);
    }

    if (IN(7)) {
        pg8::Gemm g{DFF, DFF, DFF};
        SchedPlain S{F.G, (int)blockIdx.x, 128, 4, (const char*)(ws + WS_HID), (const char*)(ws + WS_WDN), (size_t)256 * DFF * 2, (size_t)256 * DFF * 2};
        pg8::EpiPlain E{(bf16_t*)(ws + WS_FO), 1024};
        pg8::gemm_phase<pg8::EpiPlain, SchedPlain, true, true>(F.lds + RING_OFF, g, S, E);
        SEAM(7);
    }

    if (IN(8)) { p5c_rows(F); }
#undef IN
#undef SEAM
}

extern "C" void kernel_launch(void* const* d_in, const int* in_sizes, int n_in, void* d_out, int out_size, void* d_ws, size_t ws_size, hipStream_t stream) {
    static int grid = 0;
    if (grid == 0) {
        if (n_in != 28 || in_sizes[0] != M * DM || out_size != M * DM || ws_size < WS_END) { fprintf(stderr, "kernel_launch: unexpected shapes (n_in %d, in0 %d, out %d, ws %zu)\n", n_in, n_in > 0 ? in_sizes[0] : -1, out_size, ws_size); grid = -1; return; }
        int dev = 0, cus = 0, per_cu = 0;
        if (hipGetDevice(&dev) != hipSuccess || hipDeviceGetAttribute(&cus, hipDeviceAttributeMultiprocessorCount, dev) != hipSuccess) { grid = -1; return; }
        if (hipFuncSetAttribute((const void*)hyb_fwd, hipFuncAttributeMaxDynamicSharedMemorySize, LDS_BYTES) != hipSuccess) { fprintf(stderr, "kernel_launch: hipFuncSetAttribute failed\n"); grid = -1; return; }
        if (hipOccupancyMaxActiveBlocksPerMultiprocessor(&per_cu, (const void*)hyb_fwd, NWAVES * 64, LDS_BYTES) != hipSuccess || per_cu < 1) { fprintf(stderr, "kernel_launch: occupancy query says %d blocks per CU\n", per_cu); (void)hipGetLastError(); grid = -1; return; }
        grid = cus;
    }
    if (grid < 0) return;
    if (hipMemsetAsync((char*)d_ws + WS_CTL, 0, CTL_ZERO_BYTES, stream) != hipSuccess) return;
    Args a{};
    for (int i = 0; i < 28; ++i) a.in[i] = (const float*)d_in[i];
    a.out = (float*)d_out; a.ws = (unsigned char*)d_ws;
    if (MK_N_LAUNCHES == 1) { a.ph_lo = 0; a.ph_hi = N_PHASES; a.li = 0; hipLaunchKernelGGL(hyb_fwd, dim3(grid), dim3(NWAVES * 64), LDS_BYTES, stream, a); }
    else for (int li = 0; li < N_PHASES; ++li) { a.ph_lo = li; a.ph_hi = li + 1; a.li = li; hipLaunchKernelGGL(hyb_fwd, dim3(grid), dim3(NWAVES * 64), LDS_BYTES, stream, a); }
}
```

```cpp
#include <hip/hip_runtime.h>
#include <cstdio>
#include <cstdint>

#ifndef MK_N_LAUNCHES
#define MK_N_LAUNCHES 1
#endif

#define LAS __attribute__((address_space(3)))
#define GAS __attribute__((address_space(1)))
typedef unsigned short bf16_t;
typedef short bf16x8 __attribute__((ext_vector_type(8)));
typedef float f32x4 __attribute__((ext_vector_type(4)));
typedef float f32x2 __attribute__((ext_vector_type(2)));
typedef unsigned u32x4 __attribute__((ext_vector_type(4)));
typedef unsigned u32x2 __attribute__((ext_vector_type(2)));

constexpr int BATCH = 16, SEQ = 2048, DM = 1024, M = BATCH * SEQ;
constexpr int MEMLEN = 256, MMEM = BATCH * MEMLEN;
constexpr int DFF = 2816;
constexpr int INCOLS = 6920;
constexpr int PA = 3840;
constexpr int C_FQ = 0, C_FK = 512, C_FV = 1024, C_RR = 1536, C_RK = 2048, C_RV = 2560, C_MQ = 3072, C_WD = 3584, C_AD = 3648, C_GD = 3712;
constexpr float NORM_EPS = 1e-6f, GN_EPS = 64e-5f;
constexpr float LOG2E = 1.4426950408889634f;
constexpr float C2_FOX = 0.125f * LOG2E;
constexpr float C2_MEM = 0.08838834764831845f * LOG2E;

constexpr size_t MiB = 1u << 20;
constexpr size_t WS_CTL = 0, CTL_ZERO_BYTES = 1 * MiB;
constexpr size_t WS_WALL = 1 * MiB;
constexpr size_t WS_WBR = 17 * MiB;
constexpr size_t WS_WO = 20 * MiB;
constexpr size_t WS_WGU = 22 * MiB;
constexpr size_t WS_WDN = 33 * MiB;
constexpr size_t WS_LS = 39 * MiB;
constexpr size_t WS_XNALL = 41 * MiB;
constexpr size_t WS_PROJA = 113 * MiB;
constexpr size_t WS_G01 = 353 * MiB;
constexpr size_t WS_MEMKV = 481 * MiB;
constexpr size_t WS_END = 489 * MiB;
constexpr size_t WS_MERGED = WS_XNALL;
constexpr size_t WS_Y = WS_G01;
constexpr size_t WS_U2 = WS_PROJA;
constexpr size_t WS_HID = WS_PROJA + 64 * MiB;
constexpr size_t WS_FO = WS_G01;
static_assert(WS_HID + (size_t)M * DFF * 2 <= WS_G01, "HID overlay");

constexpr int CW_TMO = 0, CW_CODE = 1;
constexpr int CW_BAR = 4096;
constexpr int CW_QUEUE = 2048;

constexpr int RING_OFF = 0, RING_BYTES = 131072;
constexpr int LDSCTL_OFF = RING_BYTES, MISC_OFF = LDSCTL_OFF + 320;
constexpr int EXTRA_OFF = MISC_OFF + 128;
constexpr int LDS_BYTES = 147456;
constexpr int NWAVES = 8;

__device__ __forceinline__ unsigned f2bf(float f) { unsigned u = __builtin_bit_cast(unsigned, f); return (u + 0x7fffu + ((u >> 16) & 1u)) >> 16; }
__device__ __forceinline__ unsigned pk2(float lo, float hi) { return f2bf(lo) | (f2bf(hi) << 16); }
__device__ __forceinline__ float bflo(unsigned w) { return __builtin_bit_cast(float, w << 16); }
__device__ __forceinline__ float bfhi(unsigned w) { return __builtin_bit_cast(float, w & 0xffff0000u); }
__device__ __forceinline__ float sigm(float x) { return 1.0f / (1.0f + __expf(-x)); }
__device__ __forceinline__ float wave_sum(float v) {
#pragma unroll
    for (int o = 1; o < 64; o <<= 1) v += __shfl_xor(v, o);
    return v;
}
#define LDS_WAIT() asm volatile("s_waitcnt lgkmcnt(0)" ::: "memory")
#define VM_WAIT() asm volatile("s_waitcnt vmcnt(0)" ::: "memory")

namespace pg8 {
#define PG8_LAS __attribute__((address_space(3)))
constexpr int BM = 256, BK = 64, HALF = 128, HTB = HALF * BK * 2, STAGE_BYTES = 8 * HTB, NXCD = 8, WGM = 8;
__host__ __device__ __forceinline__ int lds_byte(int r, int c) { const int st = (r >> 4) * 2 + (c >> 5), rr = r & 15, cc = c & 31, ob = rr * 64 + cc * 2; return st * 1024 + (ob ^ (((ob >> 9) & 1) << 5)); }
__host__ __device__ __forceinline__ void stage_rc(int b, int& R, int& C) { const int st = b / 1024, sb = b % 1024, swz = sb ^ (((sb >> 9) & 1) << 5); R = (st >> 1) * 16 + swz / 64; C = (st & 1) * 32 + (swz % 64) / 2; }
__host__ __device__ __forceinline__ int perm32(int rho) { const int n = rho >> 4, i = rho & 15; return 8 * (i >> 2) + 4 * n + (i & 3); }

struct Unit { int pm, pn, tag; const char* a; const char* b; };
struct Gemm { int K, lda, ldb; };

__device__ __forceinline__ void tile_of(int L, int nM, int nN, int& pm, int& pn) {
    const int nwg = nM * nN; int wgid = L;
    { const int q = nwg / NXCD, r = nwg % NXCD, xcd = wgid % NXCD, off = wgid / NXCD; wgid = (xcd < r ? xcd * (q + 1) : r * (q + 1) + (xcd - r) * q) + off; }
    const int nig = WGM * nN, gid = wgid / nig, fm = gid * WGM, gsz = (nM - fm) < WGM ? (nM - fm) : WGM;
    pm = fm + ((wgid % nig) % gsz); pn = (wgid % nig) / gsz;
}

typedef __bf16 bf16x2_t __attribute__((ext_vector_type(2)));
__device__ __forceinline__ unsigned cvt_pk_bf16(float lo, float hi) { f32x2 v = {lo, hi}; bf16x2_t b = __builtin_convertvector(v, bf16x2_t); return __builtin_bit_cast(unsigned, b); }

template <class Epi, class Sched, bool ALIGN_EPI = false, bool SP2 = false>
__device__ __forceinline__ void gemm_phase(PG8_LAS unsigned char* lds, const Gemm g, const Sched& S, const Epi& E) {
    const int tid = threadIdx.x, wid = __builtin_amdgcn_readfirstlane(tid >> 6), lane = tid & 63, wr = wid >> 2, wc = wid & 3, fr = lane & 15, fq = lane >> 4;
    const int K = g.K, nt = K / BK;
    unsigned voffA[2], voffB[2];
#pragma unroll
    for (int i = 0; i < 2; ++i) { int R, C; stage_rc(tid * 16 + i * 8192, R, C); const int Rb = Epi::PERM ? ((R & ~31) + perm32(R & 31)) : R;
        voffA[i] = (unsigned)(R * g.lda + C) * 2u; voffB[i] = (unsigned)(Rb * g.ldb + C) * 2u; }
    const size_t kstep = (size_t)(BK * 2);
    const size_t hstepA = (size_t)HALF * g.lda * 2, hstepB = (size_t)HALF * g.ldb * 2;
    const unsigned ldsw = (unsigned)wid * 1024u;
    const int aoff = lds_byte(wr * 64 + fr, fq * 8), boff = lds_byte(wc * 32 + fr, fq * 8);
#define PG8_SA(b, h) (((b) * 2 + (h)) * HTB)
#define PG8_SB(b, h) ((4 + (b) * 2 + (h)) * HTB)
#define PG8_STAGE(bufoff, gbase, voff) do { _Pragma("unroll") for (int _i = 0; _i < 2; ++_i) \
        __builtin_amdgcn_global_load_lds((const unsigned*)((const char*)(gbase) + (voff)[_i]), (PG8_LAS unsigned*)(lds + (bufoff) + ldsw + _i * 8192), 16, 0, 0); } while (0)
#define PG8_LDA(dst, b, h) do { _Pragma("unroll") for (int m = 0; m < 4; ++m) _Pragma("unroll") for (int k = 0; k < 2; ++k) dst[m][k] = *(const PG8_LAS bf16x8*)(lds + PG8_SA(b, h) + aoff + m * 2048 + k * 1024); } while (0)
#define PG8_LDB(dst, b, h) do { _Pragma("unroll") for (int n = 0; n < 2; ++n) _Pragma("unroll") for (int k = 0; k < 2; ++k) dst[n][k] = *(const PG8_LAS bf16x8*)(lds + PG8_SB(b, h) + boff + n * 2048 + k * 1024); } while (0)
#define PG8_MMA(ai, bj, At, Bt) do { __builtin_amdgcn_s_setprio(1); _Pragma("unroll") for (int m = 0; m < 4; ++m) _Pragma("unroll") for (int n = 0; n < 2; ++n) _Pragma("unroll") for (int k = 0; k < 2; ++k) \
        acc[ai][bj][m][n] = __builtin_amdgcn_mfma_f32_16x16x32_bf16(Bt[n][k], At[m][k], acc[ai][bj][m][n], 0, 0, 0); __builtin_amdgcn_s_setprio(0); } while (0)
#define PG8_WAIT_V(n) asm volatile("s_waitcnt vmcnt(" #n ")" ::: "memory")
#define PG8_WAIT_L(n) asm volatile("s_waitcnt lgkmcnt(" #n ")" ::: "memory")
#define PG8_BAR __builtin_amdgcn_s_barrier()
#define PG8_SCHED __builtin_amdgcn_sched_barrier(0)
    Unit cur, nxt; int ui = 0;
    if (!S.next(0, cur)) return;
    f32x4 acc[2][2][4][2];
#pragma unroll
    for (int a = 0; a < 2; ++a)
#pragma unroll
        for (int b = 0; b < 2; ++b)
#pragma unroll
            for (int m = 0; m < 4; ++m)
#pragma unroll
                for (int n = 0; n < 2; ++n) acc[a][b][m][n] = (f32x4){0.f, 0.f, 0.f, 0.f};
    bf16x8 At[4][2], B0[2][2], B1[2][2];
    const char* cA = cur.a; const char* cB = cur.b;
    if constexpr (SP2) {
        PG8_STAGE(PG8_SB(0, 0), cB, voffB); PG8_STAGE(PG8_SB(0, 1), cB + hstepB, voffB); PG8_STAGE(PG8_SA(0, 0), cA, voffA); PG8_STAGE(PG8_SA(0, 1), cA + hstepA, voffA);
        if (wr == 1) PG8_BAR;
        PG8_WAIT_V(2); PG8_BAR;
        PG8_STAGE(PG8_SB(1, 0), cB + kstep, voffB); PG8_STAGE(PG8_SA(1, 0), cA + kstep, voffA); PG8_STAGE(PG8_SB(1, 1), cB + hstepB + kstep, voffB);
        PG8_WAIT_V(6); PG8_BAR;
    } else {
        PG8_STAGE(PG8_SB(0, 0), cB, voffB); PG8_STAGE(PG8_SA(0, 0), cA, voffA); PG8_STAGE(PG8_SB(0, 1), cB + hstepB, voffB); PG8_STAGE(PG8_SA(0, 1), cA + hstepA, voffA);
        if (wr == 1) PG8_BAR;
        PG8_WAIT_V(4); PG8_BAR;
        PG8_STAGE(PG8_SB(1, 0), cB + kstep, voffB); PG8_STAGE(PG8_SA(1, 0), cA + kstep, voffA); PG8_STAGE(PG8_SB(1, 1), cB + hstepB + kstep, voffB);
        PG8_WAIT_V(6); PG8_BAR;
    }
    for (;;) {
        const bool has_next = S.next(ui + 1, nxt);
        const char* nA = has_next ? nxt.a : cA; const char* nB = has_next ? nxt.b : cB;
        for (int t = 0; t < nt; t += 2) {
            const bool last = (t == nt - 2);
            const char* a1 = cA + (size_t)(t + 1) * kstep;
            const char* a2 = last ? nA : cA + (size_t)(t + 2) * kstep; const char* b2 = last ? nB : cB + (size_t)(t + 2) * kstep;
            const char* a3 = a2 + kstep; const char* b3 = b2 + kstep;
            if constexpr (SP2) {
            PG8_LDB(B0, 0, 0); PG8_LDB(B1, 0, 1); PG8_SCHED; PG8_LDA(At, 0, 0); PG8_STAGE(PG8_SA(1, 1), a1 + hstepA, voffA);
            PG8_WAIT_V(8); PG8_WAIT_L(0); PG8_BAR; PG8_MMA(0, 0, At, B0); PG8_MMA(0, 1, At, B1); PG8_BAR; PG8_SCHED;
            PG8_LDA(At, 0, 1); PG8_STAGE(PG8_SB(0, 0), b2, voffB); PG8_STAGE(PG8_SB(0, 1), b2 + hstepB, voffB); PG8_STAGE(PG8_SA(0, 0), a2, voffA);
            PG8_WAIT_V(8); PG8_WAIT_L(0); PG8_BAR; PG8_MMA(1, 0, At, B0); PG8_MMA(1, 1, At, B1); PG8_BAR; PG8_SCHED;
            PG8_LDB(B0, 1, 0); PG8_LDB(B1, 1, 1); PG8_SCHED; PG8_LDA(At, 1, 0); PG8_STAGE(PG8_SA(0, 1), a2 + hstepA, voffA);
            PG8_WAIT_V(8); PG8_WAIT_L(0); PG8_BAR; PG8_MMA(0, 0, At, B0); PG8_MMA(0, 1, At, B1); PG8_BAR; PG8_SCHED;
            PG8_LDA(At, 1, 1); PG8_STAGE(PG8_SB(1, 0), b3, voffB); PG8_STAGE(PG8_SB(1, 1), b3 + hstepB, voffB); PG8_STAGE(PG8_SA(1, 0), a3, voffA);
            PG8_WAIT_V(8); PG8_WAIT_L(0); PG8_BAR; PG8_MMA(1, 0, At, B0); PG8_MMA(1, 1, At, B1); PG8_BAR; PG8_SCHED;
            } else {
            PG8_LDB(B0, 0, 0); PG8_SCHED; PG8_LDA(At, 0, 0); PG8_STAGE(PG8_SA(1, 1), a1 + hstepA, voffA);
            PG8_WAIT_L(8); PG8_BAR; PG8_WAIT_L(0); PG8_MMA(0, 0, At, B0); PG8_BAR; PG8_SCHED;
            PG8_LDB(B1, 0, 1); PG8_STAGE(PG8_SB(0, 0), b2, voffB);
            PG8_BAR; PG8_WAIT_L(0); PG8_MMA(0, 1, At, B1); PG8_BAR;
            PG8_LDA(At, 0, 1); PG8_STAGE(PG8_SA(0, 0), a2, voffA);
            PG8_BAR; PG8_WAIT_L(0); PG8_MMA(1, 0, At, B0); PG8_BAR; PG8_SCHED;
            PG8_STAGE(PG8_SB(0, 1), b2 + hstepB, voffB);
            PG8_WAIT_V(6); PG8_BAR; PG8_MMA(1, 1, At, B1); PG8_BAR;
            PG8_LDB(B0, 1, 0); PG8_SCHED; PG8_LDA(At, 1, 0); PG8_STAGE(PG8_SA(0, 1), a2 + hstepA, voffA);
            PG8_WAIT_L(8); PG8_BAR; PG8_WAIT_L(0); PG8_MMA(0, 0, At, B0); PG8_BAR; PG8_SCHED;
            PG8_LDB(B1, 1, 1); PG8_STAGE(PG8_SB(1, 0), b3, voffB);
            PG8_BAR; PG8_WAIT_L(0); PG8_MMA(0, 1, At, B1); PG8_BAR;
            PG8_LDA(At, 1, 1); PG8_STAGE(PG8_SA(1, 0), a3, voffA);
            PG8_BAR; PG8_WAIT_L(0); PG8_MMA(1, 0, At, B0); PG8_BAR; PG8_SCHED;
            PG8_STAGE(PG8_SB(1, 1), b3 + hstepB, voffB);
            PG8_WAIT_V(6); PG8_BAR; PG8_MMA(1, 1, At, B1); PG8_BAR;
            }
        }
        if constexpr (ALIGN_EPI) { if (wr == 0) PG8_BAR; }
        if constexpr (!Epi::AFTER_DRAIN) { E(acc, cur, wr, wc, fr, fq); }
        if (!has_next) break;
#pragma unroll
        for (int a = 0; a < 2; ++a)
#pragma unroll
            for (int b = 0; b < 2; ++b)
#pragma unroll
                for (int m = 0; m < 4; ++m)
#pragma unroll
                    for (int n = 0; n < 2; ++n) acc[a][b][m][n] = (f32x4){0.f, 0.f, 0.f, 0.f};
        cur = nxt; cA = nA; cB = nB; ++ui;
        if constexpr (ALIGN_EPI) { if (wr == 1) PG8_BAR; }
    }
    PG8_WAIT_V(0);
    if constexpr (!ALIGN_EPI) { if (wr == 0) PG8_BAR; }
    PG8_BAR;
    if constexpr (Epi::AFTER_DRAIN) { E.fused(acc, cur, wr, wc, fr, fq, lds, wid, lane); }
#undef PG8_SA
#undef PG8_SB
#undef PG8_STAGE
#undef PG8_LDA
#undef PG8_LDB
#undef PG8_MMA
#undef PG8_WAIT_V
#undef PG8_WAIT_L
#undef PG8_BAR
#undef PG8_SCHED
}

#define PG8_FOR_GROUPS(acc, wr, wc, fr, fq, BODY) \
    _Pragma("unroll") for (int ai = 0; ai < 2; ++ai) _Pragma("unroll") for (int m = 0; m < 4; ++m) _Pragma("unroll") for (int bj = 0; bj < 2; ++bj) { \
        const int trow = ai * HALF + wr * 64 + m * 16 + fr, tcol = bj * HALF + wc * 32 + 8 * fq; f32x4 v0 = acc[ai][bj][m][0], v1 = acc[ai][bj][m][1]; BODY }

__device__ __forceinline__ u32x4 pack8(f32x4 v0, f32x4 v1) { u32x4 w; w.x = cvt_pk_bf16(v0[0], v0[1]); w.y = cvt_pk_bf16(v0[2], v0[3]); w.z = cvt_pk_bf16(v1[0], v1[1]); w.w = cvt_pk_bf16(v1[2], v1[3]); return w; }

struct EpiPlain {
    static constexpr bool PERM = true, AFTER_DRAIN = false;
    bf16_t* O; int ldc;
    __device__ __forceinline__ void operator()(const f32x4 (&acc)[2][2][4][2], const Unit& u, int wr, int wc, int fr, int fq) const {
        PG8_FOR_GROUPS(acc, wr, wc, fr, fq, { *(u32x4*)(O + (size_t)(u.pm * BM + trow) * ldc + u.pn * BM + tcol) = pack8(v0, v1); })
    }
};
struct EpiInProj {
    static constexpr bool PERM = true, AFTER_DRAIN = false;
    bf16_t* proja; bf16_t* g01; bf16_t* g2; bf16_t* memkv;
    __device__ __forceinline__ void operator()(const f32x4 (&acc)[2][2][4][2], const Unit& u, int wr, int wc, int fr, int fq) const {
        if (u.tag == 1) {
            PG8_FOR_GROUPS(acc, wr, wc, fr, fq, { *(u32x4*)(memkv + (size_t)((u.pm - 128) * BM + trow) * 1024 + (u.pn - 27) * BM + tcol) = pack8(v0, v1); })
        } else if (u.pn < 15) {
            const float sc = (u.pn < 2) ? C2_FOX : ((u.pn == 12 || u.pn == 13) ? C2_MEM : 1.0f);
            PG8_FOR_GROUPS(acc, wr, wc, fr, fq, { v0 = v0 * sc; v1 = v1 * sc; *(u32x4*)(proja + (size_t)(u.pm * BM + trow) * PA + u.pn * BM + tcol) = pack8(v0, v1); })
        } else {
            bf16_t* base; int ld, c0;
            if (u.pn < 23) { base = g01; ld = 2048; c0 = (u.pn - 15) * BM; } else { base = g2; ld = 1024; c0 = (u.pn - 23) * BM; }
            PG8_FOR_GROUPS(acc, wr, wc, fr, fq, {
                _Pragma("unroll") for (int e = 0; e < 4; ++e) { v0[e] = __builtin_amdgcn_rcpf(1.0f + __builtin_amdgcn_exp2f(-LOG2E * v0[e])); v1[e] = __builtin_amdgcn_rcpf(1.0f + __builtin_amdgcn_exp2f(-LOG2E * v1[e])); }
                *(u32x4*)(base + (size_t)(u.pm * BM + trow) * ld + c0 + tcol) = pack8(v0, v1); })
        }
    }
};
struct EpiMerge {
    static constexpr bool PERM = true, AFTER_DRAIN = false;
    const bf16_t* g01; const bf16_t* g2; bf16_t* merged;
    __device__ __forceinline__ void operator()(const f32x4 (&acc)[2][2][4][2], const Unit& u, int wr, int wc, int fr, int fq) const {
        const int b = u.tag;
        PG8_FOR_GROUPS(acc, wr, wc, fr, fq, {
            const size_t row = (size_t)(u.pm * BM + trow); const int col = u.pn * BM + tcol;
            const u32x4 gw = (b < 2) ? *(const u32x4*)(g01 + row * 2048 + b * 1024 + col) : *(const u32x4*)(g2 + row * 1024 + col);
            v0[0] *= bflo(gw.x); v0[1] *= bfhi(gw.x); v0[2] *= bflo(gw.y); v0[3] *= bfhi(gw.y); v1[0] *= bflo(gw.z); v1[1] *= bfhi(gw.z); v1[2] *= bflo(gw.w); v1[3] *= bfhi(gw.w);
            bf16_t* mp = merged + row * 1024 + col;
            if (b > 0) { const u32x4 mw = *(const u32x4*)mp;
                v0[0] += bflo(mw.x); v0[1] += bfhi(mw.x); v0[2] += bflo(mw.y); v0[3] += bfhi(mw.y); v1[0] += bflo(mw.z); v1[1] += bfhi(mw.z); v1[2] += bflo(mw.w); v1[3] += bfhi(mw.w); }
            *(u32x4*)mp = pack8(v0, v1); })
    }
};
struct EpiSwiGLU {
    static constexpr bool PERM = true, AFTER_DRAIN = false;
    bf16_t* hid;
    __device__ __forceinline__ void operator()(const f32x4 (&acc)[2][2][4][2], const Unit& u, int wr, int wc, int fr, int fq) const {
#pragma unroll
        for (int ai = 0; ai < 2; ++ai)
#pragma unroll
            for (int m = 0; m < 4; ++m) {
                const int trow = ai * HALF + wr * 64 + m * 16 + fr, tcol = wc * 32 + 8 * fq;
                f32x4 g0 = acc[ai][0][m][0], g1 = acc[ai][0][m][1]; const f32x4 u0 = acc[ai][1][m][0], u1 = acc[ai][1][m][1];
#pragma unroll
                for (int e = 0; e < 4; ++e) { g0[e] = g0[e] * __builtin_amdgcn_rcpf(1.0f + __builtin_amdgcn_exp2f(-LOG2E * g0[e])) * u0[e]; g1[e] = g1[e] * __builtin_amdgcn_rcpf(1.0f + __builtin_amdgcn_exp2f(-LOG2E * g1[e])) * u1[e]; }
                *(u32x4*)(hid + (size_t)(u.pm * BM + trow) * DFF + u.pn * HALF + tcol) = pack8(g0, g1);
            }
    }
};
}

typedef GAS unsigned gu32;
#define RLX_AGENT __ATOMIC_RELAXED, __HIP_MEMORY_SCOPE_AGENT
#define XB_TMO      128
#define XB_XCNT(j)  (256  + 64 * (j))
#define XB_XSUB(j)  (1280 + 64 * (j))
#define XB_XGEN(j)  (2304 + 64 * (j))
#define XB_TOP      3328
#define XB_TOPGEN   3392
#define XCD_BAR_WORDS 3456
#define XB_SPIN_CAP (1u << 18)
__device__ __forceinline__ unsigned xb_ld(unsigned* p)              { return __hip_atomic_load(p, __ATOMIC_RELAXED, __HIP_MEMORY_SCOPE_AGENT); }
__device__ __forceinline__ unsigned xb_add(unsigned* p, unsigned v) { return __hip_atomic_fetch_add(p, v, __ATOMIC_RELAXED, __HIP_MEMORY_SCOPE_AGENT); }
__device__ __forceinline__ unsigned xb_xcc_id() { return (unsigned)__builtin_amdgcn_s_getreg((3 << 11) | 20) & 0xFu; }
#define XB_SPIN(cond, bar) do { unsigned _sp = 0; while (cond) { __builtin_amdgcn_s_sleep(1); \
    if ((++_sp & 255u) == 0u) { if (xb_ld(&(bar)[XB_TMO])) break; if (_sp > XB_SPIN_CAP) { atomicAdd(&(bar)[XB_TMO], 1u); break; } } } } while (0)
struct XcdBarrier { unsigned* bar; unsigned x; volatile LAS unsigned* st; };
__device__ __forceinline__ XcdBarrier xcd_barrier_post(unsigned* bar, volatile LAS unsigned* st) {
    XcdBarrier b; b.bar = bar; b.x = xb_xcc_id(); b.st = st;
    if (threadIdx.x == 0) (void)xb_add(&bar[XB_XCNT(b.x)], 1u);
    return b;
}
__device__ __forceinline__ void xcd_barrier_complete(unsigned* bar, unsigned x, unsigned& nloc, unsigned& nx) {
    const unsigned G = gridDim.x * gridDim.y * gridDim.z;
    unsigned sum, cnt, mine, sp = 0u;
    for (;;) {
        sum = 0u; cnt = 0u; mine = 0u;
#pragma unroll
        for (unsigned j = 0; j < 16; ++j) { const unsigned c = xb_ld(&bar[XB_XCNT(j)]); sum += c; cnt += (c > 0u) ? 1u : 0u; mine = (j == x) ? c : mine; }
        if (sum == G) break;
        __builtin_amdgcn_s_sleep(1);
        if ((++sp & 255u) == 0u) { if (xb_ld(&bar[XB_TMO])) break; if (sp > XB_SPIN_CAP) { atomicAdd(&bar[XB_TMO], 1u); break; } }
    }
    nloc = mine > 0u ? mine : 1u; nx = cnt > 0u ? cnt : 1u;
}
__device__ __forceinline__ void xcd_barrier(const XcdBarrier& b) {
    asm volatile("s_waitcnt vmcnt(0)" ::: "memory");
    __syncthreads();
    if (threadIdx.x == 0) {
        unsigned* bar = b.bar;
        __builtin_amdgcn_s_waitcnt(0);
        unsigned nloc = b.st[0], nx = b.st[1];
        if (nloc == 0u) { xcd_barrier_complete(bar, b.x, nloc, nx); b.st[0] = nloc; b.st[1] = nx; }
        const unsigned old = xb_add(&bar[XB_XSUB(b.x)], 1u);
        const unsigned gen = old / nloc;
        if (old + 1u == (gen + 1u) * nloc) {
            __builtin_amdgcn_fence(__ATOMIC_RELEASE, "agent");
            asm volatile("s_waitcnt vmcnt(0)" ::: "memory");
            const unsigned og = xb_add(&bar[XB_TOP], 1u);
            const unsigned tg = og / nx;
            if (og + 1u == (tg + 1u) * nx) xb_add(&bar[XB_TOPGEN], 1u);
            else XB_SPIN(xb_ld(&bar[XB_TOPGEN]) == tg, bar);
            __builtin_amdgcn_fence(__ATOMIC_ACQUIRE, "agent");
            xb_add(&bar[XB_XGEN(b.x)], 1u);
            asm volatile("s_waitcnt vmcnt(0)" ::: "memory");
        } else {
            XB_SPIN(xb_ld(&bar[XB_XGEN(b.x)]) == gen, bar);
            __builtin_amdgcn_fence(__ATOMIC_ACQUIRE, "agent");
            asm volatile("s_waitcnt vmcnt(0)" ::: "memory");
        }
    }
    __syncthreads();
}

struct Frame {
    LAS unsigned char* lds;
    volatile LAS unsigned* MISC;
    gu32* ctl;
    int tid, lane, wave;
    int vcu, G;
    const float* in[28];
    float* out; unsigned char* ws;
};
enum { I_X = 0, I_MEM, I_PRE1, I_POST1, I_PRE2, I_POST2, I_MEMG, I_WIN, I_FBIAS, I_MU, I_W0, I_WUP, I_A0, I_AUP, I_GUP, I_KK, I_KA, I_RK, I_GNG, I_GNB,
       I_WMEMKV, I_WFOX, I_WRWKV, I_WMEMO, I_WO, I_WG, I_WU, I_WD };

__device__ __forceinline__ void p0_transpose_item(const float* src, int ldsrc, int K, bf16_t* WT, int drow0, int k0, LAS float* scr, int lane) {
#pragma unroll 8
    for (int i = 0; i < 32; ++i) { const int kk = 2 * i + (lane >> 5); scr[kk * 33 + (lane & 31)] = src[(size_t)(k0 + kk) * ldsrc + (lane & 31)]; }
    LDS_WAIT(); asm volatile("" ::: "memory");
    const int c = lane & 7;
#pragma unroll
    for (int j = 0; j < 4; ++j) { const int n = (lane >> 3) + 8 * j; const LAS float* s = scr + (8 * c) * 33 + n;
        u32x4 o; o.x = pk2(s[0 * 33], s[1 * 33]); o.y = pk2(s[2 * 33], s[3 * 33]); o.z = pk2(s[4 * 33], s[5 * 33]); o.w = pk2(s[6 * 33], s[7 * 33]);
        *(GAS u32x4*)(WT + (size_t)(drow0 + n) * K + k0 + 8 * c) = o; }
    LDS_WAIT(); asm volatile("" ::: "memory");
}
struct TJob { int src_in; int ldsrc; int K; int scol; int ncols; size_t dst_off; int drow; int mode; };
static constexpr TJob kJobs[21] = {
    {I_WIN, INCOLS, 1024, 0,    512, WS_WALL, 0,    0},
    {I_WIN, INCOLS, 1024, 512,  512, WS_WALL, 512,  0},
    {I_WIN, INCOLS, 1024, 1024, 512, WS_WALL, 1024, 0},
    {I_WIN, INCOLS, 1024, 1544, 512, WS_WALL, 1536, 0},
    {I_WIN, INCOLS, 1024, 2056, 512, WS_WALL, 2048, 0},
    {I_WIN, INCOLS, 1024, 2568, 512, WS_WALL, 2560, 0},
    {I_WIN, INCOLS, 1024, 3336, 512, WS_WALL, 3072, 0},
    {I_WIN, INCOLS, 1024, 3080, 64,  WS_WALL, 3584, 0},
    {I_WIN, INCOLS, 1024, 3144, 64,  WS_WALL, 3648, 0},
    {I_WIN, INCOLS, 1024, 3208, 128, WS_WALL, 3712, 0},
    {I_WIN, INCOLS, 1024, 3848, 1024, WS_WALL, 3840, 0},
    {I_WIN, INCOLS, 1024, 4872, 1024, WS_WALL, 4864, 0},
    {I_WIN, INCOLS, 1024, 5896, 1024, WS_WALL, 5888, 0},
    {I_WMEMKV, 1024, 1024, 0, 1024, WS_WALL, 6912, 0},
    {I_WFOX,  1024, 512, 0, 1024, WS_WBR, 0,    0},
    {I_WRWKV, 1024, 512, 0, 1024, WS_WBR, 1024, 0},
    {I_WMEMO, 1024, 512, 0, 1024, WS_WBR, 2048, 0},
    {I_WO, 1024, 1024, 0, 1024, WS_WO, 0, 0},
    {I_WG, DFF, 1024, 0, DFF, WS_WGU, 0,   1},
    {I_WU, DFF, 1024, 0, DFF, WS_WGU, 128, 1},
    {I_WD, 1024, DFF, 0, 1024, WS_WDN, 0, 0}};
__device__ __forceinline__ void p0_prologue(Frame& F) {
    LAS float* scr = (LAS float*)(F.lds + RING_OFF + F.wave * 16384);
    const int gw = F.vcu * NWAVES + F.wave, NGW = F.G * NWAVES;
    int base = 0;
#pragma unroll
    for (int j = 0; j < 21; ++j) {
        const TJob jb = kJobs[j]; const int nblk = jb.ncols / 32, nitem = (jb.K / 64) * nblk;
        int it = gw - (base % NGW); if (it < 0) it += NGW;
        const float* srcp = F.in[jb.src_in] + jb.scol; bf16_t* dstp = (bf16_t*)(F.ws + jb.dst_off);
#pragma unroll 1
        for (; it < nitem; it += NGW) {
            const int kb = it / nblk, nb = it % nblk, n0 = nb * 32;
            const int drow0 = (jb.mode == 0) ? (jb.drow + n0) : (256 * (n0 / 128) + jb.drow + (n0 % 128));
            p0_transpose_item(srcp + n0, jb.ldsrc, jb.K, dstp, drow0, 64 * kb, scr, F.lane);
        }
        base += nitem;
    }
    {
        const float* win = F.in[I_WIN]; const float* g1 = F.in[I_PRE1]; const float* fb = F.in[I_FBIAS];
        bf16_t* XN = (bf16_t*)(F.ws + WS_XNALL); float* LS = (float*)(F.ws + WS_LS);
        f32x4 gv[4];
#pragma unroll
        for (int j = 0; j < 4; ++j) gv[j] = *(const f32x4*)(g1 + 4 * F.lane + 256 * j);
        for (int m = gw; m < M; m += NGW) {
            const GAS f32x4* xr = (const GAS f32x4*)(F.in[I_X] + (size_t)m * DM) + F.lane;
            f32x4 v[4]; float s = 0.f;
#pragma unroll
            for (int j = 0; j < 4; ++j) { v[j] = xr[64 * j]; s += (v[j].x * v[j].x + v[j].y * v[j].y) + (v[j].z * v[j].z + v[j].w * v[j].w); }
            const float rn = 1.0f / sqrtf(wave_sum(s) * (1.f / DM) + NORM_EPS);
            float fa[8];
#pragma unroll
            for (int h = 0; h < 8; ++h) fa[h] = 0.f;
#pragma unroll
            for (int j = 0; j < 4; ++j) { v[j] = v[j] * rn * gv[j];
#pragma unroll
                for (int e = 0; e < 4; ++e) { const float* wp = win + (size_t)(4 * F.lane + 256 * j + e) * INCOLS + 1536; const f32x4 w0 = *(const f32x4*)wp, w1 = *(const f32x4*)(wp + 4);
                    const float u = v[j][e]; fa[0] += u * w0.x; fa[1] += u * w0.y; fa[2] += u * w0.z; fa[3] += u * w0.w; fa[4] += u * w1.x; fa[5] += u * w1.y; fa[6] += u * w1.z; fa[7] += u * w1.w; } }
            GAS unsigned long long* o8 = (GAS unsigned long long*)(XN + (size_t)m * DM) + F.lane;
#pragma unroll
            for (int j = 0; j < 4; ++j) o8[64 * j] = (unsigned long long)pk2(v[j].x, v[j].y) | ((unsigned long long)pk2(v[j].z, v[j].w) << 32);
#pragma unroll
            for (int h = 0; h < 8; ++h) fa[h] = wave_sum(fa[h]);
            if (F.lane < 8) { float f = fa[0];
#pragma unroll
                for (int h = 1; h < 8; ++h) f = (F.lane == h) ? fa[h] : f;
                f += fb[F.lane];
                const float ls = fminf(f, 0.f) - log1pf(__expf(-fabsf(f)));
                LS[(size_t)m * 8 + F.lane] = ls; }
        }
    }
    {
        const float* g1 = F.in[I_MEMG]; bf16_t* XN = (bf16_t*)(F.ws + WS_XNALL) + (size_t)M * DM;
        f32x4 gv[4];
#pragma unroll
        for (int j = 0; j < 4; ++j) gv[j] = *(const f32x4*)(g1 + 4 * F.lane + 256 * j);
        for (int m = gw; m < MMEM; m += NGW) {
            const GAS f32x4* xr = (const GAS f32x4*)(F.in[I_MEM] + (size_t)m * DM) + F.lane;
            f32x4 v[4]; float s = 0.f;
#pragma unroll
            for (int j = 0; j < 4; ++j) { v[j] = xr[64 * j]; s += (v[j].x * v[j].x + v[j].y * v[j].y) + (v[j].z * v[j].z + v[j].w * v[j].w); }
            const float rn = 1.0f / sqrtf(wave_sum(s) * (1.f / DM) + NORM_EPS);
            GAS unsigned long long* o8 = (GAS unsigned long long*)(XN + (size_t)m * DM) + F.lane;
#pragma unroll
            for (int j = 0; j < 4; ++j) { v[j] = v[j] * rn * gv[j]; o8[64 * j] = (unsigned long long)pk2(v[j].x, v[j].y) | ((unsigned long long)pk2(v[j].z, v[j].w) << 32); }
        }
    }
}

__device__ __forceinline__ void load_row_bf16(const bf16_t* p, int lane, f32x4 (&v)[4]) {
#pragma unroll
    for (int j = 0; j < 4; ++j) { const u32x2 w = *(const u32x2*)(p + 4 * lane + 256 * j); v[j] = (f32x4){bflo(w.x), bfhi(w.x), bflo(w.y), bfhi(w.y)}; }
}
__device__ __forceinline__ void p3c_rows(Frame& F) {
    const int gw = F.vcu * NWAVES + F.wave, NGW = F.G * NWAVES;
    const bf16_t* Y = (const bf16_t*)(F.ws + WS_Y); bf16_t* U2 = (bf16_t*)(F.ws + WS_U2);
    f32x4 g1[4], g2[4];
#pragma unroll
    for (int j = 0; j < 4; ++j) { g1[j] = *(const f32x4*)(F.in[I_POST1] + 4 * F.lane + 256 * j); g2[j] = *(const f32x4*)(F.in[I_PRE2] + 4 * F.lane + 256 * j); }
    for (int m = gw; m < M; m += NGW) {
        f32x4 y[4]; load_row_bf16(Y + (size_t)m * DM, F.lane, y);
        float s = 0.f;
#pragma unroll
        for (int j = 0; j < 4; ++j) s += (y[j].x * y[j].x + y[j].y * y[j].y) + (y[j].z * y[j].z + y[j].w * y[j].w);
        const float rn = 1.0f / sqrtf(wave_sum(s) * (1.f / DM) + NORM_EPS);
        const GAS f32x4* xr = (const GAS f32x4*)(F.in[I_X] + (size_t)m * DM) + F.lane;
        GAS f32x4* hr = (GAS f32x4*)(F.out + (size_t)m * DM) + F.lane;
        float s2 = 0.f;
#pragma unroll
        for (int j = 0; j < 4; ++j) { y[j] = xr[64 * j] + y[j] * rn * g1[j]; hr[64 * j] = y[j]; s2 += (y[j].x * y[j].x + y[j].y * y[j].y) + (y[j].z * y[j].z + y[j].w * y[j].w); }
        const float rn2 = 1.0f / sqrtf(wave_sum(s2) * (1.f / DM) + NORM_EPS);
        GAS unsigned long long* o8 = (GAS unsigned long long*)(U2 + (size_t)m * DM) + F.lane;
#pragma unroll
        for (int j = 0; j < 4; ++j) { const f32x4 u = y[j] * rn2 * g2[j]; o8[64 * j] = (unsigned long long)pk2(u.x, u.y) | ((unsigned long long)pk2(u.z, u.w) << 32); }
    }
}
__device__ __forceinline__ void p5c_rows(Frame& F) {
    const int gw = F.vcu * NWAVES + F.wave, NGW = F.G * NWAVES;
    const bf16_t* FO = (const bf16_t*)(F.ws + WS_FO);
    f32x4 g1[4];
#pragma unroll
    for (int j = 0; j < 4; ++j) g1[j] = *(const f32x4*)(F.in[I_POST2] + 4 * F.lane + 256 * j);
    for (int m = gw; m < M; m += NGW) {
        f32x4 y[4]; load_row_bf16(FO + (size_t)m * DM, F.lane, y);
        float s = 0.f;
#pragma unroll
        for (int j = 0; j < 4; ++j) s += (y[j].x * y[j].x + y[j].y * y[j].y) + (y[j].z * y[j].z + y[j].w * y[j].w);
        const float rn = 1.0f / sqrtf(wave_sum(s) * (1.f / DM) + NORM_EPS);
        GAS f32x4* hr = (GAS f32x4*)(F.out + (size_t)m * DM) + F.lane;
#pragma unroll
        for (int j = 0; j < 4; ++j) hr[64 * j] = hr[64 * j] + y[j] * rn * g1[j];
    }
}

__device__ __forceinline__ void fox_simple_unit(Frame& F, int b, int h, int qb) {
    const int tid = F.tid, lane = F.lane, wave = F.wave;
    LAS float* cs = (LAS float*)(F.lds);
    LAS bf16_t* Kt = (LAS bf16_t*)(F.lds + 8192);
    LAS bf16_t* Vt = (LAS bf16_t*)(F.lds + 16384);
    LAS float* wt = (LAS float*)(F.lds + 24576);
    const bf16_t* PJ = (const bf16_t*)(F.ws + WS_PROJA);
    __syncthreads();
    {
        const float* ls = (const float*)(F.ws + WS_LS) + (size_t)b * SEQ * 8 + h;
        const float e0 = ls[(4 * tid + 0) * 8], e1 = ls[(4 * tid + 1) * 8], e2 = ls[(4 * tid + 2) * 8], e3 = ls[(4 * tid + 3) * 8];
        const float s = (e0 + e1) + (e2 + e3); float inc = s;
#pragma unroll
        for (int o = 1; o < 64; o <<= 1) { const float n = __shfl_up(inc, o); if (lane >= o) inc += n; }
        if (lane == 63) wt[wave] = inc;
        __syncthreads();
        float base = 0.f;
        for (int w = 0; w < wave; ++w) base += wt[w];
        float c = base + inc - s;
        c += e0; cs[4 * tid + 0] = c * LOG2E; c += e1; cs[4 * tid + 1] = c * LOG2E; c += e2; cs[4 * tid + 2] = c * LOG2E; c += e3; cs[4 * tid + 3] = c * LOG2E;
    }
    const int q = qb * 512 + tid; const size_t row = (size_t)b * SEQ + q;
    float qf[64], o[64];
#pragma unroll
    for (int c = 0; c < 8; ++c) { const u32x4 w = *(const u32x4*)(PJ + row * PA + C_FQ + h * 64 + c * 8);
        qf[8 * c + 0] = bflo(w.x); qf[8 * c + 1] = bfhi(w.x); qf[8 * c + 2] = bflo(w.y); qf[8 * c + 3] = bfhi(w.y); qf[8 * c + 4] = bflo(w.z); qf[8 * c + 5] = bfhi(w.z); qf[8 * c + 6] = bflo(w.w); qf[8 * c + 7] = bfhi(w.w); }
#pragma unroll
    for (int d = 0; d < 64; ++d) o[d] = 0.f;
    float mrun = -1e30f, l = 0.f;
    const int ntile = (qb + 1) * 8; const int qwmax = qb * 512 + wave * 64 + 63;
    for (int kt = 0; kt < ntile; ++kt) {
        __syncthreads();
        { const size_t krow = (size_t)b * SEQ + kt * 64 + (tid >> 3);
          const u32x4 kv = *(const u32x4*)(PJ + krow * PA + C_FK + h * 64 + (tid & 7) * 8);
          const u32x4 vv = *(const u32x4*)(PJ + krow * PA + C_FV + h * 64 + (tid & 7) * 8);
          *(LAS u32x4*)(Kt + (tid >> 3) * 64 + (tid & 7) * 8) = kv; *(LAS u32x4*)(Vt + (tid >> 3) * 64 + (tid & 7) * 8) = vv; }
        __syncthreads();
        const int kbase = kt * 64;
        if (kbase <= qwmax) {
#pragma unroll 1
            for (int kk = 0; kk < 64; ++kk) {
                const int kidx = kbase + kk;
                float s0 = 0.f, s1 = 0.f;
#pragma unroll
                for (int c = 0; c < 8; ++c) { const u32x4 w = *(const LAS u32x4*)(Kt + kk * 64 + c * 8);
                    s0 += qf[8 * c + 0] * bflo(w.x) + qf[8 * c + 2] * bflo(w.y) + qf[8 * c + 4] * bflo(w.z) + qf[8 * c + 6] * bflo(w.w);
                    s1 += qf[8 * c + 1] * bfhi(w.x) + qf[8 * c + 3] * bfhi(w.y) + qf[8 * c + 5] * bfhi(w.z) + qf[8 * c + 7] * bfhi(w.w); }
                const bool ok = kidx <= q;
                const float s = ok ? (s0 + s1 - cs[kidx]) : -1e30f;
                const float mn = fmaxf(mrun, s); const float al = __builtin_amdgcn_exp2f(mrun - mn); const float p = ok ? __builtin_amdgcn_exp2f(s - mn) : 0.f;
                l = l * al + p; mrun = mn;
#pragma unroll
                for (int c = 0; c < 8; ++c) { const u32x4 w = *(const LAS u32x4*)(Vt + kk * 64 + c * 8);
                    o[8 * c + 0] = o[8 * c + 0] * al + p * bflo(w.x); o[8 * c + 1] = o[8 * c + 1] * al + p * bfhi(w.x); o[8 * c + 2] = o[8 * c + 2] * al + p * bflo(w.y); o[8 * c + 3] = o[8 * c + 3] * al + p * bfhi(w.y);
                    o[8 * c + 4] = o[8 * c + 4] * al + p * bflo(w.z); o[8 * c + 5] = o[8 * c + 5] * al + p * bfhi(w.z); o[8 * c + 6] = o[8 * c + 6] * al + p * bflo(w.w); o[8 * c + 7] = o[8 * c + 7] * al + p * bfhi(w.w); }
            }
        }
    }
    const float rl = 1.0f / l;
    bf16_t* op = (bf16_t*)(F.ws + WS_PROJA) + row * PA + C_FQ + h * 64;
#pragma unroll
    for (int c = 0; c < 8; ++c) { u32x4 w; w.x = pk2(o[8 * c + 0] * rl, o[8 * c + 1] * rl); w.y = pk2(o[8 * c + 2] * rl, o[8 * c + 3] * rl); w.z = pk2(o[8 * c + 4] * rl, o[8 * c + 5] * rl); w.w = pk2(o[8 * c + 6] * rl, o[8 * c + 7] * rl);
        *(u32x4*)(op + c * 8) = w; }
}


namespace fox {
using s16x4=__attribute__((ext_vector_type(4)))short;
using f32x16=__attribute__((ext_vector_type(16)))float;
constexpr int D=64;
constexpr int NW=8,QBLK=32,QB=QBLK*NW,KVBLK=64,NQB=SEQ/QB;
__device__ __forceinline__ int crow(int r,int hi){return (r&3)+8*(r>>2)+4*hi;}
#define SBAR() __builtin_amdgcn_sched_barrier(0)
__device__ __forceinline__ void cmask(f32x16&p0,f32x16&p1,int jb,int qrel,int hi){
  const float NEG=-INFINITY; int kb=64*jb+4*hi;
  #pragma unroll
  for(int r=0;r<16;++r){int kv=kb+(r&3)+8*(r>>2); if(kv>qrel)p0[r]=NEG; if(kv+32>qrel)p1[r]=NEG;}
}
constexpr int NSLOT=3, SLOTB=8192;
constexpr int LDS_K=0, LDS_V=NSLOT*SLOTB, LDS_WS=2*NSLOT*SLOTB, LDS_OST=LDS_WS+NW*64*4, LDS_CB=LDS_OST+NW*4096, LDS_SCAN=LDS_CB+8192, LDS_BYTES_=LDS_SCAN+64;
__device__ __forceinline__ void glds16(const void*gsrc,unsigned lds_dst){unsigned keep;
  asm volatile("s_mov_b32 %0, m0\n\ts_mov_b32 m0, %2\n\ts_nop 0\n\tglobal_load_lds_dwordx4 %1, off\n\ts_mov_b32 m0, %0":"=&s"(keep):"v"(gsrc),"s"(lds_dst):"memory");}
__device__ __forceinline__ float max3f(float a,float b,float c){float r;asm("v_max3_f32 %0, %1, %2, %3":"=v"(r):"v"(a),"v"(b),"v"(c));return r;}
__device__ __forceinline__ float max2f(float a,float b){float r;asm("v_max_f32_e32 %0, %1, %2":"=v"(r):"v"(a),"v"(b));return r;}
__device__ __forceinline__ float fadd_s(float a,float b){float r;asm("v_add_f32_e32 %0, %1, %2":"=v"(r):"v"(a),"v"(b));return r;}
__device__ __forceinline__ float fsub_s(float a,float b){float r;asm("v_sub_f32_e32 %0, %1, %2":"=v"(r):"v"(a),"v"(b));return r;}
typedef float f32x2_t __attribute__((ext_vector_type(2))); typedef __bf16 bf16x2v_t __attribute__((ext_vector_type(2)));
__device__ __forceinline__ unsigned cvtpk_s(float lo,float hi){f32x2_t v={lo,hi};bf16x2v_t b=__builtin_convertvector(v,bf16x2v_t);return __builtin_bit_cast(unsigned,b);}
#define WAIT_BAR(N) asm volatile("s_waitcnt vmcnt(" #N ") lgkmcnt(0)\n\ts_barrier":::"memory")
#define KBF(w) (kbw[0]=(w),kbw)

__device__ __forceinline__ void qkt(f32x16&p0,f32x16&p1,const char*Kslot,const bf16x8*qr,int r32,int hi,u32x4 kb0,u32x4 kb1,bf16x8 qr4){
  const char*kb=Kslot+hi*1024+r32*16;
  #pragma unroll
  for(int d0=0;d0<4;++d0){
    const bf16x8 b0=*reinterpret_cast<const bf16x8*>(kb+d0*2048);
    const bf16x8 b1=*reinterpret_cast<const bf16x8*>(kb+d0*2048+512);
    if(d0==0){p0=__builtin_amdgcn_mfma_f32_32x32x16_bf16(b0,qr[0],f32x16{},0,0,0);p1=__builtin_amdgcn_mfma_f32_32x32x16_bf16(b1,qr[0],f32x16{},0,0,0);}
    else{p0=__builtin_amdgcn_mfma_f32_32x32x16_bf16(b0,qr[d0],p0,0,0,0);p1=__builtin_amdgcn_mfma_f32_32x32x16_bf16(b1,qr[d0],p1,0,0,0);}}
  p0=__builtin_amdgcn_mfma_f32_32x32x16_bf16(__builtin_bit_cast(bf16x8,kb0),qr4,p0,0,0,0);p1=__builtin_amdgcn_mfma_f32_32x32x16_bf16(__builtin_bit_cast(bf16x8,kb1),qr4,p1,0,0,0);
}
typedef __attribute__((address_space(3))) const char* lds_cptr;
typedef short v4i16_t __attribute__((ext_vector_type(4)));
__device__ __forceinline__ void kload8(bf16x8*kf,lds_cptr kp){
  kf[0]=*(const __attribute__((address_space(3))) bf16x8*)(kp);      kf[1]=*(const __attribute__((address_space(3))) bf16x8*)(kp+512);
  kf[2]=*(const __attribute__((address_space(3))) bf16x8*)(kp+2048); kf[3]=*(const __attribute__((address_space(3))) bf16x8*)(kp+2560);
  kf[4]=*(const __attribute__((address_space(3))) bf16x8*)(kp+4096); kf[5]=*(const __attribute__((address_space(3))) bf16x8*)(kp+4608);
  kf[6]=*(const __attribute__((address_space(3))) bf16x8*)(kp+6144); kf[7]=*(const __attribute__((address_space(3))) bf16x8*)(kp+6656);
}
__device__ __forceinline__ void kload2(bf16x8*kf,lds_cptr kp,int j){ kf[2*j]=*(const __attribute__((address_space(3))) bf16x8*)(kp+j*2048); kf[2*j+1]=*(const __attribute__((address_space(3))) bf16x8*)(kp+j*2048+512); }
__device__ __forceinline__ s16x4 vtr(lds_cptr p){ return __builtin_bit_cast(s16x4,__builtin_amdgcn_ds_read_tr16_b64_v4i16((__attribute__((address_space(3))) v4i16_t*)p)); }
__device__ __forceinline__ float rowmax(const f32x16&p0,const f32x16&p1){
  float a=max3f(p0[0],p0[1],p1[0]),b=max3f(p0[2],p0[3],p1[1]);a=max3f(a,p1[2],p1[3]);
  #pragma unroll
  for(int r=4;r<16;r+=4){a=max3f(a,p0[r],p0[r+1]);b=max3f(b,p0[r+2],p0[r+3]);a=max3f(a,p1[r],p1[r+1]);b=max3f(b,p1[r+2],p1[r+3]);}
  const float m=max2f(a,b);
  auto rr=__builtin_amdgcn_permlane32_swap(__float_as_uint(m),__float_as_uint(m),false,false);
  return max2f(__uint_as_float(rr[0]),__uint_as_float(rr[1]));
}
__device__ __forceinline__ void pv(f32x16*o,int vb,bf16x8 pa0,bf16x8 pa1,bf16x8 pa2,bf16x8 pa3){
  #pragma unroll
  for(int d0=0;d0<2;++d0){s16x4 lo[4],hi[4];
    #pragma unroll
    for(int ks=0;ks<4;++ks){
      asm volatile("ds_read_b64_tr_b16 %0,%1 offset:%c2":"=&v"(lo[ks]):"v"(vb),"i"(d0*4096+ks*1024):"memory");
      asm volatile("ds_read_b64_tr_b16 %0,%1 offset:%c2":"=&v"(hi[ks]):"v"(vb),"i"(d0*4096+ks*1024+512):"memory");}
    asm volatile("s_waitcnt lgkmcnt(0)":::"memory");SBAR();
    #define PK(k) (bf16x8){lo[k][0],lo[k][1],lo[k][2],lo[k][3],hi[k][0],hi[k][1],hi[k][2],hi[k][3]}
    o[d0]=__builtin_amdgcn_mfma_f32_32x32x16_bf16(pa0,PK(0),o[d0],0,0,0);
    o[d0]=__builtin_amdgcn_mfma_f32_32x32x16_bf16(pa1,PK(1),o[d0],0,0,0);
    o[d0]=__builtin_amdgcn_mfma_f32_32x32x16_bf16(pa2,PK(2),o[d0],0,0,0);
    o[d0]=__builtin_amdgcn_mfma_f32_32x32x16_bf16(pa3,PK(3),o[d0],0,0,0);
    #undef PK
  }
}
#define ATTN_STORE16(p,v) (*(u32x4*)(p)=(v))
template<int THRL> __device__ __forceinline__ void attn_unit(int b,int h,int qb,bf16_t*PJ,const float*LS,char*shm){
  int tid=threadIdx.x; asm volatile("":"+v"(tid));
  const int lane=tid&63,r32=lane&31,hi=lane>>5; const int wid=__builtin_amdgcn_readfirstlane(tid>>6);
  const long rowbase=(long)b*SEQ; const int q0=qb*QB;
  { float*cs=(float*)(shm+LDS_CB); float*wt=(float*)(shm+LDS_SCAN);
    const float*ls=LS+(size_t)rowbase*8+h;
    const float e0=ls[(4*tid+0)*8],e1=ls[(4*tid+1)*8],e2=ls[(4*tid+2)*8],e3=ls[(4*tid+3)*8];
    const float s=(e0+e1)+(e2+e3); float inc=s;
    #pragma unroll
    for(int o=1;o<64;o<<=1){const float n=__shfl_up(inc,o); if(lane>=o)inc+=n;}
    if(lane==63)wt[wid]=inc;
    __syncthreads();
    float base=0.f; for(int w=0;w<wid;++w)base+=wt[w];
    float c=base+inc-s; c+=e0; const float c0=c; c+=e1; const float c1=c; c+=e2; const float c2=c; c+=e3; const float c3=c;
    cs[4*tid+0]=c0;cs[4*tid+1]=c1;cs[4*tid+2]=c2;cs[4*tid+3]=c3;
    __syncthreads();
    const float cref=cs[q0+QB-1];
    __syncthreads();
    unsigned*cbw=(unsigned*)cs; const float cc[4]={c0,c1,c2,c3};
    #pragma unroll
    for(int e=0;e<4;++e){ const float bv=(cref-cc[e])*LOG2E; const unsigned bh=f2bf(bv); const float res=bv-__builtin_bit_cast(float,bh<<16); cbw[4*tid+e]=bh|(f2bf(res)<<16); }
    __syncthreads();
  }
  const bf16_t*Qw=PJ+(rowbase+q0+wid*QBLK)*PA+C_FQ+h*D;
  const bf16_t*Kh=PJ+rowbase*PA+C_FK+h*D,*Vh=PJ+rowbase*PA+C_FV+h*D;
  const unsigned lds0=(unsigned)(uintptr_t)shm;
  float*wsf=(float*)(shm+LDS_WS)+wid*64;
  const bf16_t*ksrc=Kh+(long)lane*PA+wid*8;
  const bf16_t*vsrc=Vh+(long)(16*(wid&3)+(lane>>2))*PA+(wid>>2)*32+(lane&3)*8;
  const unsigned kdst=lds0+LDS_K+wid*1024, vdst=lds0+LDS_V+wid*1024;
  #define DMA_K(t,slot) glds16(ksrc+(long)(t)*KVBLK*PA,(unsigned)__builtin_amdgcn_readfirstlane(kdst+(slot)))
  #define DMA_V(t,slot) glds16(vsrc+(long)(t)*KVBLK*PA,(unsigned)__builtin_amdgcn_readfirstlane(vdst+(slot)))
  const int vb0=(int)(lds0+LDS_V)+((lane>>4)&1)*32+(lane&3)*8+(4*hi+((lane&15)>>2))*64;
  const char*Kbase=shm+LDS_K; bf16x8 kf[8];
  const lds_cptr shm3=(lds_cptr)shm; const lds_cptr kp0=shm3+LDS_K+hi*1024+r32*16; const lds_cptr vp0=shm3+LDS_V+((lane>>4)&1)*32+(lane&3)*8+(4*hi+((lane&15)>>2))*64;
  const __attribute__((address_space(3))) unsigned* cbp=(const __attribute__((address_space(3))) unsigned*)(shm3+LDS_CB)+r32;
  const unsigned kone1=hi?0u:0x3F803F80u, kone2=hi?0u:0x00003F80u;
  u32x4 kbw=(u32x4){0u,kone1,kone2,0u};
  u32x4 q4w=(u32x4){kone1,0u,0u,0u};
  #define QR4 __builtin_bit_cast(bf16x8,q4w)
  #define SETM() do{ const float nm_=-mhat; const unsigned h1_=f2bf(nm_); const float r1_=nm_-__builtin_bit_cast(float,h1_<<16); const unsigned h2_=f2bf(r1_); const float r2_=r1_-__builtin_bit_cast(float,h2_<<16); \
      q4w[1]=hi?0u:(h1_|(h2_<<16)); q4w[2]=hi?0u:f2bf(r2_); }while(0)
  #define BW(t,half) (hi?0u:cbp[(t)*64+(half)*32])
  const int NT=(q0+QB)/KVBLK;
  DMA_K(0,0);DMA_V(0,0);DMA_K(1,SLOTB);
  bf16x8 qr[4];
  #pragma unroll
  for(int d0=0;d0<4;++d0)qr[d0]=*reinterpret_cast<const bf16x8*>(&Qw[(long)r32*PA+d0*16+hi*8]);
  float mhat=0.f,l_reg=0.f;f32x16 o[2];o[0]=f32x16{};o[1]=f32x16{};
  const int qrel=wid*QBLK+r32;
  #define CMASK(P0,P1,t) do{int jb_=(t)-(NT-4); if(jb_>=0)cmask(P0,P1,jb_,qrel,hi);}while(0)
  bool resc=false;
  #define START(P0,P1) do{ const float rm=rowmax(P0,P1); resc=false; \
    { const float dl=rm; mhat=fadd_s(mhat,dl); \
      _Pragma("unroll") for(int r=0;r<16;++r){P0[r]=fsub_s(P0[r],dl);P1[r]=fsub_s(P1[r],dl);} \
      SETM(); } \
    _Pragma("unroll") for(int r=0;r<16;++r)P0[r]=__builtin_amdgcn_exp2f(P0[r]); }while(0)
  #define RESC() do{ if(resc){ asm volatile("s_waitcnt lgkmcnt(0)":::"memory"); \
      _Pragma("unroll") for(int d_=0;d_<2;++d_) _Pragma("unroll") for(int r=0;r<16;++r)o[d_][r]*=wsf[crow(r,hi)]; } }while(0)
  f32x16 pA0,pA1,pB0,pB1;
  int sl_prev=0,sl_cur=0,sl_next=SLOTB;
  #define ROT() do{sl_prev=sl_cur;sl_cur=sl_next;sl_next=(sl_next==(NSLOT-1)*SLOTB)?0:sl_next+SLOTB;}while(0)
  DMA_K(2,2*SLOTB);
  WAIT_BAR(3);
  { const unsigned bw0=BW(0,0),bw1=BW(0,1);
    u32x4 k0_=kbw; k0_[0]=bw0; u32x4 k1_=kbw; k1_[0]=bw1; qkt(pA0,pA1,Kbase,qr,r32,hi,k0_,k1_,QR4);asm volatile("s_nop 15\n\ts_nop 7":"+v"(pA0),"+v"(pA1));CMASK(pA0,pA1,0); }
  START(pA0,pA1);
  _Pragma("unroll") for(int r=0;r<16;++r)pA1[r]=__builtin_amdgcn_exp2f(pA1[r]);
  WAIT_BAR(0);
  DMA_K(3,0);DMA_V(1,SLOTB);
  ROT();
  kload8(kf,kp0+sl_cur);
  WAIT_BAR(2);
  s16x4 vlo[8],vhi[8]; u32x4 pw0,pw1,pw2,pw3;
  #define PKW(P,B) cvtpk_s(P[B],P[B+1])
  #define PAF(k) __builtin_bit_cast(bf16x8,pw##k)
  #define VFR(i) (bf16x8){vlo[i][0],vlo[i][1],vlo[i][2],vlo[i][3],vhi[i][0],vhi[i][1],vhi[i][2],vhi[i][3]}
  #define PIN(x) asm volatile("":"+v"(x))
  #define MX3(a,b,c) __builtin_fmaxf(__builtin_fmaxf((a),(b)),(c))
  #define GAPA(MF,A0,A1,A2,A3,W0,W1,PW) do{ MF; sacc+=A0; sacc+=A1; sacc+=A2; sacc+=A3; PIN(sacc); W0; W1; PIN(PW); SBAR(); }while(0)
  #define EX(v) __builtin_amdgcn_exp2f(v)
  #define GAPB(MF,X,B) do{ MF; X[B]=EX(X[B]); X[B+1]=EX(X[B+1]); X[B+2]=EX(X[B+2]); X[B+3]=EX(X[B+3]); PIN(X); SBAR(); }while(0)
  #define VRD(i) do{ vlo[i]=vtr(vp_+(((i)>>2)*4096+((i)&3)*1024)); vhi[i]=vtr(vp_+(((i)>>2)*4096+((i)&3)*1024+512)); }while(0)
  #define KRD(G,j) do{ if(G){ kload2(kf,kp0+sl_next,j); SBAR(); } }while(0)
  #define STEP(C0,C1,P0,P1,t,GK,GV,GL) do{ SBAR(); \
    const lds_cptr vp_=vp0+sl_prev; const unsigned bw0_=BW(t,0),bw1_=BW(t,1); \
    VRD(0); SBAR(); float sacc=(P0[0]+P0[1]); \
    GAPA(C0=__builtin_amdgcn_mfma_f32_32x32x16_bf16(kf[0],qr[0],f32x16{},0,0,0), P0[2],P0[3],P0[4],P0[5],     pw0[0]=PKW(P0,0), pw0[1]=PKW(P0,2), pw0); \
    VRD(4); SBAR(); GAPA(C1=__builtin_amdgcn_mfma_f32_32x32x16_bf16(kf[1],qr[0],f32x16{},0,0,0), P0[6],P0[7],P0[8],P0[9],     pw0[2]=PKW(P0,4), pw0[3]=PKW(P0,6), pw0); \
    VRD(1); SBAR(); GAPA(C0=__builtin_amdgcn_mfma_f32_32x32x16_bf16(kf[2],qr[1],C0,0,0,0),   P0[10],P0[11],P0[12],P0[13], pw1[0]=PKW(P0,8), pw1[1]=PKW(P0,10), pw1); \
    VRD(5); SBAR(); GAPA(C1=__builtin_amdgcn_mfma_f32_32x32x16_bf16(kf[3],qr[1],C1,0,0,0),   P0[14],P0[15],P1[0],P1[1],   pw1[2]=PKW(P0,12),pw1[3]=PKW(P0,14), pw1); \
    VRD(2); SBAR(); GAPA(C0=__builtin_amdgcn_mfma_f32_32x32x16_bf16(kf[4],qr[2],C0,0,0,0),   P1[2],P1[3],P1[4],P1[5],     pw2[0]=PKW(P1,0), pw2[1]=PKW(P1,2), pw2); \
    VRD(6); SBAR(); GAPA(C1=__builtin_amdgcn_mfma_f32_32x32x16_bf16(kf[5],qr[2],C1,0,0,0),   P1[6],P1[7],P1[8],P1[9],     pw2[2]=PKW(P1,4), pw2[3]=PKW(P1,6), pw2); \
    VRD(3); SBAR(); GAPA(C0=__builtin_amdgcn_mfma_f32_32x32x16_bf16(kf[6],qr[3],C0,0,0,0),   P1[10],P1[11],P1[12],P1[13], pw3[0]=PKW(P1,8), pw3[1]=PKW(P1,10), pw3); \
    VRD(7); SBAR(); GAPA(C1=__builtin_amdgcn_mfma_f32_32x32x16_bf16(kf[7],qr[3],C1,0,0,0),   P1[14],P1[15],0.f,0.f,       pw3[2]=PKW(P1,12),pw3[3]=PKW(P1,14), pw3); \
    C0=__builtin_amdgcn_mfma_f32_32x32x16_bf16(__builtin_bit_cast(bf16x8,KBF(bw0_)),QR4,C0,0,0,0); C1=__builtin_amdgcn_mfma_f32_32x32x16_bf16(__builtin_bit_cast(bf16x8,KBF(bw1_)),QR4,C1,0,0,0); SBAR(); \
    l_reg+=sacc; \
    if(GK){DMA_K((t)+3,sl_cur);} if(GV){DMA_V((t)+1,sl_next);} \
    CMASK(C0,C1,t); \
    { float a=MX3(C0[0],C0[1],C1[0]),b=MX3(C0[2],C0[3],C1[1]); a=MX3(a,C1[2],C1[3]); \
      _Pragma("unroll") for(int r=4;r<16;r+=4){a=MX3(a,C0[r],C0[r+1]);b=MX3(b,C0[r+2],C0[r+3]);a=MX3(a,C1[r],C1[r+1]);b=MX3(b,C1[r+2],C1[r+3]);} \
      float rm=__builtin_fmaxf(a,b); { auto rr=__builtin_amdgcn_permlane32_swap(__float_as_uint(rm),__float_as_uint(rm),false,false); rm=__builtin_fmaxf(__uint_as_float(rr[0]),__uint_as_float(rr[1])); } \
      resc=false; \
      if(__builtin_expect(__any(rm>(float)THRL),0)){ const float dl=__builtin_fmaxf(rm,0.f); mhat+=dl; \
        _Pragma("unroll") for(int r=0;r<16;++r){C0[r]-=dl;C1[r]-=dl;} \
        SETM(); \
        const float f=__builtin_amdgcn_exp2f(-dl); l_reg*=f; if(hi==0)wsf[r32]=f; resc=true; } } \
    SBAR(); \
    GAPB(o[0]=__builtin_amdgcn_mfma_f32_32x32x16_bf16(PAF(0),VFR(0),o[0],0,0,0), C0,0); \
    GAPB(o[1]=__builtin_amdgcn_mfma_f32_32x32x16_bf16(PAF(0),VFR(4),o[1],0,0,0), C0,4); \
    KRD(GL,0); GAPB(o[0]=__builtin_amdgcn_mfma_f32_32x32x16_bf16(PAF(1),VFR(1),o[0],0,0,0), C0,8); \
    KRD(GL,1); GAPB(o[1]=__builtin_amdgcn_mfma_f32_32x32x16_bf16(PAF(1),VFR(5),o[1],0,0,0), C0,12); \
    KRD(GL,2); GAPB(o[0]=__builtin_amdgcn_mfma_f32_32x32x16_bf16(PAF(2),VFR(2),o[0],0,0,0), C1,0); \
    KRD(GL,3); GAPB(o[1]=__builtin_amdgcn_mfma_f32_32x32x16_bf16(PAF(2),VFR(6),o[1],0,0,0), C1,4); \
    GAPB(o[0]=__builtin_amdgcn_mfma_f32_32x32x16_bf16(PAF(3),VFR(3),o[0],0,0,0), C1,8); \
    GAPB(o[1]=__builtin_amdgcn_mfma_f32_32x32x16_bf16(PAF(3),VFR(7),o[1],0,0,0), C1,12); \
    }while(0)
  int t=1;
  #undef CMASK
  #define CMASK(P0,P1,t) do{}while(0)
  for(;t+5<NT;t+=2){
    STEP(pB0,pB1,pA0,pA1,t,true,true,true);     WAIT_BAR(2); RESC(); ROT();
    STEP(pA0,pA1,pB0,pB1,t+1,true,true,true);   WAIT_BAR(2); RESC(); ROT();
  }
  #undef CMASK
  #define CMASK(P0,P1,t) do{int jb_=(t)-(NT-4); if(jb_>=0)cmask(P0,P1,jb_,qrel,hi);}while(0)
  #define ENDW(tt) do{ if((tt)+3<NT){WAIT_BAR(2);} else if((tt)+2<NT){WAIT_BAR(1);} else {WAIT_BAR(0);} }while(0)
  for(;t+1<NT;t+=2){
    STEP(pB0,pB1,pA0,pA1,t,(t+3<NT),(t+1<NT),(t+1<NT));       ENDW(t);   RESC(); ROT();
    STEP(pA0,pA1,pB0,pB1,t+1,(t+4<NT),(t+2<NT),(t+2<NT));     ENDW(t+1); RESC(); ROT();
  }
  STEP(pB0,pB1,pA0,pA1,NT-1,false,false,false); RESC();
  { float sacc=pB0[0]+pB0[1]; _Pragma("unroll") for(int r=2;r<16;++r)sacc+=pB0[r]; _Pragma("unroll") for(int r=0;r<16;++r)sacc+=pB1[r]; l_reg+=sacc;
    pw0=(u32x4){PKW(pB0,0),PKW(pB0,2),PKW(pB0,4),PKW(pB0,6)};pw1=(u32x4){PKW(pB0,8),PKW(pB0,10),PKW(pB0,12),PKW(pB0,14)};pw2=(u32x4){PKW(pB1,0),PKW(pB1,2),PKW(pB1,4),PKW(pB1,6)};pw3=(u32x4){PKW(pB1,8),PKW(pB1,10),PKW(pB1,12),PKW(pB1,14)};
    SBAR(); pv(o,vb0+sl_cur,PAF(0),PAF(1),PAF(2),PAF(3)); }
  #undef PKW
  #undef PAF
  #undef VFR
  #undef PIN
  #undef MX3
  #undef GAPA
  #undef GAPB
  #undef EX
  #undef VRD
  #undef KRD
  #undef STEP
  #undef ENDW
  {auto rr=__builtin_amdgcn_permlane32_swap(__float_as_uint(l_reg),__float_as_uint(l_reg),false,false);l_reg=__uint_as_float(rr[0])+__uint_as_float(rr[1]);}
  if(hi==0)wsf[32+r32]=l_reg;asm volatile("s_waitcnt lgkmcnt(0)":::"memory");
  float rli[16];
  #pragma unroll
  for(int r=0;r<16;++r)rli[r]=__builtin_amdgcn_rcpf(wsf[32+crow(r,hi)]);
  bf16_t*Ow=PJ+(rowbase+q0+wid*QBLK)*PA+C_FQ+h*D;
  { bf16_t*stg=(bf16_t*)(shm+LDS_OST)+wid*2048;
    #pragma unroll
    for(int r=0;r<16;++r){const int orow=crow(r,hi);
      #pragma unroll
      for(int d0=0;d0<2;++d0)stg[orow*64+d0*32+r32]=(bf16_t)f2bf(o[d0][r]*rli[r]);}
    asm volatile("s_waitcnt lgkmcnt(0)":::"memory");
    #pragma unroll
    for(int i=0;i<4;++i){const int row=i*8+(lane>>3),ch=lane&7; const u32x4 v=*(const u32x4*)(stg+row*64+ch*8); ATTN_STORE16(Ow+(long)row*PA+ch*8,v);} }
  asm volatile("s_waitcnt lgkmcnt(0)\n\ts_barrier":::"memory");
  #undef DMA_K
  #undef DMA_V
  #undef CMASK
  #undef START
  #undef RESC
  #undef ROT
  #undef BW
  #undef QR4
  #undef SETM
}
#undef SBAR
#undef WAIT_BAR
#undef KBF
}


namespace memx {
using fox::f32x16; using fox::s16x4; using fox::crow; using fox::glds16; using fox::cvtpk_s; using fox::vtr; using fox::lds_cptr; using fox::max3f; using fox::max2f;
__device__ __forceinline__ void load_kv(int b,int hd,bool loadv,const bf16_t*KV,char*shm,int wid,int lane){
  const unsigned lds0=(unsigned)(uintptr_t)shm;
  const bf16_t*Kb=KV+(size_t)b*MEMLEN*1024+hd*128; const bf16_t*Vb=Kb+512;
  #pragma unroll
  for(int blk=0;blk<4;++blk){
    #pragma unroll
    for(int cc=0;cc<2;++cc){ const int c=wid+8*cc;
      glds16(Kb+(size_t)(blk*64+lane)*1024+c*8,(unsigned)__builtin_amdgcn_readfirstlane(lds0+blk*16384+c*1024)); }
    if(loadv)
    #pragma unroll
    for(int dh=0;dh<2;++dh){
      glds16(Vb+(size_t)(blk*64+16*(wid&3)+(lane>>2))*1024+dh*64+(wid>>2)*32+(lane&3)*8,(unsigned)__builtin_amdgcn_readfirstlane(lds0+65536+(blk*2+dh)*8192+wid*1024)); }
  }
}
__device__ __forceinline__ void unit(int b,int hd,int qb,bool loadv,bf16_t*PJ,const bf16_t*KV,char*shm){
  int tid=threadIdx.x; asm volatile("":"+v"(tid));
  const int lane=tid&63,r32=lane&31,hi=lane>>5; const int wid=__builtin_amdgcn_readfirstlane(tid>>6);
  load_kv(b,hd,loadv,KV,shm,wid,lane);
  const size_t row0=(size_t)b*SEQ+qb*256+wid*32;
  const bf16_t*Qw=PJ+row0*PA+C_MQ+hd*128;
  bf16x8 qr[8];
  #pragma unroll
  for(int d0=0;d0<8;++d0)qr[d0]=*reinterpret_cast<const bf16x8*>(&Qw[(size_t)r32*PA+d0*16+hi*8]);
  asm volatile("s_waitcnt vmcnt(0)":::"memory"); __syncthreads();
  f32x16 p[8];
  const lds_cptr shm3=(lds_cptr)shm;
  #pragma unroll
  for(int blk=0;blk<4;++blk){
    const lds_cptr kb=shm3+blk*16384+hi*1024+r32*16;
    #pragma unroll
    for(int d0=0;d0<8;++d0){
      const bf16x8 k0=*(const __attribute__((address_space(3))) bf16x8*)(kb+d0*2048);
      const bf16x8 k1=*(const __attribute__((address_space(3))) bf16x8*)(kb+d0*2048+512);
      if(d0==0){p[2*blk]=__builtin_amdgcn_mfma_f32_32x32x16_bf16(k0,qr[0],f32x16{},0,0,0);p[2*blk+1]=__builtin_amdgcn_mfma_f32_32x32x16_bf16(k1,qr[0],f32x16{},0,0,0);}
      else{p[2*blk]=__builtin_amdgcn_mfma_f32_32x32x16_bf16(k0,qr[d0],p[2*blk],0,0,0);p[2*blk+1]=__builtin_amdgcn_mfma_f32_32x32x16_bf16(k1,qr[d0],p[2*blk+1],0,0,0);}
    }
  }
  float m=p[0][0];
  #pragma unroll
  for(int i=0;i<8;++i){
    #pragma unroll
    for(int r=0;r<16;++r)m=__builtin_fmaxf(m,p[i][r]); }
  { auto rr=__builtin_amdgcn_permlane32_swap(__float_as_uint(m),__float_as_uint(m),false,false); m=__builtin_fmaxf(__uint_as_float(rr[0]),__uint_as_float(rr[1])); }
  float l=0.f;
  #pragma unroll
  for(int i=0;i<8;++i){
    #pragma unroll
    for(int r=0;r<16;++r){p[i][r]=__builtin_amdgcn_exp2f(p[i][r]-m); l+=p[i][r];} }
  { auto rr=__builtin_amdgcn_permlane32_swap(__float_as_uint(l),__float_as_uint(l),false,false); l=__uint_as_float(rr[0])+__uint_as_float(rr[1]); }
  f32x16 o[4]; o[0]=f32x16{};o[1]=f32x16{};o[2]=f32x16{};o[3]=f32x16{};
  const lds_cptr vp0=shm3+65536+((lane>>4)&1)*32+(lane&3)*8+(4*hi+((lane&15)>>2))*64;
  #pragma unroll
  for(int blk=0;blk<4;++blk){
    u32x4 pw[4];
    #pragma unroll
    for(int k=0;k<4;++k){ const f32x16&P=p[2*blk+(k>>1)]; const int B=(k&1)*8; pw[k]=(u32x4){cvtpk_s(P[B],P[B+1]),cvtpk_s(P[B+2],P[B+3]),cvtpk_s(P[B+4],P[B+5]),cvtpk_s(P[B+6],P[B+7])}; }
    #pragma unroll
    for(int dh=0;dh<2;++dh){
      const lds_cptr vp=vp0+(blk*2+dh)*8192;
      #pragma unroll
      for(int dt=0;dt<2;++dt){
        #pragma unroll
        for(int k=0;k<4;++k){
          const s16x4 lo=vtr(vp+dt*4096+k*1024), hh=vtr(vp+dt*4096+k*1024+512);
          const bf16x8 vf=(bf16x8){lo[0],lo[1],lo[2],lo[3],hh[0],hh[1],hh[2],hh[3]};
          o[dh*2+dt]=__builtin_amdgcn_mfma_f32_32x32x16_bf16(__builtin_bit_cast(bf16x8,pw[k]),vf,o[dh*2+dt],0,0,0);
        }
      }
    }
  }
  const float rl0=__builtin_amdgcn_rcpf(l);
  __syncthreads();
  bf16_t*stg=(bf16_t*)(shm)+wid*4096;
  { float*tmp=(float*)stg; if(hi==0)tmp[r32]=rl0; asm volatile("s_waitcnt lgkmcnt(0)":::"memory");
    float rli[16];
    #pragma unroll
    for(int r=0;r<16;++r)rli[r]=tmp[crow(r,hi)];
    asm volatile("s_waitcnt lgkmcnt(0)":::"memory");
    #pragma unroll
    for(int r=0;r<16;++r){ const int orow=crow(r,hi);
      #pragma unroll
      for(int t4=0;t4<4;++t4)stg[orow*128+t4*32+r32]=(bf16_t)f2bf(o[t4][r]*rli[r]); }
    asm volatile("s_waitcnt lgkmcnt(0)":::"memory");
  }
  bf16_t*Ow=PJ+row0*PA+C_MQ+hd*128;
  #pragma unroll
  for(int i=0;i<8;++i){ const int row=i*4+(lane>>4),ch=lane&15; const u32x4 v=*(const u32x4*)(stg+row*128+ch*8); *(u32x4*)(Ow+(size_t)row*PA+ch*8)=v; }
  asm volatile("s_waitcnt lgkmcnt(0)":::"memory"); __syncthreads();
}
}

__device__ __forceinline__ void mem_simple_unit(Frame& F, int b, int hd, int qb) {
    const int tid = F.tid;
    LAS bf16_t* Kt = (LAS bf16_t*)(F.lds);
    LAS bf16_t* Vt = (LAS bf16_t*)(F.lds + 16384);
    const bf16_t* PJ = (const bf16_t*)(F.ws + WS_PROJA); const bf16_t* KV = (const bf16_t*)(F.ws + WS_MEMKV);
    const int q = qb * 256 + (tid >> 1), half = tid & 1; const size_t row = (size_t)b * SEQ + q;
    float qf[64], o[64];
#pragma unroll
    for (int c = 0; c < 8; ++c) { const u32x4 w = *(const u32x4*)(PJ + row * PA + C_MQ + hd * 128 + half * 64 + c * 8);
        qf[8 * c + 0] = bflo(w.x); qf[8 * c + 1] = bfhi(w.x); qf[8 * c + 2] = bflo(w.y); qf[8 * c + 3] = bfhi(w.y); qf[8 * c + 4] = bflo(w.z); qf[8 * c + 5] = bfhi(w.z); qf[8 * c + 6] = bflo(w.w); qf[8 * c + 7] = bfhi(w.w); }
#pragma unroll
    for (int d = 0; d < 64; ++d) o[d] = 0.f;
    float mrun = -1e30f, l = 0.f;
    for (int kt = 0; kt < 4; ++kt) {
        __syncthreads();
#pragma unroll
        for (int i = 0; i < 2; ++i) { const int idx = tid + 512 * i, r = idx >> 4, ch = idx & 15;
            const size_t krow = (size_t)b * MEMLEN + kt * 64 + r;
            *(LAS u32x4*)(Kt + r * 128 + ch * 8) = *(const u32x4*)(KV + krow * 1024 + hd * 128 + ch * 8);
            *(LAS u32x4*)(Vt + r * 128 + ch * 8) = *(const u32x4*)(KV + krow * 1024 + 512 + hd * 128 + ch * 8); }
        __syncthreads();
#pragma unroll 1
        for (int kk = 0; kk < 64; ++kk) {
            float s0 = 0.f, s1 = 0.f;
#pragma unroll
            for (int c = 0; c < 8; ++c) { const u32x4 w = *(const LAS u32x4*)(Kt + kk * 128 + half * 64 + c * 8);
                s0 += qf[8 * c + 0] * bflo(w.x) + qf[8 * c + 2] * bflo(w.y) + qf[8 * c + 4] * bflo(w.z) + qf[8 * c + 6] * bflo(w.w);
                s1 += qf[8 * c + 1] * bfhi(w.x) + qf[8 * c + 3] * bfhi(w.y) + qf[8 * c + 5] * bfhi(w.z) + qf[8 * c + 7] * bfhi(w.w); }
            float s = s0 + s1; s += __shfl_xor(s, 1);
            const float mn = fmaxf(mrun, s); const float al = __builtin_amdgcn_exp2f(mrun - mn); const float p = __builtin_amdgcn_exp2f(s - mn);
            l = l * al + p; mrun = mn;
#pragma unroll
            for (int c = 0; c < 8; ++c) { const u32x4 w = *(const LAS u32x4*)(Vt + kk * 128 + half * 64 + c * 8);
                o[8 * c + 0] = o[8 * c + 0] * al + p * bflo(w.x); o[8 * c + 1] = o[8 * c + 1] * al + p * bfhi(w.x); o[8 * c + 2] = o[8 * c + 2] * al + p * bflo(w.y); o[8 * c + 3] = o[8 * c + 3] * al + p * bfhi(w.y);
                o[8 * c + 4] = o[8 * c + 4] * al + p * bflo(w.z); o[8 * c + 5] = o[8 * c + 5] * al + p * bfhi(w.z); o[8 * c + 6] = o[8 * c + 6] * al + p * bflo(w.w); o[8 * c + 7] = o[8 * c + 7] * al + p * bfhi(w.w); }
        }
    }
    const float rl = 1.0f / l;
    bf16_t* op = (bf16_t*)(F.ws + WS_PROJA) + row * PA + C_MQ + hd * 128 + half * 64;
#pragma unroll
    for (int c = 0; c < 8; ++c) { u32x4 w; w.x = pk2(o[8 * c + 0] * rl, o[8 * c + 1] * rl); w.y = pk2(o[8 * c + 2] * rl, o[8 * c + 3] * rl); w.z = pk2(o[8 * c + 4] * rl, o[8 * c + 5] * rl); w.w = pk2(o[8 * c + 6] * rl, o[8 * c + 7] * rl);
        *(u32x4*)(op + c * 8) = w; }
    __syncthreads();
}

__device__ __forceinline__ void unpack8(const u32x4 w, float (&f)[8]) { f[0] = bflo(w.x); f[1] = bfhi(w.x); f[2] = bflo(w.y); f[3] = bfhi(w.y); f[4] = bflo(w.z); f[5] = bfhi(w.z); f[6] = bflo(w.w); f[7] = bfhi(w.w); }
__device__ __forceinline__ void rwkv_simple_unit(Frame& F, int b, int h) {
    const int tid = F.tid;
    LAS float* Rr = (LAS float*)(F.lds + 0 * 16384); LAS float* Ww = (LAS float*)(F.lds + 1 * 16384); LAS float* Kk = (LAS float*)(F.lds + 2 * 16384); LAS float* Vv = (LAS float*)(F.lds + 3 * 16384);
    LAS float* Aa = (LAS float*)(F.lds + 4 * 16384); LAS float* Bb = (LAS float*)(F.lds + 5 * 16384); LAS float* Gg = (LAS float*)(F.lds + 6 * 16384); LAS float* Yy = (LAS float*)(F.lds + 7 * 16384);
    LAS float* T1 = Ww; LAS float* T2 = Aa; LAS float* T3 = Bb;
    LAS float* prevr = (LAS float*)(F.lds + EXTRA_OFF);
    bf16_t* PJ = (bf16_t*)(F.ws + WS_PROJA);
    const float* mu = F.in[I_MU]; const float* w0 = F.in[I_W0]; const float* wup = F.in[I_WUP]; const float* a0 = F.in[I_A0]; const float* aup = F.in[I_AUP]; const float* gup = F.in[I_GUP];
    const float* kkp = F.in[I_KK]; const float* kap = F.in[I_KA]; const float* rkp = F.in[I_RK]; const float* gng = F.in[I_GNG]; const float* gnb = F.in[I_GNB];
    const int t = tid >> 3, cg = tid & 7, c0 = 8 * cg, hc = h * 64 + c0;
    float St[8];
#pragma unroll
    for (int e = 0; e < 8; ++e) St[e] = 0.f;
    __syncthreads();
#pragma unroll 1
    for (int bt = 0; bt < SEQ / 64; ++bt) {
        const int tt0 = bt * 64; const size_t row = (size_t)b * SEQ + tt0 + t; const bool has_prev = (tt0 + t) > 0;
        float rs[8], ks[8], vs[8];
        {
            float cur[8], prv[8];
            const bf16_t* rp = PJ + row * PA; const bf16_t* pp = rp - PA;
            unpack8(*(const u32x4*)(rp + C_RR + hc), cur);
            if (t == 63) {
#pragma unroll
                for (int e = 0; e < 8; ++e) prevr[((bt + 1) & 1) * 64 + c0 + e] = cur[e]; }
            if (t > 0) unpack8(*(const u32x4*)(pp + C_RR + hc), prv);
            else {
#pragma unroll
                for (int e = 0; e < 8; ++e) prv[e] = (bt > 0) ? prevr[(bt & 1) * 64 + c0 + e] : 0.f; }
#pragma unroll
            for (int e = 0; e < 8; ++e) rs[e] = cur[e] + (prv[e] - cur[e]) * mu[hc + e];
            unpack8(*(const u32x4*)(rp + C_RK + hc), cur);
            if (has_prev) unpack8(*(const u32x4*)(pp + C_RK + hc), prv); else {
#pragma unroll
                for (int e = 0; e < 8; ++e) prv[e] = 0.f; }
#pragma unroll
            for (int e = 0; e < 8; ++e) ks[e] = cur[e] + (prv[e] - cur[e]) * mu[512 + hc + e];
            unpack8(*(const u32x4*)(rp + C_RV + hc), cur);
            if (has_prev) unpack8(*(const u32x4*)(pp + C_RV + hc), prv); else {
#pragma unroll
                for (int e = 0; e < 8; ++e) prv[e] = 0.f; }
#pragma unroll
            for (int e = 0; e < 8; ++e) vs[e] = cur[e] + (prv[e] - cur[e]) * mu[1024 + hc + e];
            unpack8(*(const u32x4*)(rp + C_WD + c0), cur);
            if (has_prev) unpack8(*(const u32x4*)(pp + C_WD + c0), prv); else {
#pragma unroll
                for (int e = 0; e < 8; ++e) prv[e] = 0.f; }
#pragma unroll
            for (int e = 0; e < 8; ++e) { const float x = cur[e] + (prv[e] - cur[e]) * mu[1536 + c0 + e]; T1[t * 64 + c0 + e] = 1.0f - 2.0f / (1.0f + __expf(2.0f * x)); }
            unpack8(*(const u32x4*)(rp + C_AD + c0), cur);
            if (has_prev) unpack8(*(const u32x4*)(pp + C_AD + c0), prv); else {
#pragma unroll
                for (int e = 0; e < 8; ++e) prv[e] = 0.f; }
#pragma unroll
            for (int e = 0; e < 8; ++e) T2[t * 64 + c0 + e] = cur[e] + (prv[e] - cur[e]) * mu[1600 + c0 + e];
#pragma unroll
            for (int hh = 0; hh < 2; ++hh) {
                unpack8(*(const u32x4*)(rp + C_GD + 16 * cg + 8 * hh), cur);
                if (has_prev) unpack8(*(const u32x4*)(pp + C_GD + 16 * cg + 8 * hh), prv); else {
#pragma unroll
                    for (int e = 0; e < 8; ++e) prv[e] = 0.f; }
#pragma unroll
                for (int e = 0; e < 8; ++e) { const float x = cur[e] + (prv[e] - cur[e]) * mu[1664 + 16 * cg + 8 * hh + e]; T3[t * 128 + 16 * cg + 8 * hh + e] = sigm(x); }
            }
#pragma unroll
            for (int e = 0; e < 8; ++e) { Rr[t * 64 + c0 + e] = rs[e]; Vv[t * 64 + c0 + e] = vs[e]; }
        }
        __syncthreads();
        float zw[8], za[8], gg[8];
        {
#pragma unroll
            for (int e = 0; e < 8; ++e) { zw[e] = w0[hc + e]; za[e] = a0[hc + e]; gg[e] = 0.f; }
#pragma unroll 4
            for (int i = 0; i < 64; ++i) { const float x1 = T1[t * 64 + i], x2 = T2[t * 64 + i];
                const f32x4 wa = *(const f32x4*)(wup + (size_t)i * 512 + hc), wb = *(const f32x4*)(wup + (size_t)i * 512 + hc + 4);
                const f32x4 aa = *(const f32x4*)(aup + (size_t)i * 512 + hc), ab = *(const f32x4*)(aup + (size_t)i * 512 + hc + 4);
#pragma unroll
                for (int e = 0; e < 4; ++e) { zw[e] += x1 * wa[e]; zw[4 + e] += x1 * wb[e]; za[e] += x2 * aa[e]; za[4 + e] += x2 * ab[e]; } }
#pragma unroll 4
            for (int i = 0; i < 128; ++i) { const float x3 = T3[t * 128 + i];
                const f32x4 ga = *(const f32x4*)(gup + (size_t)i * 512 + hc), gb = *(const f32x4*)(gup + (size_t)i * 512 + hc + 4);
#pragma unroll
                for (int e = 0; e < 4; ++e) { gg[e] += x3 * ga[e]; gg[4 + e] += x3 * gb[e]; } }
        }
        __syncthreads();
        {
            float kk[8], ss = 0.f;
#pragma unroll
            for (int e = 0; e < 8; ++e) { kk[e] = ks[e] * kkp[hc + e]; ss += kk[e] * kk[e]; }
            ss += __shfl_xor(ss, 1); ss += __shfl_xor(ss, 2); ss += __shfl_xor(ss, 4);
            const float rn = 1.0f / sqrtf(fmaxf(ss, 1e-24f));
#pragma unroll
            for (int e = 0; e < 8; ++e) { const float a = sigm(za[e]); const float w = __expf(-0.6065306597126334f * sigm(zw[e])); const float kn = kk[e] * rn;
                Ww[t * 64 + c0 + e] = w; Kk[t * 64 + c0 + e] = ks[e] * (1.0f + (a - 1.0f) * kap[hc + e]); Aa[t * 64 + c0 + e] = -kn; Bb[t * 64 + c0 + e] = kn * a; Gg[t * 64 + c0 + e] = gg[e]; }
        }
        __syncthreads();
        {
#pragma unroll 1
            for (int tt = 0; tt < 64; ++tt) {
                const f32x4 a0v = *(const LAS f32x4*)(Aa + tt * 64 + c0), a1v = *(const LAS f32x4*)(Aa + tt * 64 + c0 + 4);
                float sa = St[0] * a0v[0] + St[1] * a0v[1] + St[2] * a0v[2] + St[3] * a0v[3] + St[4] * a1v[0] + St[5] * a1v[1] + St[6] * a1v[2] + St[7] * a1v[3];
                sa += __shfl_xor(sa, 1); sa += __shfl_xor(sa, 2); sa += __shfl_xor(sa, 4);
                const f32x4 w0v = *(const LAS f32x4*)(Ww + tt * 64 + c0), w1v = *(const LAS f32x4*)(Ww + tt * 64 + c0 + 4);
                const f32x4 b0v = *(const LAS f32x4*)(Bb + tt * 64 + c0), b1v = *(const LAS f32x4*)(Bb + tt * 64 + c0 + 4);
                const f32x4 k0v = *(const LAS f32x4*)(Kk + tt * 64 + c0), k1v = *(const LAS f32x4*)(Kk + tt * 64 + c0 + 4);
                const f32x4 r0v = *(const LAS f32x4*)(Rr + tt * 64 + c0), r1v = *(const LAS f32x4*)(Rr + tt * 64 + c0 + 4);
                const float vi = Vv[tt * 64 + t];
                float y = 0.f;
#pragma unroll
                for (int e = 0; e < 4; ++e) { St[e] = St[e] * w0v[e] + sa * b0v[e] + vi * k0v[e]; St[4 + e] = St[4 + e] * w1v[e] + sa * b1v[e] + vi * k1v[e]; y += St[e] * r0v[e] + St[4 + e] * r1v[e]; }
                y += __shfl_xor(y, 1); y += __shfl_xor(y, 2); y += __shfl_xor(y, 4);
                if (cg == 0) Yy[tt * 64 + t] = y;
            }
        }
        __syncthreads();
        {
            float y[8], s = 0.f, sb = 0.f;
#pragma unroll
            for (int e = 0; e < 8; ++e) { y[e] = Yy[t * 64 + c0 + e]; s += y[e]; sb += Rr[t * 64 + c0 + e] * Kk[t * 64 + c0 + e] * rkp[hc + e]; }
            s += __shfl_xor(s, 1); s += __shfl_xor(s, 2); s += __shfl_xor(s, 4);
            sb += __shfl_xor(sb, 1); sb += __shfl_xor(sb, 2); sb += __shfl_xor(sb, 4);
            const float mean = s * (1.0f / 64.0f); float var = 0.f;
#pragma unroll
            for (int e = 0; e < 8; ++e) { y[e] -= mean; var += y[e] * y[e]; }
            var += __shfl_xor(var, 1); var += __shfl_xor(var, 2); var += __shfl_xor(var, 4);
            const float rstd = 1.0f / sqrtf(var * (1.0f / 64.0f) + GN_EPS);
            float ov[8];
#pragma unroll
            for (int e = 0; e < 8; ++e) ov[e] = (y[e] * rstd * gng[hc + e] + gnb[hc + e] + sb * Vv[t * 64 + c0 + e]) * Gg[t * 64 + c0 + e];
            u32x4 w; w.x = pk2(ov[0], ov[1]); w.y = pk2(ov[2], ov[3]); w.z = pk2(ov[4], ov[5]); w.w = pk2(ov[6], ov[7]);
            *(u32x4*)(PJ + row * PA + C_RR + hc) = w;
        }
        __syncthreads();
    }
}

struct SchedInProj {
    int G, c; const char* A; const char* B;
    __device__ __forceinline__ bool next(int i, pg8::Unit& u) const {
        const int L = i * G + c; const size_t ts = (size_t)256 * 1024 * 2;
        if (L < 3456) { pg8::tile_of(L, 128, 27, u.pm, u.pn); u.tag = 0; }
        else if (L < 3456 + 64) { const int j = L - 3456; u.pm = 128 + (j & 15); u.pn = 27 + (j >> 4); u.tag = 1; }
        else return false;
        u.a = A + (size_t)u.pm * ts; u.b = B + (size_t)u.pn * ts; return true;
    }
};
struct SchedMerge {
    int G, c; const char* A; const char* B;
    __device__ __forceinline__ bool next(int i, pg8::Unit& u) const {
        const int br = i % 3, L = (i / 3) * G + c; if (L >= 512) return false;
        pg8::tile_of(L, 128, 4, u.pm, u.pn); u.tag = br;
        const int coff = (br == 0) ? C_FQ : ((br == 1) ? C_RR : C_MQ);
        u.a = A + ((size_t)u.pm * 256 * PA + coff) * 2; u.b = B + ((size_t)(br * 1024 + u.pn * 256) * 512) * 2; return true;
    }
};
struct SchedPlain {
    int G, c, nM, nN; const char* A; const char* B; size_t tsA, tsB;
    __device__ __forceinline__ bool next(int i, pg8::Unit& u) const {
        const int L = i * G + c; if (L >= nM * nN) return false;
        pg8::tile_of(L, nM, nN, u.pm, u.pn); u.tag = 0; u.a = A + (size_t)u.pm * tsA; u.b = B + (size_t)u.pn * tsB; return true;
    }
};

constexpr int N_PHASES = 9;
struct Args { const float* in[28]; float* out; unsigned char* ws; int ph_lo, ph_hi, li, pad; };
__global__ void __launch_bounds__(NWAVES * 64, 2) hyb_fwd(Args args) {
    extern __shared__ __attribute__((aligned(16))) unsigned char lds[];
    Frame F;
    F.lds = (LAS unsigned char*)lds;
    F.MISC = (volatile LAS unsigned*)(F.lds + MISC_OFF);
    F.tid = threadIdx.x; F.lane = F.tid & 63; F.wave = __builtin_amdgcn_readfirstlane(F.tid >> 6);
    F.G = gridDim.x; { const int bx = blockIdx.x; F.vcu = (F.G % 8 == 0) ? (bx % 8) * (F.G / 8) + bx / 8 : bx; }
    F.ws = args.ws; F.out = args.out; F.ctl = (gu32*)(args.ws + WS_CTL);
#pragma unroll
    for (int i = 0; i < 28; ++i) F.in[i] = args.in[i];
    for (int u = F.tid; u < (LDS_BYTES - LDSCTL_OFF) / 4; u += NWAVES * 64) ((LAS unsigned*)(F.lds + LDSCTL_OFF))[u] = 0u;
    __syncthreads();
    XcdBarrier bar; bar.bar = (unsigned*)(F.ctl + CW_BAR); bar.x = 0; bar.st = nullptr;
    if (MK_N_LAUNCHES == 1) bar = xcd_barrier_post((unsigned*)(F.ctl + CW_BAR), F.MISC + 8);
    const int lo = args.ph_lo, hi = args.ph_hi;
#define IN(k) (lo <= (k) && (k) < hi)
#define SEAM(k) do { if (IN(k) && IN((k) + 1)) xcd_barrier(bar); } while (0)
    unsigned char* ws = args.ws;

    if (IN(0)) { p0_prologue(F); SEAM(0); }

    if (IN(1)) {
        pg8::Gemm g{1024, 1024, 1024};
        SchedInProj S{F.G, (int)blockIdx.x, (const char*)(ws + WS_XNALL), (const char*)(ws + WS_WALL)};
        pg8::EpiInProj E{(bf16_t*)(ws + WS_PROJA), (bf16_t*)(ws + WS_G01), (bf16_t*)args.out, (bf16_t*)(ws + WS_MEMKV)};
        pg8::gemm_phase<pg8::EpiInProj, SchedInProj, true, true>(F.lds + RING_OFF, g, S, E);
        SEAM(1);
    }

    if (IN(2)) {
        for (int u = blockIdx.x; u < 128; u += F.G) rwkv_simple_unit(F, u >> 3, u & 7);
        __syncthreads();
        for (int p = F.vcu; p < 512; p += F.G) {
            const int bh = p >> 2, sidx = p & 3;
            fox::attn_unit<8>(bh >> 3, bh & 7, 7 - sidx, (bf16_t*)(ws + WS_PROJA), (const float*)(ws + WS_LS), (char*)lds + RING_OFF);
            fox::attn_unit<8>(bh >> 3, bh & 7, sidx, (bf16_t*)(ws + WS_PROJA), (const float*)(ws + WS_LS), (char*)lds + RING_OFF);
        }
        __syncthreads();
        for (int p = F.vcu; p < 256; p += F.G) {
            const int bh = p >> 2;
            memx::unit(bh >> 2, bh & 3, 2 * (p & 3), true, (bf16_t*)(ws + WS_PROJA), (const bf16_t*)(ws + WS_MEMKV), (char*)lds + RING_OFF);
            memx::unit(bh >> 2, bh & 3, 2 * (p & 3) + 1, false, (bf16_t*)(ws + WS_PROJA), (const bf16_t*)(ws + WS_MEMKV), (char*)lds + RING_OFF);
        }
        SEAM(2);
    }

    if (IN(3)) {
        pg8::Gemm g{512, PA, 512};
        SchedMerge S{F.G, (int)blockIdx.x, (const char*)(ws + WS_PROJA), (const char*)(ws + WS_WBR)};
        pg8::EpiMerge E{(const bf16_t*)(ws + WS_G01), (const bf16_t*)args.out, (bf16_t*)(ws + WS_MERGED)};
        pg8::gemm_phase<pg8::EpiMerge, SchedMerge, true, true>(F.lds + RING_OFF, g, S, E);
        SEAM(3);
    }

    if (IN(4)) {
        pg8::Gemm g{1024, 1024, 1024};
        SchedPlain S{F.G, (int)blockIdx.x, 128, 4, (const char*)(ws + WS_MERGED), (const char*)(ws + WS_WO), (size_t)256 * 1024 * 2, (size_t)256 * 1024 * 2};
        pg8::EpiPlain E{(bf16_t*)(ws + WS_Y), 1024};
        pg8::gemm_phase<pg8::EpiPlain, SchedPlain, true, true>(F.lds + RING_OFF, g, S, E);
        SEAM(4);
    }

    if (IN(5)) { p3c_rows(F); SEAM(5); }

    if (IN(6)) {
        pg8::Gemm g{1024, 1024, 1024};
        SchedPlain S{F.G, (int)blockIdx.x, 128, 22, (const char*)(ws + WS_U2), (const char*)(ws + WS_WGU), (size_t)256 * 1024 * 2, (size_t)256 * 1024 * 2};
        pg8::EpiSwiGLU E{(bf16_t*)(ws + WS_HID)};
        pg8::gemm_phase<pg8::EpiSwiGLU, SchedPlain, true, true>(F.lds + RING_OFF, g, S, E);
        SEAM(6);
    }

    if (IN(7)) {
        pg8::Gemm g{DFF, DFF, DFF};
        SchedPlain S{F.G, (int)blockIdx.x, 128, 4, (const char*)(ws + WS_HID), (const char*)(ws + WS_WDN), (size_t)256 * DFF * 2, (size_t)256 * DFF * 2};
        pg8::EpiPlain E{(bf16_t*)(ws + WS_FO), 1024};
        pg8::gemm_phase<pg8::EpiPlain, SchedPlain, true, true>(F.lds + RING_OFF, g, S, E);
        SEAM(7);
    }

    if (IN(8)) { p5c_rows(F); }
#undef IN
#undef SEAM
}

extern "C" void kernel_launch(void* const* d_in, const int* in_sizes, int n_in, void* d_out, int out_size, void* d_ws, size_t ws_size, hipStream_t stream) {
    static int grid = 0;
    if (grid == 0) {
        if (n_in != 28 || in_sizes[0] != M * DM || out_size != M * DM || ws_size < WS_END) { fprintf(stderr, "kernel_launch: unexpected shapes (n_in %d, in0 %d, out %d, ws %zu)\n", n_in, n_in > 0 ? in_sizes[0] : -1, out_size, ws_size); grid = -1; return; }
        int dev = 0, cus = 0, per_cu = 0;
        if (hipGetDevice(&dev) != hipSuccess || hipDeviceGetAttribute(&cus, hipDeviceAttributeMultiprocessorCount, dev) != hipSuccess) { grid = -1; return; }
        if (hipFuncSetAttribute((const void*)hyb_fwd, hipFuncAttributeMaxDynamicSharedMemorySize, LDS_BYTES) != hipSuccess) { fprintf(stderr, "kernel_launch: hipFuncSetAttribute failed\n"); grid = -1; return; }
        if (hipOccupancyMaxActiveBlocksPerMultiprocessor(&per_cu, (const void*)hyb_fwd, NWAVES * 64, LDS_BYTES) != hipSuccess || per_cu < 1) { fprintf(stderr, "kernel_launch: occupancy query says %d blocks per CU\n", per_cu); (void)hipGetLastError(); grid = -1; return; }
        grid = cus;
    }
    if (grid < 0) return;
    if (hipMemsetAsync((char*)d_ws + WS_CTL, 0, CTL_ZERO_BYTES, stream) != hipSuccess) return;
    Args a{};
    for (int i = 0; i < 28; ++i) a.in[i] = (const float*)d_in[i];
    a.out = (float*)d_out; a.ws = (unsigned char*)d_ws;
    if (MK_N_LAUNCHES == 1) { a.ph_lo = 0; a.ph_hi = N_PHASES; a.li = 0; hipLaunchKernelGGL(hyb_fwd, dim3(grid), dim3(NWAVES * 64), LDS_BYTES, stream, a); }
    else for (int li = 0; li < N_PHASES; ++li) { a.ph_lo = li; a.ph_hi = li + 1; a.li = li; hipLaunchKernelGGL(hyb_fwd, dim3(grid), dim3(NWAVES * 64), LDS_BYTES, stream, a); }
}
```

```cpp
#include <hip/hip_runtime.h>
#include <cstdio>
#include <cstdint>

#ifndef MK_N_LAUNCHES
#define MK_N_LAUNCHES 1
#endif

#define LAS __attribute__((address_space(3)))
#define GAS __attribute__((address_space(1)))
typedef unsigned short bf16_t;
typedef short bf16x8 __attribute__((ext_vector_type(8)));
typedef float f32x4 __attribute__((ext_vector_type(4)));
typedef float f32x2 __attribute__((ext_vector_type(2)));
typedef unsigned u32x4 __attribute__((ext_vector_type(4)));
typedef unsigned u32x2 __attribute__((ext_vector_type(2)));

constexpr int BATCH = 16, SEQ = 2048, DM = 1024, M = BATCH * SEQ;
constexpr int MEMLEN = 256, MMEM = BATCH * MEMLEN;
constexpr int DFF = 2816;
constexpr int INCOLS = 6920;
constexpr int PA = 3840;
constexpr int C_FQ = 0, C_FK = 512, C_FV = 1024, C_RR = 1536, C_RK = 2048, C_RV = 2560, C_MQ = 3072, C_WD = 3584, C_AD = 3648, C_GD = 3712;
constexpr float NORM_EPS = 1e-6f, GN_EPS = 64e-5f;
constexpr float LOG2E = 1.4426950408889634f;
constexpr float C2_FOX = 0.125f * LOG2E;
constexpr float C2_MEM = 0.08838834764831845f * LOG2E;

constexpr size_t MiB = 1u << 20;
constexpr size_t WS_CTL = 0, CTL_ZERO_BYTES = 1 * MiB;
constexpr size_t WS_WALL = 1 * MiB;
constexpr size_t WS_WBR = 17 * MiB;
constexpr size_t WS_WO = 20 * MiB;
constexpr size_t WS_WGU = 22 * MiB;
constexpr size_t WS_WDN = 33 * MiB;
constexpr size_t WS_LS = 39 * MiB;
constexpr size_t WS_WLORA = 40 * MiB;
constexpr size_t WS_XNALL = 41 * MiB;
constexpr size_t WS_PROJA = 113 * MiB;
constexpr size_t WS_G01 = 353 * MiB;
constexpr size_t WS_MEMKV = 481 * MiB;
constexpr size_t WS_END = 489 * MiB;
constexpr size_t WS_MERGED = WS_XNALL;
constexpr size_t WS_Y = WS_G01;
constexpr size_t WS_U2 = WS_PROJA;
constexpr size_t WS_HID = WS_PROJA + 64 * MiB;
constexpr size_t WS_FO = WS_G01;
static_assert(WS_HID + (size_t)M * DFF * 2 <= WS_G01, "HID overlay");

constexpr int CW_TMO = 0, CW_CODE = 1;
constexpr int CW_BAR = 4096;
constexpr int CW_QUEUE = 2048;

constexpr int RING_OFF = 0, RING_BYTES = 131072;
constexpr int LDSCTL_OFF = RING_BYTES, MISC_OFF = LDSCTL_OFF + 320;
constexpr int EXTRA_OFF = MISC_OFF + 128;
constexpr int LDS_BYTES = 147456;
constexpr int NWAVES = 8;

__device__ __forceinline__ unsigned f2bf(float f) { unsigned u = __builtin_bit_cast(unsigned, f); return (u + 0x7fffu + ((u >> 16) & 1u)) >> 16; }
__device__ __forceinline__ unsigned pk2(float lo, float hi) { return f2bf(lo) | (f2bf(hi) << 16); }
__device__ __forceinline__ float bflo(unsigned w) { return __builtin_bit_cast(float, w << 16); }
__device__ __forceinline__ float bfhi(unsigned w) { return __builtin_bit_cast(float, w & 0xffff0000u); }
__device__ __forceinline__ float sigm(float x) { return 1.0f / (1.0f + __expf(-x)); }
__device__ __forceinline__ float wave_sum(float v) {
#pragma unroll
    for (int o = 1; o < 64; o <<= 1) v += __shfl_xor(v, o);
    return v;
}
#define LDS_WAIT() asm volatile("s_waitcnt lgkmcnt(0)" ::: "memory")
#define VM_WAIT() asm volatile("s_waitcnt vmcnt(0)" ::: "memory")

namespace pg8 {
#define PG8_LAS __attribute__((address_space(3)))
constexpr int BM = 256, BK = 64, HALF = 128, HTB = HALF * BK * 2, STAGE_BYTES = 8 * HTB, NXCD = 8, WGM = 8;
__host__ __device__ __forceinline__ int lds_byte(int r, int c) { const int st = (r >> 4) * 2 + (c >> 5), rr = r & 15, cc = c & 31, ob = rr * 64 + cc * 2; return st * 1024 + (ob ^ (((ob >> 9) & 1) << 5)); }
__host__ __device__ __forceinline__ void stage_rc(int b, int& R, int& C) { const int st = b / 1024, sb = b % 1024, swz = sb ^ (((sb >> 9) & 1) << 5); R = (st >> 1) * 16 + swz / 64; C = (st & 1) * 32 + (swz % 64) / 2; }
__host__ __device__ __forceinline__ int perm32(int rho) { const int n = rho >> 4, i = rho & 15; return 8 * (i >> 2) + 4 * n + (i & 3); }

struct Unit { int pm, pn, tag; const char* a; const char* b; };
struct Gemm { int K, lda, ldb; };

__device__ __forceinline__ void tile_of(int L, int nM, int nN, int& pm, int& pn) {
    const int nwg = nM * nN; int wgid = L;
    { const int q = nwg / NXCD, r = nwg % NXCD, xcd = wgid % NXCD, off = wgid / NXCD; wgid = (xcd < r ? xcd * (q + 1) : r * (q + 1) + (xcd - r) * q) + off; }
    const int nig = WGM * nN, gid = wgid / nig, fm = gid * WGM, gsz = (nM - fm) < WGM ? (nM - fm) : WGM;
    pm = fm + ((wgid % nig) % gsz); pn = (wgid % nig) / gsz;
}

typedef __bf16 bf16x2_t __attribute__((ext_vector_type(2)));
__device__ __forceinline__ unsigned cvt_pk_bf16(float lo, float hi) { f32x2 v = {lo, hi}; bf16x2_t b = __builtin_convertvector(v, bf16x2_t); return __builtin_bit_cast(unsigned, b); }

template <class Epi, class Sched, bool ALIGN_EPI = false, bool SP2 = false>
__device__ __forceinline__ void gemm_phase(PG8_LAS unsigned char* lds, const Gemm g, const Sched& S, const Epi& E) {
    const int tid = threadIdx.x, wid = __builtin_amdgcn_readfirstlane(tid >> 6), lane = tid & 63, wr = wid >> 2, wc = wid & 3, fr = lane & 15, fq = lane >> 4;
    const int K = g.K, nt = K / BK;
    unsigned voffA[2], voffB[2];
#pragma unroll
    for (int i = 0; i < 2; ++i) { int R, C; stage_rc(tid * 16 + i * 8192, R, C); const int Rb = Epi::PERM ? ((R & ~31) + perm32(R & 31)) : R;
        voffA[i] = (unsigned)(R * g.lda + C) * 2u; voffB[i] = (unsigned)(Rb * g.ldb + C) * 2u; }
    const size_t kstep = (size_t)(BK * 2);
    const size_t hstepA = (size_t)HALF * g.lda * 2, hstepB = (size_t)HALF * g.ldb * 2;
    const unsigned ldsw = (unsigned)wid * 1024u;
    const int aoff = lds_byte(wr * 64 + fr, fq * 8), boff = lds_byte(wc * 32 + fr, fq * 8);
#define PG8_SA(b, h) (((b) * 2 + (h)) * HTB)
#define PG8_SB(b, h) ((4 + (b) * 2 + (h)) * HTB)
#define PG8_STAGE(bufoff, gbase, voff) do { _Pragma("unroll") for (int _i = 0; _i < 2; ++_i) \
        __builtin_amdgcn_global_load_lds((const unsigned*)((const char*)(gbase) + (voff)[_i]), (PG8_LAS unsigned*)(lds + (bufoff) + ldsw + _i * 8192), 16, 0, 0); } while (0)
#define PG8_LDA(dst, b, h) do { _Pragma("unroll") for (int m = 0; m < 4; ++m) _Pragma("unroll") for (int k = 0; k < 2; ++k) dst[m][k] = *(const PG8_LAS bf16x8*)(lds + PG8_SA(b, h) + aoff + m * 2048 + k * 1024); } while (0)
#define PG8_LDB(dst, b, h) do { _Pragma("unroll") for (int n = 0; n < 2; ++n) _Pragma("unroll") for (int k = 0; k < 2; ++k) dst[n][k] = *(const PG8_LAS bf16x8*)(lds + PG8_SB(b, h) + boff + n * 2048 + k * 1024); } while (0)
#define PG8_MMA(ai, bj, At, Bt) do { __builtin_amdgcn_s_setprio(1); _Pragma("unroll") for (int m = 0; m < 4; ++m) _Pragma("unroll") for (int n = 0; n < 2; ++n) _Pragma("unroll") for (int k = 0; k < 2; ++k) \
        acc[ai][bj][m][n] = __builtin_amdgcn_mfma_f32_16x16x32_bf16(Bt[n][k], At[m][k], acc[ai][bj][m][n], 0, 0, 0); __builtin_amdgcn_s_setprio(0); } while (0)
#define PG8_WAIT_V(n) asm volatile("s_waitcnt vmcnt(" #n ")" ::: "memory")
#define PG8_WAIT_L(n) asm volatile("s_waitcnt lgkmcnt(" #n ")" ::: "memory")
#define PG8_BAR __builtin_amdgcn_s_barrier()
#define PG8_SCHED __builtin_amdgcn_sched_barrier(0)
    Unit cur, nxt; int ui = 0;
    if (!S.next(0, cur)) return;
    f32x4 acc[2][2][4][2];
#pragma unroll
    for (int a = 0; a < 2; ++a)
#pragma unroll
        for (int b = 0; b < 2; ++b)
#pragma unroll
            for (int m = 0; m < 4; ++m)
#pragma unroll
                for (int n = 0; n < 2; ++n) acc[a][b][m][n] = (f32x4){0.f, 0.f, 0.f, 0.f};
    bf16x8 At[4][2], B0[2][2], B1[2][2];
    const char* cA = cur.a; const char* cB = cur.b;
    if constexpr (SP2) {
        PG8_STAGE(PG8_SB(0, 0), cB, voffB); PG8_STAGE(PG8_SB(0, 1), cB + hstepB, voffB); PG8_STAGE(PG8_SA(0, 0), cA, voffA); PG8_STAGE(PG8_SA(0, 1), cA + hstepA, voffA);
        if (wr == 1) PG8_BAR;
        PG8_WAIT_V(2); PG8_BAR;
        PG8_STAGE(PG8_SB(1, 0), cB + kstep, voffB); PG8_STAGE(PG8_SA(1, 0), cA + kstep, voffA); PG8_STAGE(PG8_SB(1, 1), cB + hstepB + kstep, voffB);
        PG8_WAIT_V(6); PG8_BAR;
    } else {
        PG8_STAGE(PG8_SB(0, 0), cB, voffB); PG8_STAGE(PG8_SA(0, 0), cA, voffA); PG8_STAGE(PG8_SB(0, 1), cB + hstepB, voffB); PG8_STAGE(PG8_SA(0, 1), cA + hstepA, voffA);
        if (wr == 1) PG8_BAR;
        PG8_WAIT_V(4); PG8_BAR;
        PG8_STAGE(PG8_SB(1, 0), cB + kstep, voffB); PG8_STAGE(PG8_SA(1, 0), cA + kstep, voffA); PG8_STAGE(PG8_SB(1, 1), cB + hstepB + kstep, voffB);
        PG8_WAIT_V(6); PG8_BAR;
    }
    for (;;) {
        const bool has_next = S.next(ui + 1, nxt);
        const char* nA = has_next ? nxt.a : cA; const char* nB = has_next ? nxt.b : cB;
        for (int t = 0; t < nt; t += 2) {
            const bool last = (t == nt - 2);
            const char* a1 = cA + (size_t)(t + 1) * kstep;
            const char* a2 = last ? nA : cA + (size_t)(t + 2) * kstep; const char* b2 = last ? nB : cB + (size_t)(t + 2) * kstep;
            const char* a3 = a2 + kstep; const char* b3 = b2 + kstep;
            if constexpr (SP2) {
            PG8_LDB(B0, 0, 0); PG8_LDB(B1, 0, 1); PG8_SCHED; PG8_LDA(At, 0, 0); PG8_STAGE(PG8_SA(1, 1), a1 + hstepA, voffA);
            PG8_WAIT_V(8); PG8_WAIT_L(0); PG8_BAR; PG8_MMA(0, 0, At, B0); PG8_MMA(0, 1, At, B1); PG8_BAR; PG8_SCHED;
            PG8_LDA(At, 0, 1); PG8_STAGE(PG8_SB(0, 0), b2, voffB); PG8_STAGE(PG8_SB(0, 1), b2 + hstepB, voffB); PG8_STAGE(PG8_SA(0, 0), a2, voffA);
            PG8_WAIT_V(8); PG8_WAIT_L(0); PG8_BAR; PG8_MMA(1, 0, At, B0); PG8_MMA(1, 1, At, B1); PG8_BAR; PG8_SCHED;
            PG8_LDB(B0, 1, 0); PG8_LDB(B1, 1, 1); PG8_SCHED; PG8_LDA(At, 1, 0); PG8_STAGE(PG8_SA(0, 1), a2 + hstepA, voffA);
            PG8_WAIT_V(8); PG8_WAIT_L(0); PG8_BAR; PG8_MMA(0, 0, At, B0); PG8_MMA(0, 1, At, B1); PG8_BAR; PG8_SCHED;
            PG8_LDA(At, 1, 1); PG8_STAGE(PG8_SB(1, 0), b3, voffB); PG8_STAGE(PG8_SB(1, 1), b3 + hstepB, voffB); PG8_STAGE(PG8_SA(1, 0), a3, voffA);
            PG8_WAIT_V(8); PG8_WAIT_L(0); PG8_BAR; PG8_MMA(1, 0, At, B0); PG8_MMA(1, 1, At, B1); PG8_BAR; PG8_SCHED;
            } else {
            PG8_LDB(B0, 0, 0); PG8_SCHED; PG8_LDA(At, 0, 0); PG8_STAGE(PG8_SA(1, 1), a1 + hstepA, voffA);
            PG8_WAIT_L(8); PG8_BAR; PG8_WAIT_L(0); PG8_MMA(0, 0, At, B0); PG8_BAR; PG8_SCHED;
            PG8_LDB(B1, 0, 1); PG8_STAGE(PG8_SB(0, 0), b2, voffB);
            PG8_BAR; PG8_WAIT_L(0); PG8_MMA(0, 1, At, B1); PG8_BAR;
            PG8_LDA(At, 0, 1); PG8_STAGE(PG8_SA(0, 0), a2, voffA);
            PG8_BAR; PG8_WAIT_L(0); PG8_MMA(1, 0, At, B0); PG8_BAR; PG8_SCHED;
            PG8_STAGE(PG8_SB(0, 1), b2 + hstepB, voffB);
            PG8_WAIT_V(6); PG8_BAR; PG8_MMA(1, 1, At, B1); PG8_BAR;
            PG8_LDB(B0, 1, 0); PG8_SCHED; PG8_LDA(At, 1, 0); PG8_STAGE(PG8_SA(0, 1), a2 + hstepA, voffA);
            PG8_WAIT_L(8); PG8_BAR; PG8_WAIT_L(0); PG8_MMA(0, 0, At, B0); PG8_BAR; PG8_SCHED;
            PG8_LDB(B1, 1, 1); PG8_STAGE(PG8_SB(1, 0), b3, voffB);
            PG8_BAR; PG8_WAIT_L(0); PG8_MMA(0, 1, At, B1); PG8_BAR;
            PG8_LDA(At, 1, 1); PG8_STAGE(PG8_SA(1, 0), a3, voffA);
            PG8_BAR; PG8_WAIT_L(0); PG8_MMA(1, 0, At, B0); PG8_BAR; PG8_SCHED;
            PG8_STAGE(PG8_SB(1, 1), b3 + hstepB, voffB);
            PG8_WAIT_V(6); PG8_BAR; PG8_MMA(1, 1, At, B1); PG8_BAR;
            }
        }
        if constexpr (ALIGN_EPI) { if (wr == 0) PG8_BAR; }
        if constexpr (!Epi::AFTER_DRAIN) { E(acc, cur, wr, wc, fr, fq); }
        if (!has_next) break;
#pragma unroll
        for (int a = 0; a < 2; ++a)
#pragma unroll
            for (int b = 0; b < 2; ++b)
#pragma unroll
                for (int m = 0; m < 4; ++m)
#pragma unroll
                    for (int n = 0; n < 2; ++n) acc[a][b][m][n] = (f32x4){0.f, 0.f, 0.f, 0.f};
        cur = nxt; cA = nA; cB = nB; ++ui;
        if constexpr (ALIGN_EPI) { if (wr == 1) PG8_BAR; }
    }
    PG8_WAIT_V(0);
    if constexpr (!ALIGN_EPI) { if (wr == 0) PG8_BAR; }
    PG8_BAR;
    if constexpr (Epi::AFTER_DRAIN) { E.fused(acc, cur, wr, wc, fr, fq, lds, wid, lane); }
#undef PG8_SA
#undef PG8_SB
#undef PG8_STAGE
#undef PG8_LDA
#undef PG8_LDB
#undef PG8_MMA
#undef PG8_WAIT_V
#undef PG8_WAIT_L
#undef PG8_BAR
#undef PG8_SCHED
}

#define PG8_FOR_GROUPS(acc, wr, wc, fr, fq, BODY) \
    _Pragma("unroll") for (int ai = 0; ai < 2; ++ai) _Pragma("unroll") for (int m = 0; m < 4; ++m) _Pragma("unroll") for (int bj = 0; bj < 2; ++bj) { \
        const int trow = ai * HALF + wr * 64 + m * 16 + fr, tcol = bj * HALF + wc * 32 + 8 * fq; f32x4 v0 = acc[ai][bj][m][0], v1 = acc[ai][bj][m][1]; BODY }

__device__ __forceinline__ u32x4 pack8(f32x4 v0, f32x4 v1) { u32x4 w; w.x = cvt_pk_bf16(v0[0], v0[1]); w.y = cvt_pk_bf16(v0[2], v0[3]); w.z = cvt_pk_bf16(v1[0], v1[1]); w.w = cvt_pk_bf16(v1[2], v1[3]); return w; }

struct EpiPlain {
    static constexpr bool PERM = true, AFTER_DRAIN = false;
    bf16_t* O; int ldc;
    __device__ __forceinline__ void operator()(const f32x4 (&acc)[2][2][4][2], const Unit& u, int wr, int wc, int fr, int fq) const {
        PG8_FOR_GROUPS(acc, wr, wc, fr, fq, { *(u32x4*)(O + (size_t)(u.pm * BM + trow) * ldc + u.pn * BM + tcol) = pack8(v0, v1); })
    }
};
struct EpiInProj {
    static constexpr bool PERM = true, AFTER_DRAIN = false;
    bf16_t* proja; bf16_t* g01; bf16_t* g2; bf16_t* memkv;
    __device__ __forceinline__ void operator()(const f32x4 (&acc)[2][2][4][2], const Unit& u, int wr, int wc, int fr, int fq) const {
        if (u.tag == 1) {
            PG8_FOR_GROUPS(acc, wr, wc, fr, fq, { *(u32x4*)(memkv + (size_t)((u.pm - 128) * BM + trow) * 1024 + (u.pn - 27) * BM + tcol) = pack8(v0, v1); })
        } else if (u.pn < 15) {
            const float sc = (u.pn < 2) ? C2_FOX : ((u.pn == 12 || u.pn == 13) ? C2_MEM : 1.0f);
            PG8_FOR_GROUPS(acc, wr, wc, fr, fq, { v0 = v0 * sc; v1 = v1 * sc; *(u32x4*)(proja + (size_t)(u.pm * BM + trow) * PA + u.pn * BM + tcol) = pack8(v0, v1); })
        } else {
            bf16_t* base; int ld, c0;
            if (u.pn < 23) { base = g01; ld = 2048; c0 = (u.pn - 15) * BM; } else { base = g2; ld = 1024; c0 = (u.pn - 23) * BM; }
            PG8_FOR_GROUPS(acc, wr, wc, fr, fq, {
                _Pragma("unroll") for (int e = 0; e < 4; ++e) { v0[e] = __builtin_amdgcn_rcpf(1.0f + __builtin_amdgcn_exp2f(-LOG2E * v0[e])); v1[e] = __builtin_amdgcn_rcpf(1.0f + __builtin_amdgcn_exp2f(-LOG2E * v1[e])); }
                *(u32x4*)(base + (size_t)(u.pm * BM + trow) * ld + c0 + tcol) = pack8(v0, v1); })
        }
    }
};
struct EpiMerge {
    static constexpr bool PERM = true, AFTER_DRAIN = false;
    const bf16_t* g01; const bf16_t* g2; bf16_t* merged;
    __device__ __forceinline__ void operator()(const f32x4 (&acc)[2][2][4][2], const Unit& u, int wr, int wc, int fr, int fq) const {
        const int b = u.tag;
        PG8_FOR_GROUPS(acc, wr, wc, fr, fq, {
            const size_t row = (size_t)(u.pm * BM + trow); const int col = u.pn * BM + tcol;
            const u32x4 gw = (b < 2) ? *(const u32x4*)(g01 + row * 2048 + b * 1024 + col) : *(const u32x4*)(g2 + row * 1024 + col);
            v0[0] *= bflo(gw.x); v0[1] *= bfhi(gw.x); v0[2] *= bflo(gw.y); v0[3] *= bfhi(gw.y); v1[0] *= bflo(gw.z); v1[1] *= bfhi(gw.z); v1[2] *= bflo(gw.w); v1[3] *= bfhi(gw.w);
            bf16_t* mp = merged + row * 1024 + col;
            if (b > 0) { const u32x4 mw = *(const u32x4*)mp;
                v0[0] += bflo(mw.x); v0[1] += bfhi(mw.x); v0[2] += bflo(mw.y); v0[3] += bfhi(mw.y); v1[0] += bflo(mw.z); v1[1] += bfhi(mw.z); v1[2] += bflo(mw.w); v1[3] += bfhi(mw.w); }
            *(u32x4*)mp = pack8(v0, v1); })
    }
};
struct EpiSwiGLU {
    static constexpr bool PERM = true, AFTER_DRAIN = false;
    bf16_t* hid;
    __device__ __forceinline__ void operator()(const f32x4 (&acc)[2][2][4][2], const Unit& u, int wr, int wc, int fr, int fq) const {
#pragma unroll
        for (int ai = 0; ai < 2; ++ai)
#pragma unroll
            for (int m = 0; m < 4; ++m) {
                const int trow = ai * HALF + wr * 64 + m * 16 + fr, tcol = wc * 32 + 8 * fq;
                f32x4 g0 = acc[ai][0][m][0], g1 = acc[ai][0][m][1]; const f32x4 u0 = acc[ai][1][m][0], u1 = acc[ai][1][m][1];
#pragma unroll
                for (int e = 0; e < 4; ++e) { g0[e] = g0[e] * __builtin_amdgcn_rcpf(1.0f + __builtin_amdgcn_exp2f(-LOG2E * g0[e])) * u0[e]; g1[e] = g1[e] * __builtin_amdgcn_rcpf(1.0f + __builtin_amdgcn_exp2f(-LOG2E * g1[e])) * u1[e]; }
                *(u32x4*)(hid + (size_t)(u.pm * BM + trow) * DFF + u.pn * HALF + tcol) = pack8(g0, g1);
            }
    }
};
}

typedef GAS unsigned gu32;
#define RLX_AGENT __ATOMIC_RELAXED, __HIP_MEMORY_SCOPE_AGENT
#define XB_TMO      128
#define XB_XCNT(j)  (256  + 64 * (j))
#define XB_XSUB(j)  (1280 + 64 * (j))
#define XB_XGEN(j)  (2304 + 64 * (j))
#define XB_TOP      3328
#define XB_TOPGEN   3392
#define XCD_BAR_WORDS 3456
#define XB_SPIN_CAP (1u << 18)
__device__ __forceinline__ unsigned xb_ld(unsigned* p)              { return __hip_atomic_load(p, __ATOMIC_RELAXED, __HIP_MEMORY_SCOPE_AGENT); }
__device__ __forceinline__ unsigned xb_add(unsigned* p, unsigned v) { return __hip_atomic_fetch_add(p, v, __ATOMIC_RELAXED, __HIP_MEMORY_SCOPE_AGENT); }
__device__ __forceinline__ unsigned xb_xcc_id() { return (unsigned)__builtin_amdgcn_s_getreg((3 << 11) | 20) & 0xFu; }
#define XB_SPIN(cond, bar) do { unsigned _sp = 0; while (cond) { __builtin_amdgcn_s_sleep(1); \
    if ((++_sp & 255u) == 0u) { if (xb_ld(&(bar)[XB_TMO])) break; if (_sp > XB_SPIN_CAP) { atomicAdd(&(bar)[XB_TMO], 1u); break; } } } } while (0)
struct XcdBarrier { unsigned* bar; unsigned x; volatile LAS unsigned* st; };
__device__ __forceinline__ XcdBarrier xcd_barrier_post(unsigned* bar, volatile LAS unsigned* st) {
    XcdBarrier b; b.bar = bar; b.x = xb_xcc_id(); b.st = st;
    if (threadIdx.x == 0) (void)xb_add(&bar[XB_XCNT(b.x)], 1u);
    return b;
}
__device__ __forceinline__ void xcd_barrier_complete(unsigned* bar, unsigned x, unsigned& nloc, unsigned& nx) {
    const unsigned G = gridDim.x * gridDim.y * gridDim.z;
    unsigned sum, cnt, mine, sp = 0u;
    for (;;) {
        sum = 0u; cnt = 0u; mine = 0u;
#pragma unroll
        for (unsigned j = 0; j < 16; ++j) { const unsigned c = xb_ld(&bar[XB_XCNT(j)]); sum += c; cnt += (c > 0u) ? 1u : 0u; mine = (j == x) ? c : mine; }
        if (sum == G) break;
        __builtin_amdgcn_s_sleep(1);
        if ((++sp & 255u) == 0u) { if (xb_ld(&bar[XB_TMO])) break; if (sp > XB_SPIN_CAP) { atomicAdd(&bar[XB_TMO], 1u); break; } }
    }
    nloc = mine > 0u ? mine : 1u; nx = cnt > 0u ? cnt : 1u;
}
__device__ __forceinline__ void xcd_barrier(const XcdBarrier& b) {
    asm volatile("s_waitcnt vmcnt(0)" ::: "memory");
    __syncthreads();
    if (threadIdx.x == 0) {
        unsigned* bar = b.bar;
        __builtin_amdgcn_s_waitcnt(0);
        unsigned nloc = b.st[0], nx = b.st[1];
        if (nloc == 0u) { xcd_barrier_complete(bar, b.x, nloc, nx); b.st[0] = nloc; b.st[1] = nx; }
        const unsigned old = xb_add(&bar[XB_XSUB(b.x)], 1u);
        const unsigned gen = old / nloc;
        if (old + 1u == (gen + 1u) * nloc) {
            __builtin_amdgcn_fence(__ATOMIC_RELEASE, "agent");
            asm volatile("s_waitcnt vmcnt(0)" ::: "memory");
            const unsigned og = xb_add(&bar[XB_TOP], 1u);
            const unsigned tg = og / nx;
            if (og + 1u == (tg + 1u) * nx) xb_add(&bar[XB_TOPGEN], 1u);
            else XB_SPIN(xb_ld(&bar[XB_TOPGEN]) == tg, bar);
            __builtin_amdgcn_fence(__ATOMIC_ACQUIRE, "agent");
            xb_add(&bar[XB_XGEN(b.x)], 1u);
            asm volatile("s_waitcnt vmcnt(0)" ::: "memory");
        } else {
            XB_SPIN(xb_ld(&bar[XB_XGEN(b.x)]) == gen, bar);
            __builtin_amdgcn_fence(__ATOMIC_ACQUIRE, "agent");
            asm volatile("s_waitcnt vmcnt(0)" ::: "memory");
        }
    }
    __syncthreads();
}

struct Frame {
    LAS unsigned char* lds;
    volatile LAS unsigned* MISC;
    gu32* ctl;
    int tid, lane, wave;
    int vcu, G;
    const float* in[28];
    float* out; unsigned char* ws;
};
enum { I_X = 0, I_MEM, I_PRE1, I_POST1, I_PRE2, I_POST2, I_MEMG, I_WIN, I_FBIAS, I_MU, I_W0, I_WUP, I_A0, I_AUP, I_GUP, I_KK, I_KA, I_RK, I_GNG, I_GNB,
       I_WMEMKV, I_WFOX, I_WRWKV, I_WMEMO, I_WO, I_WG, I_WU, I_WD };

__device__ __forceinline__ void p0_transpose_item(const float* src, int ldsrc, int K, bf16_t* WT, int drow0, int k0, LAS float* scr, int lane) {
#pragma unroll 8
    for (int i = 0; i < 32; ++i) { const int kk = 2 * i + (lane >> 5); scr[kk * 33 + (lane & 31)] = src[(size_t)(k0 + kk) * ldsrc + (lane & 31)]; }
    LDS_WAIT(); asm volatile("" ::: "memory");
    const int c = lane & 7;
#pragma unroll
    for (int j = 0; j < 4; ++j) { const int n = (lane >> 3) + 8 * j; const LAS float* s = scr + (8 * c) * 33 + n;
        u32x4 o; o.x = pk2(s[0 * 33], s[1 * 33]); o.y = pk2(s[2 * 33], s[3 * 33]); o.z = pk2(s[4 * 33], s[5 * 33]); o.w = pk2(s[6 * 33], s[7 * 33]);
        *(GAS u32x4*)(WT + (size_t)(drow0 + n) * K + k0 + 8 * c) = o; }
    LDS_WAIT(); asm volatile("" ::: "memory");
}
struct TJob { int src_in; int ldsrc; int K; int scol; int ncols; size_t dst_off; int drow; int mode; };
static constexpr TJob kJobs[24] = {
    {I_WUP, 512, 64, 0, 512, WS_WLORA, 0, 0},
    {I_AUP, 512, 64, 0, 512, WS_WLORA + 65536, 0, 0},
    {I_GUP, 512, 128, 0, 512, WS_WLORA + 131072, 0, 0},
    {I_WIN, INCOLS, 1024, 0,    512, WS_WALL, 0,    0},
    {I_WIN, INCOLS, 1024, 512,  512, WS_WALL, 512,  0},
    {I_WIN, INCOLS, 1024, 1024, 512, WS_WALL, 1024, 0},
    {I_WIN, INCOLS, 1024, 1544, 512, WS_WALL, 1536, 0},
    {I_WIN, INCOLS, 1024, 2056, 512, WS_WALL, 2048, 0},
    {I_WIN, INCOLS, 1024, 2568, 512, WS_WALL, 2560, 0},
    {I_WIN, INCOLS, 1024, 3336, 512, WS_WALL, 3072, 0},
    {I_WIN, INCOLS, 1024, 3080, 64,  WS_WALL, 3584, 0},
    {I_WIN, INCOLS, 1024, 3144, 64,  WS_WALL, 3648, 0},
    {I_WIN, INCOLS, 1024, 3208, 128, WS_WALL, 3712, 0},
    {I_WIN, INCOLS, 1024, 3848, 1024, WS_WALL, 3840, 0},
    {I_WIN, INCOLS, 1024, 4872, 1024, WS_WALL, 4864, 0},
    {I_WIN, INCOLS, 1024, 5896, 1024, WS_WALL, 5888, 0},
    {I_WMEMKV, 1024, 1024, 0, 1024, WS_WALL, 6912, 0},
    {I_WFOX,  1024, 512, 0, 1024, WS_WBR, 0,    0},
    {I_WRWKV, 1024, 512, 0, 1024, WS_WBR, 1024, 0},
    {I_WMEMO, 1024, 512, 0, 1024, WS_WBR, 2048, 0},
    {I_WO, 1024, 1024, 0, 1024, WS_WO, 0, 0},
    {I_WG, DFF, 1024, 0, DFF, WS_WGU, 0,   1},
    {I_WU, DFF, 1024, 0, DFF, WS_WGU, 128, 1},
    {I_WD, 1024, DFF, 0, 1024, WS_WDN, 0, 0}};
__device__ __forceinline__ void p0_prologue(Frame& F) {
    LAS float* scr = (LAS float*)(F.lds + RING_OFF + F.wave * 16384);
    const int gw = F.vcu * NWAVES + F.wave, NGW = F.G * NWAVES;
    int base = 0;
#pragma unroll
    for (int j = 0; j < 24; ++j) {
        const TJob jb = kJobs[j]; const int nblk = jb.ncols / 32, nitem = (jb.K / 64) * nblk;
        int it = gw - (base % NGW); if (it < 0) it += NGW;
        const float* srcp = F.in[jb.src_in] + jb.scol; bf16_t* dstp = (bf16_t*)(F.ws + jb.dst_off);
#pragma unroll 1
        for (; it < nitem; it += NGW) {
            const int kb = it / nblk, nb = it % nblk, n0 = nb * 32;
            const int drow0 = (jb.mode == 0) ? (jb.drow + n0) : (256 * (n0 / 128) + jb.drow + (n0 % 128));
            p0_transpose_item(srcp + n0, jb.ldsrc, jb.K, dstp, drow0, 64 * kb, scr, F.lane);
        }
        base += nitem;
    }
    {
        const float* win = F.in[I_WIN]; const float* g1 = F.in[I_PRE1]; const float* fb = F.in[I_FBIAS];
        bf16_t* XN = (bf16_t*)(F.ws + WS_XNALL); float* LS = (float*)(F.ws + WS_LS);
        f32x4 gv[4];
#pragma unroll
        for (int j = 0; j < 4; ++j) gv[j] = *(const f32x4*)(g1 + 4 * F.lane + 256 * j);
        for (int m = gw; m < M; m += NGW) {
            const GAS f32x4* xr = (const GAS f32x4*)(F.in[I_X] + (size_t)m * DM) + F.lane;
            f32x4 v[4]; float s = 0.f;
#pragma unroll
            for (int j = 0; j < 4; ++j) { v[j] = xr[64 * j]; s += (v[j].x * v[j].x + v[j].y * v[j].y) + (v[j].z * v[j].z + v[j].w * v[j].w); }
            const float rn = 1.0f / sqrtf(wave_sum(s) * (1.f / DM) + NORM_EPS);
            float fa[8];
#pragma unroll
            for (int h = 0; h < 8; ++h) fa[h] = 0.f;
#pragma unroll
            for (int j = 0; j < 4; ++j) { v[j] = v[j] * rn * gv[j];
#pragma unroll
                for (int e = 0; e < 4; ++e) { const float* wp = win + (size_t)(4 * F.lane + 256 * j + e) * INCOLS + 1536; const f32x4 w0 = *(const f32x4*)wp, w1 = *(const f32x4*)(wp + 4);
                    const float u = v[j][e]; fa[0] += u * w0.x; fa[1] += u * w0.y; fa[2] += u * w0.z; fa[3] += u * w0.w; fa[4] += u * w1.x; fa[5] += u * w1.y; fa[6] += u * w1.z; fa[7] += u * w1.w; } }
            GAS unsigned long long* o8 = (GAS unsigned long long*)(XN + (size_t)m * DM) + F.lane;
#pragma unroll
            for (int j = 0; j < 4; ++j) o8[64 * j] = (unsigned long long)pk2(v[j].x, v[j].y) | ((unsigned long long)pk2(v[j].z, v[j].w) << 32);
#pragma unroll
            for (int h = 0; h < 8; ++h) fa[h] = wave_sum(fa[h]);
            if (F.lane < 8) { float f = fa[0];
#pragma unroll
                for (int h = 1; h < 8; ++h) f = (F.lane == h) ? fa[h] : f;
                f += fb[F.lane];
                const float ls = fminf(f, 0.f) - log1pf(__expf(-fabsf(f)));
                LS[(size_t)m * 8 + F.lane] = ls; }
        }
    }
    {
        const float* g1 = F.in[I_MEMG]; bf16_t* XN = (bf16_t*)(F.ws + WS_XNALL) + (size_t)M * DM;
        f32x4 gv[4];
#pragma unroll
        for (int j = 0; j < 4; ++j) gv[j] = *(const f32x4*)(g1 + 4 * F.lane + 256 * j);
        for (int m = gw; m < MMEM; m += NGW) {
            const GAS f32x4* xr = (const GAS f32x4*)(F.in[I_MEM] + (size_t)m * DM) + F.lane;
            f32x4 v[4]; float s = 0.f;
#pragma unroll
            for (int j = 0; j < 4; ++j) { v[j] = xr[64 * j]; s += (v[j].x * v[j].x + v[j].y * v[j].y) + (v[j].z * v[j].z + v[j].w * v[j].w); }
            const float rn = 1.0f / sqrtf(wave_sum(s) * (1.f / DM) + NORM_EPS);
            GAS unsigned long long* o8 = (GAS unsigned long long*)(XN + (size_t)m * DM) + F.lane;
#pragma unroll
            for (int j = 0; j < 4; ++j) { v[j] = v[j] * rn * gv[j]; o8[64 * j] = (unsigned long long)pk2(v[j].x, v[j].y) | ((unsigned long long)pk2(v[j].z, v[j].w) << 32); }
        }
    }
}

__device__ __forceinline__ void load_row_bf16(const bf16_t* p, int lane, f32x4 (&v)[4]) {
#pragma unroll
    for (int j = 0; j < 4; ++j) { const u32x2 w = *(const u32x2*)(p + 4 * lane + 256 * j); v[j] = (f32x4){bflo(w.x), bfhi(w.x), bflo(w.y), bfhi(w.y)}; }
}
__device__ __forceinline__ void p3c_rows(Frame& F) {
    const int gw = F.vcu * NWAVES + F.wave, NGW = F.G * NWAVES;
    const bf16_t* Y = (const bf16_t*)(F.ws + WS_Y); bf16_t* U2 = (bf16_t*)(F.ws + WS_U2);
    f32x4 g1[4], g2[4];
#pragma unroll
    for (int j = 0; j < 4; ++j) { g1[j] = *(const f32x4*)(F.in[I_POST1] + 4 * F.lane + 256 * j); g2[j] = *(const f32x4*)(F.in[I_PRE2] + 4 * F.lane + 256 * j); }
    for (int m = gw; m < M; m += NGW) {
        f32x4 y[4]; load_row_bf16(Y + (size_t)m * DM, F.lane, y);
        float s = 0.f;
#pragma unroll
        for (int j = 0; j < 4; ++j) s += (y[j].x * y[j].x + y[j].y * y[j].y) + (y[j].z * y[j].z + y[j].w * y[j].w);
        const float rn = 1.0f / sqrtf(wave_sum(s) * (1.f / DM) + NORM_EPS);
        const GAS f32x4* xr = (const GAS f32x4*)(F.in[I_X] + (size_t)m * DM) + F.lane;
        GAS f32x4* hr = (GAS f32x4*)(F.out + (size_t)m * DM) + F.lane;
        float s2 = 0.f;
#pragma unroll
        for (int j = 0; j < 4; ++j) { y[j] = xr[64 * j] + y[j] * rn * g1[j]; hr[64 * j] = y[j]; s2 += (y[j].x * y[j].x + y[j].y * y[j].y) + (y[j].z * y[j].z + y[j].w * y[j].w); }
        const float rn2 = 1.0f / sqrtf(wave_sum(s2) * (1.f / DM) + NORM_EPS);
        GAS unsigned long long* o8 = (GAS unsigned long long*)(U2 + (size_t)m * DM) + F.lane;
#pragma unroll
        for (int j = 0; j < 4; ++j) { const f32x4 u = y[j] * rn2 * g2[j]; o8[64 * j] = (unsigned long long)pk2(u.x, u.y) | ((unsigned long long)pk2(u.z, u.w) << 32); }
    }
}
__device__ __forceinline__ void p5c_rows(Frame& F) {
    const int gw = F.vcu * NWAVES + F.wave, NGW = F.G * NWAVES;
    const bf16_t* FO = (const bf16_t*)(F.ws + WS_FO);
    f32x4 g1[4];
#pragma unroll
    for (int j = 0; j < 4; ++j) g1[j] = *(const f32x4*)(F.in[I_POST2] + 4 * F.lane + 256 * j);
    for (int m = gw; m < M; m += NGW) {
        f32x4 y[4]; load_row_bf16(FO + (size_t)m * DM, F.lane, y);
        float s = 0.f;
#pragma unroll
        for (int j = 0; j < 4; ++j) s += (y[j].x * y[j].x + y[j].y * y[j].y) + (y[j].z * y[j].z + y[j].w * y[j].w);
        const float rn = 1.0f / sqrtf(wave_sum(s) * (1.f / DM) + NORM_EPS);
        GAS f32x4* hr = (GAS f32x4*)(F.out + (size_t)m * DM) + F.lane;
#pragma unroll
        for (int j = 0; j < 4; ++j) hr[64 * j] = hr[64 * j] + y[j] * rn * g1[j];
    }
}

__device__ __forceinline__ void fox_simple_unit(Frame& F, int b, int h, int qb) {
    const int tid = F.tid, lane = F.lane, wave = F.wave;
    LAS float* cs = (LAS float*)(F.lds);
    LAS bf16_t* Kt = (LAS bf16_t*)(F.lds + 8192);
    LAS bf16_t* Vt = (LAS bf16_t*)(F.lds + 16384);
    LAS float* wt = (LAS float*)(F.lds + 24576);
    const bf16_t* PJ = (const bf16_t*)(F.ws + WS_PROJA);
    __syncthreads();
    {
        const float* ls = (const float*)(F.ws + WS_LS) + (size_t)b * SEQ * 8 + h;
        const float e0 = ls[(4 * tid + 0) * 8], e1 = ls[(4 * tid + 1) * 8], e2 = ls[(4 * tid + 2) * 8], e3 = ls[(4 * tid + 3) * 8];
        const float s = (e0 + e1) + (e2 + e3); float inc = s;
#pragma unroll
        for (int o = 1; o < 64; o <<= 1) { const float n = __shfl_up(inc, o); if (lane >= o) inc += n; }
        if (lane == 63) wt[wave] = inc;
        __syncthreads();
        float base = 0.f;
        for (int w = 0; w < wave; ++w) base += wt[w];
        float c = base + inc - s;
        c += e0; cs[4 * tid + 0] = c * LOG2E; c += e1; cs[4 * tid + 1] = c * LOG2E; c += e2; cs[4 * tid + 2] = c * LOG2E; c += e3; cs[4 * tid + 3] = c * LOG2E;
    }
    const int q = qb * 512 + tid; const size_t row = (size_t)b * SEQ + q;
    float qf[64], o[64];
#pragma unroll
    for (int c = 0; c < 8; ++c) { const u32x4 w = *(const u32x4*)(PJ + row * PA + C_FQ + h * 64 + c * 8);
        qf[8 * c + 0] = bflo(w.x); qf[8 * c + 1] = bfhi(w.x); qf[8 * c + 2] = bflo(w.y); qf[8 * c + 3] = bfhi(w.y); qf[8 * c + 4] = bflo(w.z); qf[8 * c + 5] = bfhi(w.z); qf[8 * c + 6] = bflo(w.w); qf[8 * c + 7] = bfhi(w.w); }
#pragma unroll
    for (int d = 0; d < 64; ++d) o[d] = 0.f;
    float mrun = -1e30f, l = 0.f;
    const int ntile = (qb + 1) * 8; const int qwmax = qb * 512 + wave * 64 + 63;
    for (int kt = 0; kt < ntile; ++kt) {
        __syncthreads();
        { const size_t krow = (size_t)b * SEQ + kt * 64 + (tid >> 3);
          const u32x4 kv = *(const u32x4*)(PJ + krow * PA + C_FK + h * 64 + (tid & 7) * 8);
          const u32x4 vv = *(const u32x4*)(PJ + krow * PA + C_FV + h * 64 + (tid & 7) * 8);
          *(LAS u32x4*)(Kt + (tid >> 3) * 64 + (tid & 7) * 8) = kv; *(LAS u32x4*)(Vt + (tid >> 3) * 64 + (tid & 7) * 8) = vv; }
        __syncthreads();
        const int kbase = kt * 64;
        if (kbase <= qwmax) {
#pragma unroll 1
            for (int kk = 0; kk < 64; ++kk) {
                const int kidx = kbase + kk;
                float s0 = 0.f, s1 = 0.f;
#pragma unroll
                for (int c = 0; c < 8; ++c) { const u32x4 w = *(const LAS u32x4*)(Kt + kk * 64 + c * 8);
                    s0 += qf[8 * c + 0] * bflo(w.x) + qf[8 * c + 2] * bflo(w.y) + qf[8 * c + 4] * bflo(w.z) + qf[8 * c + 6] * bflo(w.w);
                    s1 += qf[8 * c + 1] * bfhi(w.x) + qf[8 * c + 3] * bfhi(w.y) + qf[8 * c + 5] * bfhi(w.z) + qf[8 * c + 7] * bfhi(w.w); }
                const bool ok = kidx <= q;
                const float s = ok ? (s0 + s1 - cs[kidx]) : -1e30f;
                const float mn = fmaxf(mrun, s); const float al = __builtin_amdgcn_exp2f(mrun - mn); const float p = ok ? __builtin_amdgcn_exp2f(s - mn) : 0.f;
                l = l * al + p; mrun = mn;
#pragma unroll
                for (int c = 0; c < 8; ++c) { const u32x4 w = *(const LAS u32x4*)(Vt + kk * 64 + c * 8);
                    o[8 * c + 0] = o[8 * c + 0] * al + p * bflo(w.x); o[8 * c + 1] = o[8 * c + 1] * al + p * bfhi(w.x); o[8 * c + 2] = o[8 * c + 2] * al + p * bflo(w.y); o[8 * c + 3] = o[8 * c + 3] * al + p * bfhi(w.y);
                    o[8 * c + 4] = o[8 * c + 4] * al + p * bflo(w.z); o[8 * c + 5] = o[8 * c + 5] * al + p * bfhi(w.z); o[8 * c + 6] = o[8 * c + 6] * al + p * bflo(w.w); o[8 * c + 7] = o[8 * c + 7] * al + p * bfhi(w.w); }
            }
        }
    }
    const float rl = 1.0f / l;
    bf16_t* op = (bf16_t*)(F.ws + WS_PROJA) + row * PA + C_FQ + h * 64;
#pragma unroll
    for (int c = 0; c < 8; ++c) { u32x4 w; w.x = pk2(o[8 * c + 0] * rl, o[8 * c + 1] * rl); w.y = pk2(o[8 * c + 2] * rl, o[8 * c + 3] * rl); w.z = pk2(o[8 * c + 4] * rl, o[8 * c + 5] * rl); w.w = pk2(o[8 * c + 6] * rl, o[8 * c + 7] * rl);
        *(u32x4*)(op + c * 8) = w; }
}


namespace fox {
using s16x4=__attribute__((ext_vector_type(4)))short;
using f32x16=__attribute__((ext_vector_type(16)))float;
constexpr int D=64;
constexpr int NW=8,QBLK=32,QB=QBLK*NW,KVBLK=64,NQB=SEQ/QB;
__device__ __forceinline__ int crow(int r,int hi){return (r&3)+8*(r>>2)+4*hi;}
#define SBAR() __builtin_amdgcn_sched_barrier(0)
__device__ __forceinline__ void cmask(f32x16&p0,f32x16&p1,int jb,int qrel,int hi){
  const float NEG=-INFINITY; int kb=64*jb+4*hi;
  #pragma unroll
  for(int r=0;r<16;++r){int kv=kb+(r&3)+8*(r>>2); if(kv>qrel)p0[r]=NEG; if(kv+32>qrel)p1[r]=NEG;}
}
constexpr int NSLOT=3, SLOTB=8192;
constexpr int LDS_K=0, LDS_V=NSLOT*SLOTB, LDS_WS=2*NSLOT*SLOTB, LDS_OST=LDS_WS+NW*64*4, LDS_CB=LDS_OST+NW*4096, LDS_SCAN=LDS_CB+8192, LDS_BYTES_=LDS_SCAN+64;
__device__ __forceinline__ void glds16(const void*gsrc,unsigned lds_dst){unsigned keep;
  asm volatile("s_mov_b32 %0, m0\n\ts_mov_b32 m0, %2\n\ts_nop 0\n\tglobal_load_lds_dwordx4 %1, off\n\ts_mov_b32 m0, %0":"=&s"(keep):"v"(gsrc),"s"(lds_dst):"memory");}
__device__ __forceinline__ float max3f(float a,float b,float c){float r;asm("v_max3_f32 %0, %1, %2, %3":"=v"(r):"v"(a),"v"(b),"v"(c));return r;}
__device__ __forceinline__ float max2f(float a,float b){float r;asm("v_max_f32_e32 %0, %1, %2":"=v"(r):"v"(a),"v"(b));return r;}
__device__ __forceinline__ float fadd_s(float a,float b){float r;asm("v_add_f32_e32 %0, %1, %2":"=v"(r):"v"(a),"v"(b));return r;}
__device__ __forceinline__ float fsub_s(float a,float b){float r;asm("v_sub_f32_e32 %0, %1, %2":"=v"(r):"v"(a),"v"(b));return r;}
typedef float f32x2_t __attribute__((ext_vector_type(2))); typedef __bf16 bf16x2v_t __attribute__((ext_vector_type(2)));
__device__ __forceinline__ unsigned cvtpk_s(float lo,float hi){f32x2_t v={lo,hi};bf16x2v_t b=__builtin_convertvector(v,bf16x2v_t);return __builtin_bit_cast(unsigned,b);}
#define WAIT_BAR(N) asm volatile("s_waitcnt vmcnt(" #N ") lgkmcnt(0)\n\ts_barrier":::"memory")
#define KBF(w) (kbw[0]=(w),kbw)

__device__ __forceinline__ void qkt(f32x16&p0,f32x16&p1,const char*Kslot,const bf16x8*qr,int r32,int hi,u32x4 kb0,u32x4 kb1,bf16x8 qr4){
  const char*kb=Kslot+hi*1024+r32*16;
  #pragma unroll
  for(int d0=0;d0<4;++d0){
    const bf16x8 b0=*reinterpret_cast<const bf16x8*>(kb+d0*2048);
    const bf16x8 b1=*reinterpret_cast<const bf16x8*>(kb+d0*2048+512);
    if(d0==0){p0=__builtin_amdgcn_mfma_f32_32x32x16_bf16(b0,qr[0],f32x16{},0,0,0);p1=__builtin_amdgcn_mfma_f32_32x32x16_bf16(b1,qr[0],f32x16{},0,0,0);}
    else{p0=__builtin_amdgcn_mfma_f32_32x32x16_bf16(b0,qr[d0],p0,0,0,0);p1=__builtin_amdgcn_mfma_f32_32x32x16_bf16(b1,qr[d0],p1,0,0,0);}}
  p0=__builtin_amdgcn_mfma_f32_32x32x16_bf16(__builtin_bit_cast(bf16x8,kb0),qr4,p0,0,0,0);p1=__builtin_amdgcn_mfma_f32_32x32x16_bf16(__builtin_bit_cast(bf16x8,kb1),qr4,p1,0,0,0);
}
typedef __attribute__((address_space(3))) const char* lds_cptr;
typedef short v4i16_t __attribute__((ext_vector_type(4)));
__device__ __forceinline__ void kload8(bf16x8*kf,lds_cptr kp){
  kf[0]=*(const __attribute__((address_space(3))) bf16x8*)(kp);      kf[1]=*(const __attribute__((address_space(3))) bf16x8*)(kp+512);
  kf[2]=*(const __attribute__((address_space(3))) bf16x8*)(kp+2048); kf[3]=*(const __attribute__((address_space(3))) bf16x8*)(kp+2560);
  kf[4]=*(const __attribute__((address_space(3))) bf16x8*)(kp+4096); kf[5]=*(const __attribute__((address_space(3))) bf16x8*)(kp+4608);
  kf[6]=*(const __attribute__((address_space(3))) bf16x8*)(kp+6144); kf[7]=*(const __attribute__((address_space(3))) bf16x8*)(kp+6656);
}
__device__ __forceinline__ void kload2(bf16x8*kf,lds_cptr kp,int j){ kf[2*j]=*(const __attribute__((address_space(3))) bf16x8*)(kp+j*2048); kf[2*j+1]=*(const __attribute__((address_space(3))) bf16x8*)(kp+j*2048+512); }
__device__ __forceinline__ s16x4 vtr(lds_cptr p){ return __builtin_bit_cast(s16x4,__builtin_amdgcn_ds_read_tr16_b64_v4i16((__attribute__((address_space(3))) v4i16_t*)p)); }
__device__ __forceinline__ float rowmax(const f32x16&p0,const f32x16&p1){
  float a=max3f(p0[0],p0[1],p1[0]),b=max3f(p0[2],p0[3],p1[1]);a=max3f(a,p1[2],p1[3]);
  #pragma unroll
  for(int r=4;r<16;r+=4){a=max3f(a,p0[r],p0[r+1]);b=max3f(b,p0[r+2],p0[r+3]);a=max3f(a,p1[r],p1[r+1]);b=max3f(b,p1[r+2],p1[r+3]);}
  const float m=max2f(a,b);
  auto rr=__builtin_amdgcn_permlane32_swap(__float_as_uint(m),__float_as_uint(m),false,false);
  return max2f(__uint_as_float(rr[0]),__uint_as_float(rr[1]));
}
__device__ __forceinline__ void pv(f32x16*o,int vb,bf16x8 pa0,bf16x8 pa1,bf16x8 pa2,bf16x8 pa3){
  #pragma unroll
  for(int d0=0;d0<2;++d0){s16x4 lo[4],hi[4];
    #pragma unroll
    for(int ks=0;ks<4;++ks){
      asm volatile("ds_read_b64_tr_b16 %0,%1 offset:%c2":"=&v"(lo[ks]):"v"(vb),"i"(d0*4096+ks*1024):"memory");
      asm volatile("ds_read_b64_tr_b16 %0,%1 offset:%c2":"=&v"(hi[ks]):"v"(vb),"i"(d0*4096+ks*1024+512):"memory");}
    asm volatile("s_waitcnt lgkmcnt(0)":::"memory");SBAR();
    #define PK(k) (bf16x8){lo[k][0],lo[k][1],lo[k][2],lo[k][3],hi[k][0],hi[k][1],hi[k][2],hi[k][3]}
    o[d0]=__builtin_amdgcn_mfma_f32_32x32x16_bf16(pa0,PK(0),o[d0],0,0,0);
    o[d0]=__builtin_amdgcn_mfma_f32_32x32x16_bf16(pa1,PK(1),o[d0],0,0,0);
    o[d0]=__builtin_amdgcn_mfma_f32_32x32x16_bf16(pa2,PK(2),o[d0],0,0,0);
    o[d0]=__builtin_amdgcn_mfma_f32_32x32x16_bf16(pa3,PK(3),o[d0],0,0,0);
    #undef PK
  }
}
#define ATTN_STORE16(p,v) (*(u32x4*)(p)=(v))
template<int THRL> __device__ __forceinline__ void attn_unit(int b,int h,int qb,bf16_t*PJ,const float*LS,char*shm){
  int tid=threadIdx.x; asm volatile("":"+v"(tid));
  const int lane=tid&63,r32=lane&31,hi=lane>>5; const int wid=__builtin_amdgcn_readfirstlane(tid>>6);
  const long rowbase=(long)b*SEQ; const int q0=qb*QB;
  { float*cs=(float*)(shm+LDS_CB); float*wt=(float*)(shm+LDS_SCAN);
    const float*ls=LS+(size_t)rowbase*8+h;
    const float e0=ls[(4*tid+0)*8],e1=ls[(4*tid+1)*8],e2=ls[(4*tid+2)*8],e3=ls[(4*tid+3)*8];
    const float s=(e0+e1)+(e2+e3); float inc=s;
    #pragma unroll
    for(int o=1;o<64;o<<=1){const float n=__shfl_up(inc,o); if(lane>=o)inc+=n;}
    if(lane==63)wt[wid]=inc;
    __syncthreads();
    float base=0.f; for(int w=0;w<wid;++w)base+=wt[w];
    float c=base+inc-s; c+=e0; const float c0=c; c+=e1; const float c1=c; c+=e2; const float c2=c; c+=e3; const float c3=c;
    cs[4*tid+0]=c0;cs[4*tid+1]=c1;cs[4*tid+2]=c2;cs[4*tid+3]=c3;
    __syncthreads();
    const float cref=cs[q0+QB-1];
    __syncthreads();
    unsigned*cbw=(unsigned*)cs; const float cc[4]={c0,c1,c2,c3};
    #pragma unroll
    for(int e=0;e<4;++e){ const float bv=(cref-cc[e])*LOG2E; const unsigned bh=f2bf(bv); const float res=bv-__builtin_bit_cast(float,bh<<16); cbw[4*tid+e]=bh|(f2bf(res)<<16); }
    __syncthreads();
  }
  const bf16_t*Qw=PJ+(rowbase+q0+wid*QBLK)*PA+C_FQ+h*D;
  const bf16_t*Kh=PJ+rowbase*PA+C_FK+h*D,*Vh=PJ+rowbase*PA+C_FV+h*D;
  const unsigned lds0=(unsigned)(uintptr_t)shm;
  float*wsf=(float*)(shm+LDS_WS)+wid*64;
  const bf16_t*ksrc=Kh+(long)lane*PA+wid*8;
  const bf16_t*vsrc=Vh+(long)(16*(wid&3)+(lane>>2))*PA+(wid>>2)*32+(lane&3)*8;
  const unsigned kdst=lds0+LDS_K+wid*1024, vdst=lds0+LDS_V+wid*1024;
  #define DMA_K(t,slot) glds16(ksrc+(long)(t)*KVBLK*PA,(unsigned)__builtin_amdgcn_readfirstlane(kdst+(slot)))
  #define DMA_V(t,slot) glds16(vsrc+(long)(t)*KVBLK*PA,(unsigned)__builtin_amdgcn_readfirstlane(vdst+(slot)))
  const int vb0=(int)(lds0+LDS_V)+((lane>>4)&1)*32+(lane&3)*8+(4*hi+((lane&15)>>2))*64;
  const char*Kbase=shm+LDS_K; bf16x8 kf[8];
  const lds_cptr shm3=(lds_cptr)shm; const lds_cptr kp0=shm3+LDS_K+hi*1024+r32*16; const lds_cptr vp0=shm3+LDS_V+((lane>>4)&1)*32+(lane&3)*8+(4*hi+((lane&15)>>2))*64;
  const __attribute__((address_space(3))) unsigned* cbp=(const __attribute__((address_space(3))) unsigned*)(shm3+LDS_CB)+r32;
  const unsigned kone1=hi?0u:0x3F803F80u, kone2=hi?0u:0x00003F80u;
  u32x4 kbw=(u32x4){0u,kone1,kone2,0u};
  u32x4 q4w=(u32x4){kone1,0u,0u,0u};
  #define QR4 __builtin_bit_cast(bf16x8,q4w)
  #define SETM() do{ const float nm_=-mhat; const unsigned h1_=f2bf(nm_); const float r1_=nm_-__builtin_bit_cast(float,h1_<<16); const unsigned h2_=f2bf(r1_); const float r2_=r1_-__builtin_bit_cast(float,h2_<<16); \
      q4w[1]=hi?0u:(h1_|(h2_<<16)); q4w[2]=hi?0u:f2bf(r2_); }while(0)
  #define BW(t,half) (hi?0u:cbp[(t)*64+(half)*32])
  const int NT=(q0+QB)/KVBLK;
  DMA_K(0,0);DMA_V(0,0);DMA_K(1,SLOTB);
  bf16x8 qr[4];
  #pragma unroll
  for(int d0=0;d0<4;++d0)qr[d0]=*reinterpret_cast<const bf16x8*>(&Qw[(long)r32*PA+d0*16+hi*8]);
  float mhat=0.f,l_reg=0.f;f32x16 o[2];o[0]=f32x16{};o[1]=f32x16{};
  const int qrel=wid*QBLK+r32;
  #define CMASK(P0,P1,t) do{int jb_=(t)-(NT-4); if(jb_>=0)cmask(P0,P1,jb_,qrel,hi);}while(0)
  bool resc=false;
  #define START(P0,P1) do{ const float rm=rowmax(P0,P1); resc=false; \
    { const float dl=rm; mhat=fadd_s(mhat,dl); \
      _Pragma("unroll") for(int r=0;r<16;++r){P0[r]=fsub_s(P0[r],dl);P1[r]=fsub_s(P1[r],dl);} \
      SETM(); } \
    _Pragma("unroll") for(int r=0;r<16;++r)P0[r]=__builtin_amdgcn_exp2f(P0[r]); }while(0)
  #define RESC() do{ if(resc){ asm volatile("s_waitcnt lgkmcnt(0)":::"memory"); \
      _Pragma("unroll") for(int d_=0;d_<2;++d_) _Pragma("unroll") for(int r=0;r<16;++r)o[d_][r]*=wsf[crow(r,hi)]; } }while(0)
  f32x16 pA0,pA1,pB0,pB1;
  int sl_prev=0,sl_cur=0,sl_next=SLOTB;
  #define ROT() do{sl_prev=sl_cur;sl_cur=sl_next;sl_next=(sl_next==(NSLOT-1)*SLOTB)?0:sl_next+SLOTB;}while(0)
  DMA_K(2,2*SLOTB);
  WAIT_BAR(3);
  { const unsigned bw0=BW(0,0),bw1=BW(0,1);
    u32x4 k0_=kbw; k0_[0]=bw0; u32x4 k1_=kbw; k1_[0]=bw1; qkt(pA0,pA1,Kbase,qr,r32,hi,k0_,k1_,QR4);asm volatile("s_nop 15\n\ts_nop 7":"+v"(pA0),"+v"(pA1));CMASK(pA0,pA1,0); }
  START(pA0,pA1);
  _Pragma("unroll") for(int r=0;r<16;++r)pA1[r]=__builtin_amdgcn_exp2f(pA1[r]);
  WAIT_BAR(0);
  DMA_K(3,0);DMA_V(1,SLOTB);
  ROT();
  kload8(kf,kp0+sl_cur);
  WAIT_BAR(2);
  s16x4 vlo[8],vhi[8]; u32x4 pw0,pw1,pw2,pw3;
  #define PKW(P,B) cvtpk_s(P[B],P[B+1])
  #define PAF(k) __builtin_bit_cast(bf16x8,pw##k)
  #define VFR(i) (bf16x8){vlo[i][0],vlo[i][1],vlo[i][2],vlo[i][3],vhi[i][0],vhi[i][1],vhi[i][2],vhi[i][3]}
  #define PIN(x) asm volatile("":"+v"(x))
  #define MX3(a,b,c) __builtin_fmaxf(__builtin_fmaxf((a),(b)),(c))
  #define GAPA(MF,A0,A1,A2,A3,W0,W1,PW) do{ MF; sacc+=A0; sacc+=A1; sacc+=A2; sacc+=A3; PIN(sacc); W0; W1; PIN(PW); SBAR(); }while(0)
  #define EX(v) __builtin_amdgcn_exp2f(v)
  #define GAPB(MF,X,B) do{ MF; X[B]=EX(X[B]); X[B+1]=EX(X[B+1]); X[B+2]=EX(X[B+2]); X[B+3]=EX(X[B+3]); PIN(X); SBAR(); }while(0)
  #define VRD(i) do{ vlo[i]=vtr(vp_+(((i)>>2)*4096+((i)&3)*1024)); vhi[i]=vtr(vp_+(((i)>>2)*4096+((i)&3)*1024+512)); }while(0)
  #define KRD(G,j) do{ if(G){ kload2(kf,kp0+sl_next,j); SBAR(); } }while(0)
  #define STEP(C0,C1,P0,P1,t,GK,GV,GL) do{ SBAR(); \
    const lds_cptr vp_=vp0+sl_prev; const unsigned bw0_=BW(t,0),bw1_=BW(t,1); \
    VRD(0); SBAR(); float sacc=(P0[0]+P0[1]); \
    GAPA(C0=__builtin_amdgcn_mfma_f32_32x32x16_bf16(kf[0],qr[0],f32x16{},0,0,0), P0[2],P0[3],P0[4],P0[5],     pw0[0]=PKW(P0,0), pw0[1]=PKW(P0,2), pw0); \
    VRD(4); SBAR(); GAPA(C1=__builtin_amdgcn_mfma_f32_32x32x16_bf16(kf[1],qr[0],f32x16{},0,0,0), P0[6],P0[7],P0[8],P0[9],     pw0[2]=PKW(P0,4), pw0[3]=PKW(P0,6), pw0); \
    VRD(1); SBAR(); GAPA(C0=__builtin_amdgcn_mfma_f32_32x32x16_bf16(kf[2],qr[1],C0,0,0,0),   P0[10],P0[11],P0[12],P0[13], pw1[0]=PKW(P0,8), pw1[1]=PKW(P0,10), pw1); \
    VRD(5); SBAR(); GAPA(C1=__builtin_amdgcn_mfma_f32_32x32x16_bf16(kf[3],qr[1],C1,0,0,0),   P0[14],P0[15],P1[0],P1[1],   pw1[2]=PKW(P0,12),pw1[3]=PKW(P0,14), pw1); \
    VRD(2); SBAR(); GAPA(C0=__builtin_amdgcn_mfma_f32_32x32x16_bf16(kf[4],qr[2],C0,0,0,0),   P1[2],P1[3],P1[4],P1[5],     pw2[0]=PKW(P1,0), pw2[1]=PKW(P1,2), pw2); \
    VRD(6); SBAR(); GAPA(C1=__builtin_amdgcn_mfma_f32_32x32x16_bf16(kf[5],qr[2],C1,0,0,0),   P1[6],P1[7],P1[8],P1[9],     pw2[2]=PKW(P1,4), pw2[3]=PKW(P1,6), pw2); \
    VRD(3); SBAR(); GAPA(C0=__builtin_amdgcn_mfma_f32_32x32x16_bf16(kf[6],qr[3],C0,0,0,0),   P1[10],P1[11],P1[12],P1[13], pw3[0]=PKW(P1,8), pw3[1]=PKW(P1,10), pw3); \
    VRD(7); SBAR(); GAPA(C1=__builtin_amdgcn_mfma_f32_32x32x16_bf16(kf[7],qr[3],C1,0,0,0),   P1[14],P1[15],0.f,0.f,       pw3[2]=PKW(P1,12),pw3[3]=PKW(P1,14), pw3); \
    C0=__builtin_amdgcn_mfma_f32_32x32x16_bf16(__builtin_bit_cast(bf16x8,KBF(bw0_)),QR4,C0,0,0,0); C1=__builtin_amdgcn_mfma_f32_32x32x16_bf16(__builtin_bit_cast(bf16x8,KBF(bw1_)),QR4,C1,0,0,0); SBAR(); \
    l_reg+=sacc; \
    if(GK){DMA_K((t)+3,sl_cur);} if(GV){DMA_V((t)+1,sl_next);} \
    CMASK(C0,C1,t); \
    { float a=MX3(C0[0],C0[1],C1[0]),b=MX3(C0[2],C0[3],C1[1]); a=MX3(a,C1[2],C1[3]); \
      _Pragma("unroll") for(int r=4;r<16;r+=4){a=MX3(a,C0[r],C0[r+1]);b=MX3(b,C0[r+2],C0[r+3]);a=MX3(a,C1[r],C1[r+1]);b=MX3(b,C1[r+2],C1[r+3]);} \
      float rm=__builtin_fmaxf(a,b); { auto rr=__builtin_amdgcn_permlane32_swap(__float_as_uint(rm),__float_as_uint(rm),false,false); rm=__builtin_fmaxf(__uint_as_float(rr[0]),__uint_as_float(rr[1])); } \
      resc=false; \
      if(__builtin_expect(__any(rm>(float)THRL),0)){ const float dl=__builtin_fmaxf(rm,0.f); mhat+=dl; \
        _Pragma("unroll") for(int r=0;r<16;++r){C0[r]-=dl;C1[r]-=dl;} \
        SETM(); \
        const float f=__builtin_amdgcn_exp2f(-dl); l_reg*=f; if(hi==0)wsf[r32]=f; resc=true; } } \
    SBAR(); \
    GAPB(o[0]=__builtin_amdgcn_mfma_f32_32x32x16_bf16(PAF(0),VFR(0),o[0],0,0,0), C0,0); \
    GAPB(o[1]=__builtin_amdgcn_mfma_f32_32x32x16_bf16(PAF(0),VFR(4),o[1],0,0,0), C0,4); \
    KRD(GL,0); GAPB(o[0]=__builtin_amdgcn_mfma_f32_32x32x16_bf16(PAF(1),VFR(1),o[0],0,0,0), C0,8); \
    KRD(GL,1); GAPB(o[1]=__builtin_amdgcn_mfma_f32_32x32x16_bf16(PAF(1),VFR(5),o[1],0,0,0), C0,12); \
    KRD(GL,2); GAPB(o[0]=__builtin_amdgcn_mfma_f32_32x32x16_bf16(PAF(2),VFR(2),o[0],0,0,0), C1,0); \
    KRD(GL,3); GAPB(o[1]=__builtin_amdgcn_mfma_f32_32x32x16_bf16(PAF(2),VFR(6),o[1],0,0,0), C1,4); \
    GAPB(o[0]=__builtin_amdgcn_mfma_f32_32x32x16_bf16(PAF(3),VFR(3),o[0],0,0,0), C1,8); \
    GAPB(o[1]=__builtin_amdgcn_mfma_f32_32x32x16_bf16(PAF(3),VFR(7),o[1],0,0,0), C1,12); \
    }while(0)
  int t=1;
  #undef CMASK
  #define CMASK(P0,P1,t) do{}while(0)
  for(;t+5<NT;t+=2){
    STEP(pB0,pB1,pA0,pA1,t,true,true,true);     WAIT_BAR(2); RESC(); ROT();
    STEP(pA0,pA1,pB0,pB1,t+1,true,true,true);   WAIT_BAR(2); RESC(); ROT();
  }
  #undef CMASK
  #define CMASK(P0,P1,t) do{int jb_=(t)-(NT-4); if(jb_>=0)cmask(P0,P1,jb_,qrel,hi);}while(0)
  #define ENDW(tt) do{ if((tt)+3<NT){WAIT_BAR(2);} else if((tt)+2<NT){WAIT_BAR(1);} else {WAIT_BAR(0);} }while(0)
  for(;t+1<NT;t+=2){
    STEP(pB0,pB1,pA0,pA1,t,(t+3<NT),(t+1<NT),(t+1<NT));       ENDW(t);   RESC(); ROT();
    STEP(pA0,pA1,pB0,pB1,t+1,(t+4<NT),(t+2<NT),(t+2<NT));     ENDW(t+1); RESC(); ROT();
  }
  STEP(pB0,pB1,pA0,pA1,NT-1,false,false,false); RESC();
  { float sacc=pB0[0]+pB0[1]; _Pragma("unroll") for(int r=2;r<16;++r)sacc+=pB0[r]; _Pragma("unroll") for(int r=0;r<16;++r)sacc+=pB1[r]; l_reg+=sacc;
    pw0=(u32x4){PKW(pB0,0),PKW(pB0,2),PKW(pB0,4),PKW(pB0,6)};pw1=(u32x4){PKW(pB0,8),PKW(pB0,10),PKW(pB0,12),PKW(pB0,14)};pw2=(u32x4){PKW(pB1,0),PKW(pB1,2),PKW(pB1,4),PKW(pB1,6)};pw3=(u32x4){PKW(pB1,8),PKW(pB1,10),PKW(pB1,12),PKW(pB1,14)};
    SBAR(); pv(o,vb0+sl_cur,PAF(0),PAF(1),PAF(2),PAF(3)); }
  #undef PKW
  #undef PAF
  #undef VFR
  #undef PIN
  #undef MX3
  #undef GAPA
  #undef GAPB
  #undef EX
  #undef VRD
  #undef KRD
  #undef STEP
  #undef ENDW
  {auto rr=__builtin_amdgcn_permlane32_swap(__float_as_uint(l_reg),__float_as_uint(l_reg),false,false);l_reg=__uint_as_float(rr[0])+__uint_as_float(rr[1]);}
  if(hi==0)wsf[32+r32]=l_reg;asm volatile("s_waitcnt lgkmcnt(0)":::"memory");
  float rli[16];
  #pragma unroll
  for(int r=0;r<16;++r)rli[r]=__builtin_amdgcn_rcpf(wsf[32+crow(r,hi)]);
  bf16_t*Ow=PJ+(rowbase+q0+wid*QBLK)*PA+C_FQ+h*D;
  { bf16_t*stg=(bf16_t*)(shm+LDS_OST)+wid*2048;
    #pragma unroll
    for(int r=0;r<16;++r){const int orow=crow(r,hi);
      #pragma unroll
      for(int d0=0;d0<2;++d0)stg[orow*64+d0*32+r32]=(bf16_t)f2bf(o[d0][r]*rli[r]);}
    asm volatile("s_waitcnt lgkmcnt(0)":::"memory");
    #pragma unroll
    for(int i=0;i<4;++i){const int row=i*8+(lane>>3),ch=lane&7; const u32x4 v=*(const u32x4*)(stg+row*64+ch*8); ATTN_STORE16(Ow+(long)row*PA+ch*8,v);} }
  asm volatile("s_waitcnt lgkmcnt(0)\n\ts_barrier":::"memory");
  #undef DMA_K
  #undef DMA_V
  #undef CMASK
  #undef START
  #undef RESC
  #undef ROT
  #undef BW
  #undef QR4
  #undef SETM
}
#undef SBAR
#undef WAIT_BAR
#undef KBF
}


namespace memx {
using fox::f32x16; using fox::s16x4; using fox::crow; using fox::glds16; using fox::cvtpk_s; using fox::vtr; using fox::lds_cptr; using fox::max3f; using fox::max2f;
__device__ __forceinline__ void load_kv(int b,int hd,bool loadv,const bf16_t*KV,char*shm,int wid,int lane){
  const unsigned lds0=(unsigned)(uintptr_t)shm;
  const bf16_t*Kb=KV+(size_t)b*MEMLEN*1024+hd*128; const bf16_t*Vb=Kb+512;
  #pragma unroll
  for(int blk=0;blk<4;++blk){
    #pragma unroll
    for(int cc=0;cc<2;++cc){ const int c=wid+8*cc;
      glds16(Kb+(size_t)(blk*64+lane)*1024+c*8,(unsigned)__builtin_amdgcn_readfirstlane(lds0+blk*16384+c*1024)); }
    if(loadv)
    #pragma unroll
    for(int dh=0;dh<2;++dh){
      glds16(Vb+(size_t)(blk*64+16*(wid&3)+(lane>>2))*1024+dh*64+(wid>>2)*32+(lane&3)*8,(unsigned)__builtin_amdgcn_readfirstlane(lds0+65536+(blk*2+dh)*8192+wid*1024)); }
  }
}
__device__ __forceinline__ void unit(int b,int hd,int qb,bool loadv,bf16_t*PJ,const bf16_t*KV,char*shm){
  int tid=threadIdx.x; asm volatile("":"+v"(tid));
  const int lane=tid&63,r32=lane&31,hi=lane>>5; const int wid=__builtin_amdgcn_readfirstlane(tid>>6);
  load_kv(b,hd,loadv,KV,shm,wid,lane);
  const size_t row0=(size_t)b*SEQ+qb*256+wid*32;
  const bf16_t*Qw=PJ+row0*PA+C_MQ+hd*128;
  bf16x8 qr[8];
  #pragma unroll
  for(int d0=0;d0<8;++d0)qr[d0]=*reinterpret_cast<const bf16x8*>(&Qw[(size_t)r32*PA+d0*16+hi*8]);
  asm volatile("s_waitcnt vmcnt(0)":::"memory"); __syncthreads();
  f32x16 p[8];
  const lds_cptr shm3=(lds_cptr)shm;
  #pragma unroll
  for(int blk=0;blk<4;++blk){
    const lds_cptr kb=shm3+blk*16384+hi*1024+r32*16;
    #pragma unroll
    for(int d0=0;d0<8;++d0){
      const bf16x8 k0=*(const __attribute__((address_space(3))) bf16x8*)(kb+d0*2048);
      const bf16x8 k1=*(const __attribute__((address_space(3))) bf16x8*)(kb+d0*2048+512);
      if(d0==0){p[2*blk]=__builtin_amdgcn_mfma_f32_32x32x16_bf16(k0,qr[0],f32x16{},0,0,0);p[2*blk+1]=__builtin_amdgcn_mfma_f32_32x32x16_bf16(k1,qr[0],f32x16{},0,0,0);}
      else{p[2*blk]=__builtin_amdgcn_mfma_f32_32x32x16_bf16(k0,qr[d0],p[2*blk],0,0,0);p[2*blk+1]=__builtin_amdgcn_mfma_f32_32x32x16_bf16(k1,qr[d0],p[2*blk+1],0,0,0);}
    }
  }
  float m=p[0][0];
  #pragma unroll
  for(int i=0;i<8;++i){
    #pragma unroll
    for(int r=0;r<16;++r)m=__builtin_fmaxf(m,p[i][r]); }
  { auto rr=__builtin_amdgcn_permlane32_swap(__float_as_uint(m),__float_as_uint(m),false,false); m=__builtin_fmaxf(__uint_as_float(rr[0]),__uint_as_float(rr[1])); }
  float l=0.f;
  #pragma unroll
  for(int i=0;i<8;++i){
    #pragma unroll
    for(int r=0;r<16;++r){p[i][r]=__builtin_amdgcn_exp2f(p[i][r]-m); l+=p[i][r];} }
  { auto rr=__builtin_amdgcn_permlane32_swap(__float_as_uint(l),__float_as_uint(l),false,false); l=__uint_as_float(rr[0])+__uint_as_float(rr[1]); }
  f32x16 o[4]; o[0]=f32x16{};o[1]=f32x16{};o[2]=f32x16{};o[3]=f32x16{};
  const lds_cptr vp0=shm3+65536+((lane>>4)&1)*32+(lane&3)*8+(4*hi+((lane&15)>>2))*64;
  #pragma unroll
  for(int blk=0;blk<4;++blk){
    u32x4 pw[4];
    #pragma unroll
    for(int k=0;k<4;++k){ const f32x16&P=p[2*blk+(k>>1)]; const int B=(k&1)*8; pw[k]=(u32x4){cvtpk_s(P[B],P[B+1]),cvtpk_s(P[B+2],P[B+3]),cvtpk_s(P[B+4],P[B+5]),cvtpk_s(P[B+6],P[B+7])}; }
    #pragma unroll
    for(int dh=0;dh<2;++dh){
      const lds_cptr vp=vp0+(blk*2+dh)*8192;
      #pragma unroll
      for(int dt=0;dt<2;++dt){
        #pragma unroll
        for(int k=0;k<4;++k){
          const s16x4 lo=vtr(vp+dt*4096+k*1024), hh=vtr(vp+dt*4096+k*1024+512);
          const bf16x8 vf=(bf16x8){lo[0],lo[1],lo[2],lo[3],hh[0],hh[1],hh[2],hh[3]};
          o[dh*2+dt]=__builtin_amdgcn_mfma_f32_32x32x16_bf16(__builtin_bit_cast(bf16x8,pw[k]),vf,o[dh*2+dt],0,0,0);
        }
      }
    }
  }
  const float rl0=__builtin_amdgcn_rcpf(l);
  __syncthreads();
  bf16_t*stg=(bf16_t*)(shm)+wid*4096;
  { float*tmp=(float*)stg; if(hi==0)tmp[r32]=rl0; asm volatile("s_waitcnt lgkmcnt(0)":::"memory");
    float rli[16];
    #pragma unroll
    for(int r=0;r<16;++r)rli[r]=tmp[crow(r,hi)];
    asm volatile("s_waitcnt lgkmcnt(0)":::"memory");
    #pragma unroll
    for(int r=0;r<16;++r){ const int orow=crow(r,hi);
      #pragma unroll
      for(int t4=0;t4<4;++t4)stg[orow*128+t4*32+r32]=(bf16_t)f2bf(o[t4][r]*rli[r]); }
    asm volatile("s_waitcnt lgkmcnt(0)":::"memory");
  }
  bf16_t*Ow=PJ+row0*PA+C_MQ+hd*128;
  #pragma unroll
  for(int i=0;i<8;++i){ const int row=i*4+(lane>>4),ch=lane&15; const u32x4 v=*(const u32x4*)(stg+row*128+ch*8); *(u32x4*)(Ow+(size_t)row*PA+ch*8)=v; }
  asm volatile("s_waitcnt lgkmcnt(0)":::"memory"); __syncthreads();
}
}

__device__ __forceinline__ void mem_simple_unit(Frame& F, int b, int hd, int qb) {
    const int tid = F.tid;
    LAS bf16_t* Kt = (LAS bf16_t*)(F.lds);
    LAS bf16_t* Vt = (LAS bf16_t*)(F.lds + 16384);
    const bf16_t* PJ = (const bf16_t*)(F.ws + WS_PROJA); const bf16_t* KV = (const bf16_t*)(F.ws + WS_MEMKV);
    const int q = qb * 256 + (tid >> 1), half = tid & 1; const size_t row = (size_t)b * SEQ + q;
    float qf[64], o[64];
#pragma unroll
    for (int c = 0; c < 8; ++c) { const u32x4 w = *(const u32x4*)(PJ + row * PA + C_MQ + hd * 128 + half * 64 + c * 8);
        qf[8 * c + 0] = bflo(w.x); qf[8 * c + 1] = bfhi(w.x); qf[8 * c + 2] = bflo(w.y); qf[8 * c + 3] = bfhi(w.y); qf[8 * c + 4] = bflo(w.z); qf[8 * c + 5] = bfhi(w.z); qf[8 * c + 6] = bflo(w.w); qf[8 * c + 7] = bfhi(w.w); }
#pragma unroll
    for (int d = 0; d < 64; ++d) o[d] = 0.f;
    float mrun = -1e30f, l = 0.f;
    for (int kt = 0; kt < 4; ++kt) {
        __syncthreads();
#pragma unroll
        for (int i = 0; i < 2; ++i) { const int idx = tid + 512 * i, r = idx >> 4, ch = idx & 15;
            const size_t krow = (size_t)b * MEMLEN + kt * 64 + r;
            *(LAS u32x4*)(Kt + r * 128 + ch * 8) = *(const u32x4*)(KV + krow * 1024 + hd * 128 + ch * 8);
            *(LAS u32x4*)(Vt + r * 128 + ch * 8) = *(const u32x4*)(KV + krow * 1024 + 512 + hd * 128 + ch * 8); }
        __syncthreads();
#pragma unroll 1
        for (int kk = 0; kk < 64; ++kk) {
            float s0 = 0.f, s1 = 0.f;
#pragma unroll
            for (int c = 0; c < 8; ++c) { const u32x4 w = *(const LAS u32x4*)(Kt + kk * 128 + half * 64 + c * 8);
                s0 += qf[8 * c + 0] * bflo(w.x) + qf[8 * c + 2] * bflo(w.y) + qf[8 * c + 4] * bflo(w.z) + qf[8 * c + 6] * bflo(w.w);
                s1 += qf[8 * c + 1] * bfhi(w.x) + qf[8 * c + 3] * bfhi(w.y) + qf[8 * c + 5] * bfhi(w.z) + qf[8 * c + 7] * bfhi(w.w); }
            float s = s0 + s1; s += __shfl_xor(s, 1);
            const float mn = fmaxf(mrun, s); const float al = __builtin_amdgcn_exp2f(mrun - mn); const float p = __builtin_amdgcn_exp2f(s - mn);
            l = l * al + p; mrun = mn;
#pragma unroll
            for (int c = 0; c < 8; ++c) { const u32x4 w = *(const LAS u32x4*)(Vt + kk * 128 + half * 64 + c * 8);
                o[8 * c + 0] = o[8 * c + 0] * al + p * bflo(w.x); o[8 * c + 1] = o[8 * c + 1] * al + p * bfhi(w.x); o[8 * c + 2] = o[8 * c + 2] * al + p * bflo(w.y); o[8 * c + 3] = o[8 * c + 3] * al + p * bfhi(w.y);
                o[8 * c + 4] = o[8 * c + 4] * al + p * bflo(w.z); o[8 * c + 5] = o[8 * c + 5] * al + p * bfhi(w.z); o[8 * c + 6] = o[8 * c + 6] * al + p * bflo(w.w); o[8 * c + 7] = o[8 * c + 7] * al + p * bfhi(w.w); }
        }
    }
    const float rl = 1.0f / l;
    bf16_t* op = (bf16_t*)(F.ws + WS_PROJA) + row * PA + C_MQ + hd * 128 + half * 64;
#pragma unroll
    for (int c = 0; c < 8; ++c) { u32x4 w; w.x = pk2(o[8 * c + 0] * rl, o[8 * c + 1] * rl); w.y = pk2(o[8 * c + 2] * rl, o[8 * c + 3] * rl); w.z = pk2(o[8 * c + 4] * rl, o[8 * c + 5] * rl); w.w = pk2(o[8 * c + 6] * rl, o[8 * c + 7] * rl);
        *(u32x4*)(op + c * 8) = w; }
    __syncthreads();
}

__device__ __forceinline__ void unpack8(const u32x4 w, float (&f)[8]) { f[0] = bflo(w.x); f[1] = bfhi(w.x); f[2] = bflo(w.y); f[3] = bfhi(w.y); f[4] = bflo(w.z); f[5] = bfhi(w.z); f[6] = bflo(w.w); f[7] = bfhi(w.w); }
__device__ __forceinline__ void rwkv_simple_unit(Frame& F, int b, int h) {
    const int tid = F.tid;
    LAS float* Rr = (LAS float*)(F.lds + 0 * 16384); LAS float* Ww = (LAS float*)(F.lds + 1 * 16384); LAS float* Kk = (LAS float*)(F.lds + 2 * 16384); LAS float* Vv = (LAS float*)(F.lds + 3 * 16384);
    LAS float* Aa = (LAS float*)(F.lds + 4 * 16384); LAS float* Bb = (LAS float*)(F.lds + 5 * 16384); LAS float* Gg = (LAS float*)(F.lds + 6 * 16384); LAS float* Yy = (LAS float*)(F.lds + 7 * 16384);
    LAS float* T1 = Ww; LAS float* T2 = Aa; LAS float* T3 = Bb;
    LAS float* prevr = (LAS float*)(F.lds + EXTRA_OFF);
    bf16_t* PJ = (bf16_t*)(F.ws + WS_PROJA);
    const float* mu = F.in[I_MU]; const float* w0 = F.in[I_W0]; const float* wup = F.in[I_WUP]; const float* a0 = F.in[I_A0]; const float* aup = F.in[I_AUP]; const float* gup = F.in[I_GUP];
    const float* kkp = F.in[I_KK]; const float* kap = F.in[I_KA]; const float* rkp = F.in[I_RK]; const float* gng = F.in[I_GNG]; const float* gnb = F.in[I_GNB];
    const int t = tid >> 3, cg = tid & 7, c0 = 8 * cg, hc = h * 64 + c0;
    float St[8];
#pragma unroll
    for (int e = 0; e < 8; ++e) St[e] = 0.f;
    __syncthreads();
#pragma unroll 1
    for (int bt = 0; bt < SEQ / 64; ++bt) {
        const int tt0 = bt * 64; const size_t row = (size_t)b * SEQ + tt0 + t; const bool has_prev = (tt0 + t) > 0;
        float rs[8], ks[8], vs[8];
        {
            float cur[8], prv[8];
            const bf16_t* rp = PJ + row * PA; const bf16_t* pp = rp - PA;
            unpack8(*(const u32x4*)(rp + C_RR + hc), cur);
            if (t == 63) {
#pragma unroll
                for (int e = 0; e < 8; ++e) prevr[((bt + 1) & 1) * 64 + c0 + e] = cur[e]; }
            if (t > 0) unpack8(*(const u32x4*)(pp + C_RR + hc), prv);
            else {
#pragma unroll
                for (int e = 0; e < 8; ++e) prv[e] = (bt > 0) ? prevr[(bt & 1) * 64 + c0 + e] : 0.f; }
#pragma unroll
            for (int e = 0; e < 8; ++e) rs[e] = cur[e] + (prv[e] - cur[e]) * mu[hc + e];
            unpack8(*(const u32x4*)(rp + C_RK + hc), cur);
            if (has_prev) unpack8(*(const u32x4*)(pp + C_RK + hc), prv); else {
#pragma unroll
                for (int e = 0; e < 8; ++e) prv[e] = 0.f; }
#pragma unroll
            for (int e = 0; e < 8; ++e) ks[e] = cur[e] + (prv[e] - cur[e]) * mu[512 + hc + e];
            unpack8(*(const u32x4*)(rp + C_RV + hc), cur);
            if (has_prev) unpack8(*(const u32x4*)(pp + C_RV + hc), prv); else {
#pragma unroll
                for (int e = 0; e < 8; ++e) prv[e] = 0.f; }
#pragma unroll
            for (int e = 0; e < 8; ++e) vs[e] = cur[e] + (prv[e] - cur[e]) * mu[1024 + hc + e];
            unpack8(*(const u32x4*)(rp + C_WD + c0), cur);
            if (has_prev) unpack8(*(const u32x4*)(pp + C_WD + c0), prv); else {
#pragma unroll
                for (int e = 0; e < 8; ++e) prv[e] = 0.f; }
#pragma unroll
            for (int e = 0; e < 8; ++e) { const float x = cur[e] + (prv[e] - cur[e]) * mu[1536 + c0 + e]; T1[t * 64 + c0 + e] = 1.0f - 2.0f / (1.0f + __expf(2.0f * x)); }
            unpack8(*(const u32x4*)(rp + C_AD + c0), cur);
            if (has_prev) unpack8(*(const u32x4*)(pp + C_AD + c0), prv); else {
#pragma unroll
                for (int e = 0; e < 8; ++e) prv[e] = 0.f; }
#pragma unroll
            for (int e = 0; e < 8; ++e) T2[t * 64 + c0 + e] = cur[e] + (prv[e] - cur[e]) * mu[1600 + c0 + e];
#pragma unroll
            for (int hh = 0; hh < 2; ++hh) {
                unpack8(*(const u32x4*)(rp + C_GD + 16 * cg + 8 * hh), cur);
                if (has_prev) unpack8(*(const u32x4*)(pp + C_GD + 16 * cg + 8 * hh), prv); else {
#pragma unroll
                    for (int e = 0; e < 8; ++e) prv[e] = 0.f; }
#pragma unroll
                for (int e = 0; e < 8; ++e) { const float x = cur[e] + (prv[e] - cur[e]) * mu[1664 + 16 * cg + 8 * hh + e]; T3[t * 128 + 16 * cg + 8 * hh + e] = sigm(x); }
            }
#pragma unroll
            for (int e = 0; e < 8; ++e) { Rr[t * 64 + c0 + e] = rs[e]; Vv[t * 64 + c0 + e] = vs[e]; }
        }
        __syncthreads();
        float zw[8], za[8], gg[8];
        {
#pragma unroll
            for (int e = 0; e < 8; ++e) { zw[e] = w0[hc + e]; za[e] = a0[hc + e]; gg[e] = 0.f; }
#pragma unroll 4
            for (int i = 0; i < 64; ++i) { const float x1 = T1[t * 64 + i], x2 = T2[t * 64 + i];
                const f32x4 wa = *(const f32x4*)(wup + (size_t)i * 512 + hc), wb = *(const f32x4*)(wup + (size_t)i * 512 + hc + 4);
                const f32x4 aa = *(const f32x4*)(aup + (size_t)i * 512 + hc), ab = *(const f32x4*)(aup + (size_t)i * 512 + hc + 4);
#pragma unroll
                for (int e = 0; e < 4; ++e) { zw[e] += x1 * wa[e]; zw[4 + e] += x1 * wb[e]; za[e] += x2 * aa[e]; za[4 + e] += x2 * ab[e]; } }
#pragma unroll 4
            for (int i = 0; i < 128; ++i) { const float x3 = T3[t * 128 + i];
                const f32x4 ga = *(const f32x4*)(gup + (size_t)i * 512 + hc), gb = *(const f32x4*)(gup + (size_t)i * 512 + hc + 4);
#pragma unroll
                for (int e = 0; e < 4; ++e) { gg[e] += x3 * ga[e]; gg[4 + e] += x3 * gb[e]; } }
        }
        __syncthreads();
        {
            float kk[8], ss = 0.f;
#pragma unroll
            for (int e = 0; e < 8; ++e) { kk[e] = ks[e] * kkp[hc + e]; ss += kk[e] * kk[e]; }
            ss += __shfl_xor(ss, 1); ss += __shfl_xor(ss, 2); ss += __shfl_xor(ss, 4);
            const float rn = 1.0f / sqrtf(fmaxf(ss, 1e-24f));
#pragma unroll
            for (int e = 0; e < 8; ++e) { const float a = sigm(za[e]); const float w = __expf(-0.6065306597126334f * sigm(zw[e])); const float kn = kk[e] * rn;
                Ww[t * 64 + c0 + e] = w; Kk[t * 64 + c0 + e] = ks[e] * (1.0f + (a - 1.0f) * kap[hc + e]); Aa[t * 64 + c0 + e] = -kn; Bb[t * 64 + c0 + e] = kn * a; Gg[t * 64 + c0 + e] = gg[e]; }
        }
        __syncthreads();
        {
#pragma unroll 1
            for (int tt = 0; tt < 64; ++tt) {
                const f32x4 a0v = *(const LAS f32x4*)(Aa + tt * 64 + c0), a1v = *(const LAS f32x4*)(Aa + tt * 64 + c0 + 4);
                float sa = St[0] * a0v[0] + St[1] * a0v[1] + St[2] * a0v[2] + St[3] * a0v[3] + St[4] * a1v[0] + St[5] * a1v[1] + St[6] * a1v[2] + St[7] * a1v[3];
                sa += __shfl_xor(sa, 1); sa += __shfl_xor(sa, 2); sa += __shfl_xor(sa, 4);
                const f32x4 w0v = *(const LAS f32x4*)(Ww + tt * 64 + c0), w1v = *(const LAS f32x4*)(Ww + tt * 64 + c0 + 4);
                const f32x4 b0v = *(const LAS f32x4*)(Bb + tt * 64 + c0), b1v = *(const LAS f32x4*)(Bb + tt * 64 + c0 + 4);
                const f32x4 k0v = *(const LAS f32x4*)(Kk + tt * 64 + c0), k1v = *(const LAS f32x4*)(Kk + tt * 64 + c0 + 4);
                const f32x4 r0v = *(const LAS f32x4*)(Rr + tt * 64 + c0), r1v = *(const LAS f32x4*)(Rr + tt * 64 + c0 + 4);
                const float vi = Vv[tt * 64 + t];
                float y = 0.f;
#pragma unroll
                for (int e = 0; e < 4; ++e) { St[e] = St[e] * w0v[e] + sa * b0v[e] + vi * k0v[e]; St[4 + e] = St[4 + e] * w1v[e] + sa * b1v[e] + vi * k1v[e]; y += St[e] * r0v[e] + St[4 + e] * r1v[e]; }
                y += __shfl_xor(y, 1); y += __shfl_xor(y, 2); y += __shfl_xor(y, 4);
                if (cg == 0) Yy[tt * 64 + t] = y;
            }
        }
        __syncthreads();
        {
            float y[8], s = 0.f, sb = 0.f;
#pragma unroll
            for (int e = 0; e < 8; ++e) { y[e] = Yy[t * 64 + c0 + e]; s += y[e]; sb += Rr[t * 64 + c0 + e] * Kk[t * 64 + c0 + e] * rkp[hc + e]; }
            s += __shfl_xor(s, 1); s += __shfl_xor(s, 2); s += __shfl_xor(s, 4);
            sb += __shfl_xor(sb, 1); sb += __shfl_xor(sb, 2); sb += __shfl_xor(sb, 4);
            const float mean = s * (1.0f / 64.0f); float var = 0.f;
#pragma unroll
            for (int e = 0; e < 8; ++e) { y[e] -= mean; var += y[e] * y[e]; }
            var += __shfl_xor(var, 1); var += __shfl_xor(var, 2); var += __shfl_xor(var, 4);
            const float rstd = 1.0f / sqrtf(var * (1.0f / 64.0f) + GN_EPS);
            float ov[8];
#pragma unroll
            for (int e = 0; e < 8; ++e) ov[e] = (y[e] * rstd * gng[hc + e] + gnb[hc + e] + sb * Vv[t * 64 + c0 + e]) * Gg[t * 64 + c0 + e];
            u32x4 w; w.x = pk2(ov[0], ov[1]); w.y = pk2(ov[2], ov[3]); w.z = pk2(ov[4], ov[5]); w.w = pk2(ov[6], ov[7]);
            *(u32x4*)(PJ + row * PA + C_RR + hc) = w;
        }
        __syncthreads();
    }
}


namespace rwkv {
constexpr size_t WLORA_AUP = 65536, WLORA_GUP = 131072;
constexpr int SLOT = 8192;
constexpr int X_DIAG = EXTRA_OFF, X_SCAN = X_DIAG + 4096, X_GAMMA = X_SCAN + 2048, X_BONUS = X_GAMMA + 256, X_PREV = X_BONUS + 256;
static_assert(X_PREV + 2 * 896 <= LDS_BYTES, "rwkv extra LDS");
typedef LAS unsigned char* lp;
__device__ __forceinline__ int sw64(int row, int k) { return row * 128 + ((k * 2) ^ ((row & 7) << 4)); }
__device__ __forceinline__ int sw128(int row, int k) { return row * 256 + ((k * 2) ^ ((row & 7) << 4)); }
__device__ __forceinline__ bf16x8 ldfrag(lp base, int rowblk, int ks, int fr, int fg) { return *(const LAS bf16x8*)(base + (16 * rowblk + fr) * 128 + ((64 * ks + 16 * fg) ^ ((fr & 7) << 4))); }
__device__ __forceinline__ bf16x8 ldfrag128(lp base, int rowblk, int ks, int fr, int fg) { return *(const LAS bf16x8*)(base + (16 * rowblk + fr) * 256 + ((64 * ks + 16 * fg) ^ ((fr & 7) << 4))); }
__device__ __forceinline__ float ldbf(lp base, int row, int k) { return __builtin_bit_cast(float, (unsigned)(*(const LAS bf16_t*)(base + sw64(row, k))) << 16); }
__device__ __forceinline__ void stbf(lp base, int row, int k, float v) { *(LAS bf16_t*)(base + sw64(row, k)) = (bf16_t)f2bf(v); }
#define MFMA16(a, b, c) __builtin_amdgcn_mfma_f32_16x16x32_bf16(a, b, c, 0, 0, 0)
__device__ __forceinline__ void mm64(f32x4 (&acc)[2], lp A, lp B, int ti, int tj0, int fr, int fg) {
#pragma unroll
    for (int ks = 0; ks < 2; ++ks) { const bf16x8 a = ldfrag(A, ti, ks, fr, fg), b0 = ldfrag(B, tj0, ks, fr, fg), b1 = ldfrag(B, tj0 + 1, ks, fr, fg);
        acc[0] = MFMA16(a, b0, acc[0]); acc[1] = MFMA16(a, b1, acc[1]); }
}
__device__ __forceinline__ void st_nm(lp base, const f32x4 (&acc)[2], int ti, int tj0, int fr, int fg) {
#pragma unroll
    for (int tt = 0; tt < 2; ++tt) { const int n = 16 * (tj0 + tt) + fr, m0 = 16 * ti + 4 * fg;
        *(LAS u32x2*)(base + n * 128 + ((m0 * 2) ^ ((n & 7) << 4))) = (u32x2){pg8::cvt_pk_bf16(acc[tt][0], acc[tt][1]), pg8::cvt_pk_bf16(acc[tt][2], acc[tt][3])}; }
}
__device__ __forceinline__ void st_mn(lp base, const f32x4 (&acc)[2], int ti, int tj0, int fr, int fg) {
#pragma unroll
    for (int tt = 0; tt < 2; ++tt) { const int n = 16 * (tj0 + tt) + fr;
#pragma unroll
        for (int e = 0; e < 4; ++e) stbf(base, 16 * ti + 4 * fg + e, n, acc[tt][e]); }
}
struct Raw { u32x4 r, k, v, wd, ad, g0, g1; };
__device__ __forceinline__ void load_raw(Raw& x, const bf16_t* rp, int hc, int c0, int cg) {
    x.r = *(const u32x4*)(rp + C_RR + hc); x.k = *(const u32x4*)(rp + C_RK + hc); x.v = *(const u32x4*)(rp + C_RV + hc);
    x.wd = *(const u32x4*)(rp + C_WD + c0); x.ad = *(const u32x4*)(rp + C_AD + c0); x.g0 = *(const u32x4*)(rp + C_GD + 16 * cg); x.g1 = *(const u32x4*)(rp + C_GD + 16 * cg + 8);
}
__device__ __forceinline__ void shift8(float (&o)[8], const u32x4 cur, const u32x4 prv, const float* mu) {
    float c[8], p[8]; unpack8(cur, c); unpack8(prv, p); const f32x4 m0 = *(const f32x4*)mu, m1 = *(const f32x4*)(mu + 4);
#pragma unroll
    for (int e = 0; e < 4; ++e) { o[e] = c[e] + (p[e] - c[e]) * m0[e]; o[4 + e] = c[4 + e] + (p[4 + e] - c[4 + e]) * m1[e]; }
}
__device__ __forceinline__ u32x4 pack8f(const float (&f)[8]) { return (u32x4){pk2(f[0], f[1]), pk2(f[2], f[3]), pk2(f[4], f[5]), pk2(f[6], f[7])}; }

__device__ __forceinline__ void unit(Frame& F, int b, int h) {
    int tid0 = threadIdx.x; asm volatile("" : "+v"(tid0));
#define IDX() int tid = tid0; asm volatile("" : "+v"(tid)); const int lane = tid & 63, wid = __builtin_amdgcn_readfirstlane(tid >> 6); \
    const int t = tid >> 3, cg = tid & 7, c0 = 8 * cg, hc = h * 64 + c0; const int fr = lane & 15, fg = lane >> 4, ti = wid >> 1, tj0 = 2 * (wid & 1); \
    (void)t; (void)cg; (void)c0; (void)hc; (void)fr; (void)fg; (void)ti; (void)tj0; (void)lane; (void)wid
    const lp L = F.lds;
#define SL(n) (L + (n) * SLOT)
    bf16_t* PJ = (bf16_t*)(F.ws + WS_PROJA);
    const bf16_t* WUPT = (const bf16_t*)(F.ws + WS_WLORA); const bf16_t* AUPT = (const bf16_t*)(F.ws + WS_WLORA + WLORA_AUP); const bf16_t* GUPT = (const bf16_t*)(F.ws + WS_WLORA + WLORA_GUP);
    const float* mu = F.in[I_MU];
    LAS float* DIAG = (LAS float*)(L + X_DIAG); LAS float* SCANP = (LAS float*)(L + X_SCAN); LAS float* GAMMA = (LAS float*)(L + X_GAMMA); LAS float* BONUS = (LAS float*)(L + X_BONUS);
    LAS u32x4* PREV = (LAS u32x4*)(L + X_PREV);
    f32x4 Hreg[2]; Hreg[0] = (f32x4){0.f, 0.f, 0.f, 0.f}; Hreg[1] = Hreg[0];
    __syncthreads();
    Raw cur, prv;
    { IDX(); *(LAS u32x4*)(SL(0) + tid * 16) = (u32x4){0u, 0u, 0u, 0u};
      const bf16_t* rp = PJ + ((size_t)b * SEQ + t) * PA; load_raw(cur, rp, hc, c0, cg); if (t > 0) load_raw(prv, rp - PA, hc, c0, cg); }
#pragma unroll 1
    for (int bt = 0; bt < SEQ / 64; ++bt) {
        { IDX();
            if (t == 0) { const u32x4 z = (u32x4){0u, 0u, 0u, 0u};
                if (bt == 0) { prv.r = z; prv.k = z; prv.v = z; prv.wd = z; prv.ad = z; prv.g0 = z; prv.g1 = z; }
                else { LAS u32x4* pp = PREV + (bt & 1) * 56 + cg; prv.r = pp[0]; prv.k = pp[8]; prv.v = pp[16]; prv.wd = pp[24]; prv.ad = pp[32]; prv.g0 = pp[40]; prv.g1 = pp[48]; } }
            if (t == 63) { LAS u32x4* pp = PREV + ((bt + 1) & 1) * 56 + cg; pp[0] = cur.r; pp[8] = cur.k; pp[16] = cur.v; pp[24] = cur.wd; pp[32] = cur.ad; pp[40] = cur.g0; pp[48] = cur.g1; }
            float x[8];
            shift8(x, cur.r, prv.r, mu + hc); *(LAS u32x4*)(SL(2) + sw64(t, c0)) = pack8f(x);
            shift8(x, cur.v, prv.v, mu + 1024 + hc); *(LAS u32x4*)(SL(4) + sw64(t, c0)) = pack8f(x);
            shift8(x, cur.k, prv.k, mu + 512 + hc); *(LAS u32x4*)(SL(3) + sw64(t, c0)) = pack8f(x);
            { const f32x4 k0 = *(const f32x4*)(F.in[I_KK] + hc), k1 = *(const f32x4*)(F.in[I_KK] + hc + 4); float ss = 0.f;
#pragma unroll
              for (int e = 0; e < 4; ++e) { x[e] *= k0[e]; x[4 + e] *= k1[e]; ss += x[e] * x[e] + x[4 + e] * x[4 + e]; }
              ss += __shfl_xor(ss, 1); ss += __shfl_xor(ss, 2); ss += __shfl_xor(ss, 4);
              const float rn = -1.0f / sqrtf(fmaxf(ss, 1e-24f));
#pragma unroll
              for (int e = 0; e < 8; ++e) x[e] *= rn;
              *(LAS u32x4*)(SL(1) + sw64(t, c0)) = pack8f(x); }
            shift8(x, cur.wd, prv.wd, mu + 1536 + c0);
#pragma unroll
            for (int e = 0; e < 8; ++e) x[e] = 1.0f - 2.0f / (1.0f + __expf(2.0f * x[e]));
            *(LAS u32x4*)(SL(14) + sw64(t, c0)) = pack8f(x);
            shift8(x, cur.ad, prv.ad, mu + 1600 + c0); *(LAS u32x4*)(SL(15) + sw64(t, c0)) = pack8f(x);
            shift8(x, cur.g0, prv.g0, mu + 1664 + 16 * cg);
#pragma unroll
            for (int e = 0; e < 8; ++e) x[e] = sigm(x[e]);
            *(LAS u32x4*)(SL(9) + sw128(t, 16 * cg)) = pack8f(x);
            shift8(x, cur.g1, prv.g1, mu + 1664 + 16 * cg + 8);
#pragma unroll
            for (int e = 0; e < 8; ++e) x[e] = sigm(x[e]);
            *(LAS u32x4*)(SL(9) + sw128(t, 16 * cg + 8)) = pack8f(x);
        }
        __syncthreads();
        if (bt + 1 < SEQ / 64) { IDX(); const bf16_t* rp = PJ + ((size_t)b * SEQ + bt * 64 + t + 64) * PA; load_raw(cur, rp, hc, c0, cg); if (t > 0) load_raw(prv, rp - PA, hc, c0, cg); }
        { IDX();
            f32x4 zw[2], za[2], gg[2];
#pragma unroll
            for (int tt = 0; tt < 2; ++tt) { zw[tt] = (f32x4){0.f, 0.f, 0.f, 0.f}; za[tt] = zw[tt]; gg[tt] = zw[tt]; }
            const size_t n0 = (size_t)(h * 64 + 16 * tj0 + fr), n1 = n0 + 16;
#pragma unroll
            for (int ks = 0; ks < 2; ++ks) {
                const bf16x8 aw = ldfrag(SL(14), ti, ks, fr, fg), aa = ldfrag(SL(15), ti, ks, fr, fg);
                const bf16x8 w0 = *(const bf16x8*)(WUPT + n0 * 64 + 32 * ks + 8 * fg), w1 = *(const bf16x8*)(WUPT + n1 * 64 + 32 * ks + 8 * fg);
                const bf16x8 a0 = *(const bf16x8*)(AUPT + n0 * 64 + 32 * ks + 8 * fg), a1 = *(const bf16x8*)(AUPT + n1 * 64 + 32 * ks + 8 * fg);
                zw[0] = MFMA16(aw, w0, zw[0]); zw[1] = MFMA16(aw, w1, zw[1]); za[0] = MFMA16(aa, a0, za[0]); za[1] = MFMA16(aa, a1, za[1]); }
#pragma unroll
            for (int ks = 0; ks < 4; ++ks) {
                const bf16x8 ag = ldfrag128(SL(9), ti, ks, fr, fg);
                const bf16x8 g0 = *(const bf16x8*)(GUPT + n0 * 128 + 32 * ks + 8 * fg), g1 = *(const bf16x8*)(GUPT + n1 * 128 + 32 * ks + 8 * fg);
                gg[0] = MFMA16(ag, g0, gg[0]); gg[1] = MFMA16(ag, g1, gg[1]); }
#pragma unroll
            for (int tt = 0; tt < 2; ++tt) { const int c = 16 * (tj0 + tt) + fr; const float w0c = F.in[I_W0][h * 64 + c], a0c = F.in[I_A0][h * 64 + c];
#pragma unroll
                for (int e = 0; e < 4; ++e) { const int tr = 16 * ti + 4 * fg + e;
                    *(LAS float*)(SL(6) + (tr * 64 + c) * 4) = zw[tt][e] + w0c;
                    stbf(SL(8), tr, c, sigm(za[tt][e] + a0c));
                    stbf(SL(5), tr, c, gg[tt][e]); } }
        }
        __syncthreads();
        { IDX();
            const int c = lane, tq = wid;
            float lw[8], lgi[8];
            float run = 0.f;
#pragma unroll
            for (int e = 0; e < 8; ++e) { const float z = *(const LAS float*)(SL(6) + ((8 * tq + e) * 64 + c) * 4); lw[e] = (-0.6065306597126334f * LOG2E) * sigm(z); run += lw[e]; lgi[e] = run; }
            SCANP[tq * 64 + c] = run;
            __syncthreads();
            float pre = 0.f, tot = 0.f;
#pragma unroll
            for (int q = 0; q < 8; ++q) { const float v = SCANP[q * 64 + c]; tot += v; pre += (q < tq) ? v : 0.f; }
            if (tq == 0) GAMMA[c] = __builtin_amdgcn_exp2f(tot);
            const float kac = F.in[I_KA][h * 64 + c], rkc = F.in[I_RK][h * 64 + c];
            float bh[8], kh[8], vv[8];
#pragma unroll
            for (int e = 0; e < 8; ++e) { const int tr = 8 * tq + e; const float lg = pre + lgi[e], lgx = lg - lw[e];
                const float av = ldbf(SL(1), tr, c), rs = ldbf(SL(2), tr, c), ks = ldbf(SL(3), tr, c), ar = ldbf(SL(8), tr, c); vv[e] = ldbf(SL(4), tr, c);
                const float kp = ks * (1.0f + (ar - 1.0f) * kac), bv = -av * ar;
                const float ein = __builtin_amdgcn_exp2f(-lg), eend = __builtin_amdgcn_exp2f(tot - lg);
                stbf(SL(1), tr, c, av * __builtin_amdgcn_exp2f(lgx));
                stbf(SL(2), tr, c, rs * __builtin_amdgcn_exp2f(lg));
                stbf(SL(9), tr, c, bv * ein);
                stbf(SL(10), tr, c, kp * ein);
                bh[e] = bv * eend; kh[e] = kp * eend;
                float bs = rs * kp * rkc;
#pragma unroll
                for (int o = 1; o < 64; o <<= 1) bs += __shfl_xor(bs, o);
                if (lane == 0) BONUS[tr] = bs; }
            *(LAS u32x4*)(SL(11) + sw64(c, 8 * tq)) = pack8f(bh);
            *(LAS u32x4*)(SL(12) + sw64(c, 8 * tq)) = pack8f(kh);
            *(LAS u32x4*)(SL(13) + sw64(c, 8 * tq)) = pack8f(vv);
        }
        __syncthreads();
        { IDX();
            f32x4 acc[2];
            const f32x4 z4 = (f32x4){0.f, 0.f, 0.f, 0.f};
            acc[0] = z4; acc[1] = z4; mm64(acc, SL(1), SL(9), ti, tj0, fr, fg);
#pragma unroll
            for (int tt = 0; tt < 2; ++tt) { const int tj = tj0 + tt;
                if (tj == ti) {
#pragma unroll
                    for (int e = 0; e < 4; ++e) DIAG[ti * 256 + (4 * fg + e) * 16 + fr] = (fr < 4 * fg + e) ? acc[tt][e] : 0.f; }
                if (tj >= ti) acc[tt] = z4; }
            st_nm(SL(8), acc, ti, tj0, fr, fg);
            acc[0] = z4; acc[1] = z4; mm64(acc, SL(10), SL(1), ti, tj0, fr, fg);
#pragma unroll
            for (int tt = 0; tt < 2; ++tt) { const int n = 16 * (tj0 + tt) + fr;
#pragma unroll
                for (int e = 0; e < 4; ++e) if (!(16 * ti + 4 * fg + e < n)) acc[tt][e] = 0.f; }
            st_nm(SL(3), acc, ti, tj0, fr, fg);
            acc[0] = z4; acc[1] = z4; mm64(acc, SL(9), SL(2), ti, tj0, fr, fg);
#pragma unroll
            for (int tt = 0; tt < 2; ++tt) { const int n = 16 * (tj0 + tt) + fr;
#pragma unroll
                for (int e = 0; e < 4; ++e) if (!(16 * ti + 4 * fg + e <= n)) acc[tt][e] = 0.f; }
            st_nm(SL(6), acc, ti, tj0, fr, fg);
            acc[0] = z4; acc[1] = z4; mm64(acc, SL(10), SL(2), ti, tj0, fr, fg);
#pragma unroll
            for (int tt = 0; tt < 2; ++tt) { const int n = 16 * (tj0 + tt) + fr;
#pragma unroll
                for (int e = 0; e < 4; ++e) if (!(16 * ti + 4 * fg + e <= n)) acc[tt][e] = 0.f; }
            st_nm(SL(7), acc, ti, tj0, fr, fg);
        }
        __syncthreads();
        { IDX();
        if (wid == 0) {
            const int blk = lane >> 4, c = lane & 15; float X[16];
#pragma unroll
            for (int tr = 0; tr < 16; ++tr) { float a = (tr == c) ? 1.f : 0.f;
#pragma unroll
                for (int q4 = 0; q4 < (tr + 3) / 4; ++q4) { const f32x4 lr = *(const LAS f32x4*)(DIAG + blk * 256 + tr * 16 + 4 * q4);
#pragma unroll
                    for (int e = 0; e < 4; ++e) if (4 * q4 + e < tr) a += lr[e] * X[4 * q4 + e]; }
                X[tr] = a; }
#pragma unroll
            for (int tr = 0; tr < 16; ++tr) stbf(SL(9), 16 * blk + tr, 16 * blk + c, X[tr]);
            { const int rowc = 16 * blk + c; const float x0[8] = {X[0], X[1], X[2], X[3], X[4], X[5], X[6], X[7]}, x1[8] = {X[8], X[9], X[10], X[11], X[12], X[13], X[14], X[15]};
              *(LAS u32x4*)(SL(10) + sw64(rowc, 16 * blk)) = pack8f(x0); *(LAS u32x4*)(SL(10) + sw64(rowc, 16 * blk + 8)) = pack8f(x1); }
        } else {
            const int u = tid - 64;
#pragma unroll
            for (int it = 0; it < 2; ++it) { const int item = u + 448 * it;
                if (item < 768) { const int arr = item / 384, rem = item % 384, rowz = rem / 6, ci = rem % 6, db = 2 * (rowz >> 4), ch = ci + (ci >= db ? 2 : 0);
                    *(LAS u32x4*)(SL(9 + arr) + sw64(rowz, 8 * ch)) = (u32x4){0u, 0u, 0u, 0u}; } }
        } }
        __syncthreads();
        f32x4 g2acc[2];
        { IDX();
            f32x4 acc[2]; acc[0] = (f32x4){0.f, 0.f, 0.f, 0.f}; acc[1] = acc[0];
            mm64(acc, SL(9), SL(8), ti, tj0, fr, fg);
            st_nm(SL(15), acc, ti, tj0, fr, fg); st_mn(SL(14), acc, ti, tj0, fr, fg);
        }
        __syncthreads();
        { IDX();
            g2acc[0] = (f32x4){0.f, 0.f, 0.f, 0.f}; g2acc[1] = g2acc[0];
            mm64(g2acc, SL(14), SL(15), ti, tj0, fr, fg);
            f32x4 acc[2];
#pragma unroll
            for (int tt = 0; tt < 2; ++tt) { acc[tt] = g2acc[tt];
#pragma unroll
                for (int e = 0; e < 4; ++e) if (16 * ti + 4 * fg + e == 16 * (tj0 + tt) + fr) acc[tt][e] += 1.0f; }
            st_nm(SL(9), acc, ti, tj0, fr, fg);
        }
        __syncthreads();
        { IDX();
            f32x4 acc[2];
#pragma unroll
            for (int tt = 0; tt < 2; ++tt) { acc[tt] = g2acc[tt];
#pragma unroll
                for (int e = 0; e < 4; ++e) if (16 * ti + 4 * fg + e == 16 * (tj0 + tt) + fr) acc[tt][e] += 1.0f; }
            mm64(acc, SL(14), SL(9), ti, tj0, fr, fg);
            st_mn(SL(15), acc, ti, tj0, fr, fg);
        }
        __syncthreads();
        { IDX();
            f32x4 acc[2]; acc[0] = (f32x4){0.f, 0.f, 0.f, 0.f}; acc[1] = acc[0];
            mm64(acc, SL(15), SL(10), ti, tj0, fr, fg);
            st_mn(SL(8), acc, ti, tj0, fr, fg);
        }
        __syncthreads();
        { IDX();
            f32x4 acc[2]; acc[0] = (f32x4){0.f, 0.f, 0.f, 0.f}; acc[1] = acc[0];
            mm64(acc, SL(1), SL(0), ti, tj0, fr, fg); mm64(acc, SL(3), SL(13), ti, tj0, fr, fg);
            st_nm(SL(9), acc, ti, tj0, fr, fg);
        }
        __syncthreads();
        { IDX();
            f32x4 acc[2]; acc[0] = (f32x4){0.f, 0.f, 0.f, 0.f}; acc[1] = acc[0];
            mm64(acc, SL(8), SL(9), ti, tj0, fr, fg);
            st_nm(SL(10), acc, ti, tj0, fr, fg);
        }
        __syncthreads();
        { IDX();
            f32x4 acc[2]; acc[0] = (f32x4){0.f, 0.f, 0.f, 0.f}; acc[1] = acc[0];
            mm64(acc, SL(2), SL(0), ti, tj0, fr, fg); mm64(acc, SL(6), SL(10), ti, tj0, fr, fg); mm64(acc, SL(7), SL(13), ti, tj0, fr, fg);
#pragma unroll
            for (int tt = 0; tt < 2; ++tt)
#pragma unroll
                for (int e = 0; e < 4; ++e) *(LAS float*)(SL(14) + ((16 * ti + 4 * fg + e) * 64 + 16 * (tj0 + tt) + fr) * 4) = acc[tt][e];
            const f32x4 gm = *(const LAS f32x4*)(GAMMA + 16 * ti + 4 * fg);
            Hreg[0] = Hreg[0] * gm; Hreg[1] = Hreg[1] * gm;
            mm64(Hreg, SL(11), SL(10), ti, tj0, fr, fg); mm64(Hreg, SL(12), SL(13), ti, tj0, fr, fg);
        }
        __syncthreads();
        { IDX();
            st_nm(SL(0), Hreg, ti, tj0, fr, fg);
            const size_t row = (size_t)b * SEQ + bt * 64 + t;
            float y[8], s1 = 0.f;
            const f32x4 y0 = *(const LAS f32x4*)(SL(14) + (t * 64 + c0) * 4), y1 = *(const LAS f32x4*)(SL(14) + (t * 64 + c0 + 4) * 4);
#pragma unroll
            for (int e = 0; e < 4; ++e) { y[e] = y0[e]; y[4 + e] = y1[e]; s1 += y0[e] + y1[e]; }
            s1 += __shfl_xor(s1, 1); s1 += __shfl_xor(s1, 2); s1 += __shfl_xor(s1, 4);
            const float mean = s1 * (1.0f / 64.0f); float var = 0.f;
#pragma unroll
            for (int e = 0; e < 8; ++e) { y[e] -= mean; var += y[e] * y[e]; }
            var += __shfl_xor(var, 1); var += __shfl_xor(var, 2); var += __shfl_xor(var, 4);
            const float rstd = 1.0f / sqrtf(var * (1.0f / 64.0f) + GN_EPS), bn = BONUS[t];
            float vs[8], gt[8]; unpack8(*(const LAS u32x4*)(SL(4) + sw64(t, c0)), vs);
            const f32x4 gg0 = *(const f32x4*)(F.in[I_GNG] + hc), gg1 = *(const f32x4*)(F.in[I_GNG] + hc + 4), gb0 = *(const f32x4*)(F.in[I_GNB] + hc), gb1 = *(const f32x4*)(F.in[I_GNB] + hc + 4);
            float ov[8];
#pragma unroll
            for (int e = 0; e < 8; ++e) { gt[e] = ldbf(SL(5), t, c0 + e); const float g1 = (e < 4) ? gg0[e & 3] : gg1[e & 3], b1 = (e < 4) ? gb0[e & 3] : gb1[e & 3];
                ov[e] = (y[e] * rstd * g1 + b1 + bn * vs[e]) * gt[e]; }
            *(u32x4*)(PJ + row * PA + C_RR + hc) = pack8f(ov);
        }
        __syncthreads();
    }
#undef SL
#undef IDX
}
#undef MFMA16
}

struct SchedInProj {
    int G, c; const char* A; const char* B;
    __device__ __forceinline__ bool next(int i, pg8::Unit& u) const {
        const int L = i * G + c; const size_t ts = (size_t)256 * 1024 * 2;
        if (L < 3456) { pg8::tile_of(L, 128, 27, u.pm, u.pn); u.tag = 0; }
        else if (L < 3456 + 64) { const int j = L - 3456; u.pm = 128 + (j & 15); u.pn = 27 + (j >> 4); u.tag = 1; }
        else return false;
        u.a = A + (size_t)u.pm * ts; u.b = B + (size_t)u.pn * ts; return true;
    }
};
struct SchedMerge {
    int G, c; const char* A; const char* B;
    __device__ __forceinline__ bool next(int i, pg8::Unit& u) const {
        const int br = i % 3, L = (i / 3) * G + c; if (L >= 512) return false;
        pg8::tile_of(L, 128, 4, u.pm, u.pn); u.tag = br;
        const int coff = (br == 0) ? C_FQ : ((br == 1) ? C_RR : C_MQ);
        u.a = A + ((size_t)u.pm * 256 * PA + coff) * 2; u.b = B + ((size_t)(br * 1024 + u.pn * 256) * 512) * 2; return true;
    }
};
struct SchedPlain {
    int G, c, nM, nN; const char* A; const char* B; size_t tsA, tsB;
    __device__ __forceinline__ bool next(int i, pg8::Unit& u) const {
        const int L = i * G + c; if (L >= nM * nN) return false;
        pg8::tile_of(L, nM, nN, u.pm, u.pn); u.tag = 0; u.a = A + (size_t)u.pm * tsA; u.b = B + (size_t)u.pn * tsB; return true;
    }
};

constexpr int N_PHASES = 9;
struct Args { const float* in[28]; float* out; unsigned char* ws; int ph_lo, ph_hi, li, pad; };
__global__ void __launch_bounds__(NWAVES * 64, 2) hyb_fwd(Args args) {
    extern __shared__ __attribute__((aligned(16))) unsigned char lds[];
    Frame F;
    F.lds = (LAS unsigned char*)lds;
    F.MISC = (volatile LAS unsigned*)(F.lds + MISC_OFF);
    F.tid = threadIdx.x; F.lane = F.tid & 63; F.wave = __builtin_amdgcn_readfirstlane(F.tid >> 6);
    F.G = gridDim.x; { const int bx = blockIdx.x; F.vcu = (F.G % 8 == 0) ? (bx % 8) * (F.G / 8) + bx / 8 : bx; }
    F.ws = args.ws; F.out = args.out; F.ctl = (gu32*)(args.ws + WS_CTL);
#pragma unroll
    for (int i = 0; i < 28; ++i) F.in[i] = args.in[i];
    for (int u = F.tid; u < (LDS_BYTES - LDSCTL_OFF) / 4; u += NWAVES * 64) ((LAS unsigned*)(F.lds + LDSCTL_OFF))[u] = 0u;
    __syncthreads();
    XcdBarrier bar; bar.bar = (unsigned*)(F.ctl + CW_BAR); bar.x = 0; bar.st = nullptr;
    if (MK_N_LAUNCHES == 1) bar = xcd_barrier_post((unsigned*)(F.ctl + CW_BAR), F.MISC + 8);
    const int lo = args.ph_lo, hi = args.ph_hi;
#define IN(k) (lo <= (k) && (k) < hi)
#define SEAM(k) do { if (IN(k) && IN((k) + 1)) xcd_barrier(bar); } while (0)
    unsigned char* ws = args.ws;

    if (IN(0)) { p0_prologue(F); SEAM(0); }

    if (IN(1)) {
        pg8::Gemm g{1024, 1024, 1024};
        SchedInProj S{F.G, (int)blockIdx.x, (const char*)(ws + WS_XNALL), (const char*)(ws + WS_WALL)};
        pg8::EpiInProj E{(bf16_t*)(ws + WS_PROJA), (bf16_t*)(ws + WS_G01), (bf16_t*)args.out, (bf16_t*)(ws + WS_MEMKV)};
        pg8::gemm_phase<pg8::EpiInProj, SchedInProj, true, true>(F.lds + RING_OFF, g, S, E);
        SEAM(1);
    }

    if (IN(2)) {
        for (int u = blockIdx.x; u < 128; u += F.G) rwkv::unit(F, u >> 3, u & 7);
        __syncthreads();
        for (int p = F.vcu; p < 512; p += F.G) {
            const int bh = p >> 2, sidx = p & 3;
            fox::attn_unit<8>(bh >> 3, bh & 7, 7 - sidx, (bf16_t*)(ws + WS_PROJA), (const float*)(ws + WS_LS), (char*)lds + RING_OFF);
            fox::attn_unit<8>(bh >> 3, bh & 7, sidx, (bf16_t*)(ws + WS_PROJA), (const float*)(ws + WS_LS), (char*)lds + RING_OFF);
        }
        __syncthreads();
        for (int p = F.vcu; p < 256; p += F.G) {
            const int bh = p >> 2;
            memx::unit(bh >> 2, bh & 3, 2 * (p & 3), true, (bf16_t*)(ws + WS_PROJA), (const bf16_t*)(ws + WS_MEMKV), (char*)lds + RING_OFF);
            memx::unit(bh >> 2, bh & 3, 2 * (p & 3) + 1, false, (bf16_t*)(ws + WS_PROJA), (const bf16_t*)(ws + WS_MEMKV), (char*)lds + RING_OFF);
        }
        SEAM(2);
    }

    if (IN(3)) {
        pg8::Gemm g{512, PA, 512};
        SchedMerge S{F.G, (int)blockIdx.x, (const char*)(ws + WS_PROJA), (const char*)(ws + WS_WBR)};
        pg8::EpiMerge E{(const bf16_t*)(ws + WS_G01), (const bf16_t*)args.out, (bf16_t*)(ws + WS_MERGED)};
        pg8::gemm_phase<pg8::EpiMerge, SchedMerge, true, true>(F.lds + RING_OFF, g, S, E);
        SEAM(3);
    }

    if (IN(4)) {
        pg8::Gemm g{1024, 1024, 1024};
        SchedPlain S{F.G, (int)blockIdx.x, 128, 4, (const char*)(ws + WS_MERGED), (const char*)(ws + WS_WO), (size_t)256 * 1024 * 2, (size_t)256 * 1024 * 2};
        pg8::EpiPlain E{(bf16_t*)(ws + WS_Y), 1024};
        pg8::gemm_phase<pg8::EpiPlain, SchedPlain, true, true>(F.lds + RING_OFF, g, S, E);
        SEAM(4);
    }

    if (IN(5)) { p3c_rows(F); SEAM(5); }

    if (IN(6)) {
        pg8::Gemm g{1024, 1024, 1024};
        SchedPlain S{F.G, (int)blockIdx.x, 128, 22, (const char*)(ws + WS_U2), (const char*)(ws + WS_WGU), (size_t)256 * 1024 * 2, (size_t)256 * 1024 * 2};
        pg8::EpiSwiGLU E{(bf16_t*)(ws + WS_HID)};
        pg8::gemm_phase<pg8::EpiSwiGLU, SchedPlain, true, true>(F.lds + RING_OFF, g, S, E);
        SEAM(6);
    }

    if (IN(7)) {
        pg8::Gemm g{DFF, DFF, DFF};
        SchedPlain S{F.G, (int)blockIdx.x, 128, 4, (const char*)(ws + WS_HID), (const char*)(ws + WS_WDN), (size_t)256 * DFF * 2, (size_t)256 * DFF * 2};
        pg8::EpiPlain E{(bf16_t*)(ws + WS_FO), 1024};
        pg8::gemm_phase<pg8::EpiPlain, SchedPlain, true, true>(F.lds + RING_OFF, g, S, E);
        SEAM(7);
    }

    if (IN(8)) { p5c_rows(F); }
#undef IN
#undef SEAM
}

extern "C" void kernel_launch(void* const* d_in, const int* in_sizes, int n_in, void* d_out, int out_size, void* d_ws, size_t ws_size, hipStream_t stream) {
    static int grid = 0;
    if (grid == 0) {
        if (n_in != 28 || in_sizes[0] != M * DM || out_size != M * DM || ws_size < WS_END) { fprintf(stderr, "kernel_launch: unexpected shapes (n_in %d, in0 %d, out %d, ws %zu)\n", n_in, n_in > 0 ? in_sizes[0] : -1, out_size, ws_size); grid = -1; return; }
        int dev = 0, cus = 0, per_cu = 0;
        if (hipGetDevice(&dev) != hipSuccess || hipDeviceGetAttribute(&cus, hipDeviceAttributeMultiprocessorCount, dev) != hipSuccess) { grid = -1; return; }
        if (hipFuncSetAttribute((const void*)hyb_fwd, hipFuncAttributeMaxDynamicSharedMemorySize, LDS_BYTES) != hipSuccess) { fprintf(stderr, "kernel_launch: hipFuncSetAttribute failed\n"); grid = -1; return; }
        if (hipOccupancyMaxActiveBlocksPerMultiprocessor(&per_cu, (const void*)hyb_fwd, NWAVES * 64, LDS_BYTES) != hipSuccess || per_cu < 1) { fprintf(stderr, "kernel_launch: occupancy query says %d blocks per CU\n", per_cu); (void)hipGetLastError(); grid = -1; return; }
        grid = cus;
    }
    if (grid < 0) return;
    if (hipMemsetAsync((char*)d_ws + WS_CTL, 0, CTL_ZERO_BYTES, stream) != hipSuccess) return;
    Args a{};
    for (int i = 0; i < 28; ++i) a.in[i] = (const float*)d_in[i];
    a.out = (float*)d_out; a.ws = (unsigned char*)d_ws;
    if (MK_N_LAUNCHES == 1) { a.ph_lo = 0; a.ph_hi = N_PHASES; a.li = 0; hipLaunchKernelGGL(hyb_fwd, dim3(grid), dim3(NWAVES * 64), LDS_BYTES, stream, a); }
    else for (int li = 0; li < N_PHASES; ++li) { a.ph_lo = li; a.ph_hi = li + 1; a.li = li; hipLaunchKernelGGL(hyb_fwd, dim3(grid), dim3(NWAVES * 64), LDS_BYTES, stream, a); }
}
```

```cpp
#include <hip/hip_runtime.h>
#include <cstdio>
#include <cstdint>

#ifndef MK_N_LAUNCHES
#define MK_N_LAUNCHES 1
#endif

#define LAS __attribute__((address_space(3)))
#define GAS __attribute__((address_space(1)))
typedef unsigned short bf16_t;
typedef short bf16x8 __attribute__((ext_vector_type(8)));
typedef float f32x4 __attribute__((ext_vector_type(4)));
typedef float f32x2 __attribute__((ext_vector_type(2)));
typedef unsigned u32x4 __attribute__((ext_vector_type(4)));
typedef unsigned u32x2 __attribute__((ext_vector_type(2)));

constexpr int BATCH = 16, SEQ = 2048, DM = 1024, M = BATCH * SEQ;
constexpr int MEMLEN = 256, MMEM = BATCH * MEMLEN;
constexpr int DFF = 2816;
constexpr int INCOLS = 6920;
constexpr int PA = 3840;
constexpr int C_FQ = 0, C_FK = 512, C_FV = 1024, C_RR = 1536, C_RK = 2048, C_RV = 2560, C_MQ = 3072, C_WD = 3584, C_AD = 3648, C_GD = 3712;
constexpr float NORM_EPS = 1e-6f, GN_EPS = 64e-5f;
constexpr float LOG2E = 1.4426950408889634f;
constexpr float C2_FOX = 0.125f * LOG2E;
constexpr float C2_MEM = 0.08838834764831845f * LOG2E;

constexpr size_t MiB = 1u << 20;
constexpr size_t WS_CTL = 0, CTL_ZERO_BYTES = 1 * MiB;
constexpr size_t WS_WALL = 1 * MiB;
constexpr size_t WS_WBR = 17 * MiB;
constexpr size_t WS_WO = 20 * MiB;
constexpr size_t WS_WGU = 22 * MiB;
constexpr size_t WS_WDN = 33 * MiB;
constexpr size_t WS_LS = 39 * MiB;
constexpr size_t WS_WLORA = 40 * MiB;
constexpr size_t WS_XNALL = 41 * MiB;
constexpr size_t WS_PROJA = 113 * MiB;
constexpr size_t WS_G01 = 353 * MiB;
constexpr size_t WS_MEMKV = 481 * MiB;
constexpr size_t WS_END = 489 * MiB;
constexpr size_t WS_MERGED = WS_XNALL;
constexpr size_t WS_Y = WS_G01;
constexpr size_t WS_U2 = WS_PROJA;
constexpr size_t WS_HID = WS_PROJA + 64 * MiB;
constexpr size_t WS_FO = WS_G01;
static_assert(WS_HID + (size_t)M * DFF * 2 <= WS_G01, "HID overlay");

constexpr int CW_TMO = 0, CW_CODE = 1;
constexpr int CW_BAR = 4096;
constexpr int CW_QUEUE = 2048;

constexpr int RING_OFF = 0, RING_BYTES = 131072;
constexpr int LDSCTL_OFF = RING_BYTES, MISC_OFF = LDSCTL_OFF + 320;
constexpr int EXTRA_OFF = MISC_OFF + 128;
constexpr int LDS_BYTES = 147456;
constexpr int NWAVES = 8;

__device__ __forceinline__ unsigned f2bf(float f) { unsigned u = __builtin_bit_cast(unsigned, f); return (u + 0x7fffu + ((u >> 16) & 1u)) >> 16; }
__device__ __forceinline__ unsigned pk2(float lo, float hi) { return f2bf(lo) | (f2bf(hi) << 16); }
__device__ __forceinline__ float bflo(unsigned w) { return __builtin_bit_cast(float, w << 16); }
__device__ __forceinline__ float bfhi(unsigned w) { return __builtin_bit_cast(float, w & 0xffff0000u); }
__device__ __forceinline__ float sigm(float x) { return 1.0f / (1.0f + __expf(-x)); }
__device__ __forceinline__ float wave_sum(float v) {
#pragma unroll
    for (int o = 1; o < 64; o <<= 1) v += __shfl_xor(v, o);
    return v;
}
#define LDS_WAIT() asm volatile("s_waitcnt lgkmcnt(0)" ::: "memory")
#define VM_WAIT() asm volatile("s_waitcnt vmcnt(0)" ::: "memory")

namespace pg8 {
#define PG8_LAS __attribute__((address_space(3)))
constexpr int BM = 256, BK = 64, HALF = 128, HTB = HALF * BK * 2, STAGE_BYTES = 8 * HTB, NXCD = 8, WGM = 8;
__host__ __device__ __forceinline__ int lds_byte(int r, int c) { const int st = (r >> 4) * 2 + (c >> 5), rr = r & 15, cc = c & 31, ob = rr * 64 + cc * 2; return st * 1024 + (ob ^ (((ob >> 9) & 1) << 5)); }
__host__ __device__ __forceinline__ void stage_rc(int b, int& R, int& C) { const int st = b / 1024, sb = b % 1024, swz = sb ^ (((sb >> 9) & 1) << 5); R = (st >> 1) * 16 + swz / 64; C = (st & 1) * 32 + (swz % 64) / 2; }
__host__ __device__ __forceinline__ int perm32(int rho) { const int n = rho >> 4, i = rho & 15; return 8 * (i >> 2) + 4 * n + (i & 3); }

struct Unit { int pm, pn, tag; const char* a; const char* b; };
struct Gemm { int K, lda, ldb; };

__device__ __forceinline__ void tile_of(int L, int nM, int nN, int& pm, int& pn) {
    const int nwg = nM * nN; int wgid = L;
    { const int q = nwg / NXCD, r = nwg % NXCD, xcd = wgid % NXCD, off = wgid / NXCD; wgid = (xcd < r ? xcd * (q + 1) : r * (q + 1) + (xcd - r) * q) + off; }
    const int nig = WGM * nN, gid = wgid / nig, fm = gid * WGM, gsz = (nM - fm) < WGM ? (nM - fm) : WGM;
    pm = fm + ((wgid % nig) % gsz); pn = (wgid % nig) / gsz;
}

typedef __bf16 bf16x2_t __attribute__((ext_vector_type(2)));
__device__ __forceinline__ unsigned cvt_pk_bf16(float lo, float hi) { f32x2 v = {lo, hi}; bf16x2_t b = __builtin_convertvector(v, bf16x2_t); return __builtin_bit_cast(unsigned, b); }

template <class Epi, class Sched, bool ALIGN_EPI = false, bool SP2 = false>
__device__ __forceinline__ void gemm_phase(PG8_LAS unsigned char* lds, const Gemm g, const Sched& S, const Epi& E) {
    const int tid = threadIdx.x, wid = __builtin_amdgcn_readfirstlane(tid >> 6), lane = tid & 63, wr = wid >> 2, wc = wid & 3, fr = lane & 15, fq = lane >> 4;
    const int K = g.K, nt = K / BK;
    unsigned voffA[2], voffB[2];
#pragma unroll
    for (int i = 0; i < 2; ++i) { int R, C; stage_rc(tid * 16 + i * 8192, R, C); const int Rb = Epi::PERM ? ((R & ~31) + perm32(R & 31)) : R;
        voffA[i] = (unsigned)(R * g.lda + C) * 2u; voffB[i] = (unsigned)(Rb * g.ldb + C) * 2u; }
    const size_t kstep = (size_t)(BK * 2);
    const size_t hstepA = (size_t)HALF * g.lda * 2, hstepB = (size_t)HALF * g.ldb * 2;
    const unsigned ldsw = (unsigned)wid * 1024u;
    const int aoff = lds_byte(wr * 64 + fr, fq * 8), boff = lds_byte(wc * 32 + fr, fq * 8);
#define PG8_SA(b, h) (((b) * 2 + (h)) * HTB)
#define PG8_SB(b, h) ((4 + (b) * 2 + (h)) * HTB)
#define PG8_STAGE(bufoff, gbase, voff) do { _Pragma("unroll") for (int _i = 0; _i < 2; ++_i) \
        __builtin_amdgcn_global_load_lds((const unsigned*)((const char*)(gbase) + (voff)[_i]), (PG8_LAS unsigned*)(lds + (bufoff) + ldsw + _i * 8192), 16, 0, 0); } while (0)
#define PG8_LDA(dst, b, h) do { _Pragma("unroll") for (int m = 0; m < 4; ++m) _Pragma("unroll") for (int k = 0; k < 2; ++k) dst[m][k] = *(const PG8_LAS bf16x8*)(lds + PG8_SA(b, h) + aoff + m * 2048 + k * 1024); } while (0)
#define PG8_LDB(dst, b, h) do { _Pragma("unroll") for (int n = 0; n < 2; ++n) _Pragma("unroll") for (int k = 0; k < 2; ++k) dst[n][k] = *(const PG8_LAS bf16x8*)(lds + PG8_SB(b, h) + boff + n * 2048 + k * 1024); } while (0)
#define PG8_MMA(ai, bj, At, Bt) do { __builtin_amdgcn_s_setprio(1); _Pragma("unroll") for (int m = 0; m < 4; ++m) _Pragma("unroll") for (int n = 0; n < 2; ++n) _Pragma("unroll") for (int k = 0; k < 2; ++k) \
        acc[ai][bj][m][n] = __builtin_amdgcn_mfma_f32_16x16x32_bf16(Bt[n][k], At[m][k], acc[ai][bj][m][n], 0, 0, 0); __builtin_amdgcn_s_setprio(0); } while (0)
#define PG8_WAIT_V(n) asm volatile("s_waitcnt vmcnt(" #n ")" ::: "memory")
#define PG8_WAIT_L(n) asm volatile("s_waitcnt lgkmcnt(" #n ")" ::: "memory")
#define PG8_BAR __builtin_amdgcn_s_barrier()
#define PG8_SCHED __builtin_amdgcn_sched_barrier(0)
    Unit cur, nxt; int ui = 0;
    if (!S.next(0, cur)) return;
    f32x4 acc[2][2][4][2];
#pragma unroll
    for (int a = 0; a < 2; ++a)
#pragma unroll
        for (int b = 0; b < 2; ++b)
#pragma unroll
            for (int m = 0; m < 4; ++m)
#pragma unroll
                for (int n = 0; n < 2; ++n) acc[a][b][m][n] = (f32x4){0.f, 0.f, 0.f, 0.f};
    bf16x8 At[4][2], B0[2][2], B1[2][2];
    const char* cA = cur.a; const char* cB = cur.b;
    if constexpr (SP2) {
        PG8_STAGE(PG8_SB(0, 0), cB, voffB); PG8_STAGE(PG8_SB(0, 1), cB + hstepB, voffB); PG8_STAGE(PG8_SA(0, 0), cA, voffA); PG8_STAGE(PG8_SA(0, 1), cA + hstepA, voffA);
        if (wr == 1) PG8_BAR;
        PG8_WAIT_V(2); PG8_BAR;
        PG8_STAGE(PG8_SB(1, 0), cB + kstep, voffB); PG8_STAGE(PG8_SA(1, 0), cA + kstep, voffA); PG8_STAGE(PG8_SB(1, 1), cB + hstepB + kstep, voffB);
        PG8_WAIT_V(6); PG8_BAR;
    } else {
        PG8_STAGE(PG8_SB(0, 0), cB, voffB); PG8_STAGE(PG8_SA(0, 0), cA, voffA); PG8_STAGE(PG8_SB(0, 1), cB + hstepB, voffB); PG8_STAGE(PG8_SA(0, 1), cA + hstepA, voffA);
        if (wr == 1) PG8_BAR;
        PG8_WAIT_V(4); PG8_BAR;
        PG8_STAGE(PG8_SB(1, 0), cB + kstep, voffB); PG8_STAGE(PG8_SA(1, 0), cA + kstep, voffA); PG8_STAGE(PG8_SB(1, 1), cB + hstepB + kstep, voffB);
        PG8_WAIT_V(6); PG8_BAR;
    }
    for (;;) {
        const bool has_next = S.next(ui + 1, nxt);
        const char* nA = has_next ? nxt.a : cA; const char* nB = has_next ? nxt.b : cB;
        for (int t = 0; t < nt; t += 2) {
            const bool last = (t == nt - 2);
            const char* a1 = cA + (size_t)(t + 1) * kstep;
            const char* a2 = last ? nA : cA + (size_t)(t + 2) * kstep; const char* b2 = last ? nB : cB + (size_t)(t + 2) * kstep;
            const char* a3 = a2 + kstep; const char* b3 = b2 + kstep;
            if constexpr (SP2) {
            PG8_LDB(B0, 0, 0); PG8_LDB(B1, 0, 1); PG8_SCHED; PG8_LDA(At, 0, 0); PG8_STAGE(PG8_SA(1, 1), a1 + hstepA, voffA);
            PG8_WAIT_V(8); PG8_WAIT_L(0); PG8_BAR; PG8_MMA(0, 0, At, B0); PG8_MMA(0, 1, At, B1); PG8_BAR; PG8_SCHED;
            PG8_LDA(At, 0, 1); PG8_STAGE(PG8_SB(0, 0), b2, voffB); PG8_STAGE(PG8_SB(0, 1), b2 + hstepB, voffB); PG8_STAGE(PG8_SA(0, 0), a2, voffA);
            PG8_WAIT_V(8); PG8_WAIT_L(0); PG8_BAR; PG8_MMA(1, 0, At, B0); PG8_MMA(1, 1, At, B1); PG8_BAR; PG8_SCHED;
            PG8_LDB(B0, 1, 0); PG8_LDB(B1, 1, 1); PG8_SCHED; PG8_LDA(At, 1, 0); PG8_STAGE(PG8_SA(0, 1), a2 + hstepA, voffA);
            PG8_WAIT_V(8); PG8_WAIT_L(0); PG8_BAR; PG8_MMA(0, 0, At, B0); PG8_MMA(0, 1, At, B1); PG8_BAR; PG8_SCHED;
            PG8_LDA(At, 1, 1); PG8_STAGE(PG8_SB(1, 0), b3, voffB); PG8_STAGE(PG8_SB(1, 1), b3 + hstepB, voffB); PG8_STAGE(PG8_SA(1, 0), a3, voffA);
            PG8_WAIT_V(8); PG8_WAIT_L(0); PG8_BAR; PG8_MMA(1, 0, At, B0); PG8_MMA(1, 1, At, B1); PG8_BAR; PG8_SCHED;
            } else {
            PG8_LDB(B0, 0, 0); PG8_SCHED; PG8_LDA(At, 0, 0); PG8_STAGE(PG8_SA(1, 1), a1 + hstepA, voffA);
            PG8_WAIT_L(8); PG8_BAR; PG8_WAIT_L(0); PG8_MMA(0, 0, At, B0); PG8_BAR; PG8_SCHED;
            PG8_LDB(B1, 0, 1); PG8_STAGE(PG8_SB(0, 0), b2, voffB);
            PG8_BAR; PG8_WAIT_L(0); PG8_MMA(0, 1, At, B1); PG8_BAR;
            PG8_LDA(At, 0, 1); PG8_STAGE(PG8_SA(0, 0), a2, voffA);
            PG8_BAR; PG8_WAIT_L(0); PG8_MMA(1, 0, At, B0); PG8_BAR; PG8_SCHED;
            PG8_STAGE(PG8_SB(0, 1), b2 + hstepB, voffB);
            PG8_WAIT_V(6); PG8_BAR; PG8_MMA(1, 1, At, B1); PG8_BAR;
            PG8_LDB(B0, 1, 0); PG8_SCHED; PG8_LDA(At, 1, 0); PG8_STAGE(PG8_SA(0, 1), a2 + hstepA, voffA);
            PG8_WAIT_L(8); PG8_BAR; PG8_WAIT_L(0); PG8_MMA(0, 0, At, B0); PG8_BAR; PG8_SCHED;
            PG8_LDB(B1, 1, 1); PG8_STAGE(PG8_SB(1, 0), b3, voffB);
            PG8_BAR; PG8_WAIT_L(0); PG8_MMA(0, 1, At, B1); PG8_BAR;
            PG8_LDA(At, 1, 1); PG8_STAGE(PG8_SA(1, 0), a3, voffA);
            PG8_BAR; PG8_WAIT_L(0); PG8_MMA(1, 0, At, B0); PG8_BAR; PG8_SCHED;
            PG8_STAGE(PG8_SB(1, 1), b3 + hstepB, voffB);
            PG8_WAIT_V(6); PG8_BAR; PG8_MMA(1, 1, At, B1); PG8_BAR;
            }
        }
        if constexpr (ALIGN_EPI) { if (wr == 0) PG8_BAR; }
        if constexpr (!Epi::AFTER_DRAIN) { E(acc, cur, wr, wc, fr, fq); }
        if (!has_next) break;
#pragma unroll
        for (int a = 0; a < 2; ++a)
#pragma unroll
            for (int b = 0; b < 2; ++b)
#pragma unroll
                for (int m = 0; m < 4; ++m)
#pragma unroll
                    for (int n = 0; n < 2; ++n) acc[a][b][m][n] = (f32x4){0.f, 0.f, 0.f, 0.f};
        cur = nxt; cA = nA; cB = nB; ++ui;
        if constexpr (ALIGN_EPI) { if (wr == 1) PG8_BAR; }
    }
    PG8_WAIT_V(0);
    if constexpr (!ALIGN_EPI) { if (wr == 0) PG8_BAR; }
    PG8_BAR;
    if constexpr (Epi::AFTER_DRAIN) { E.fused(acc, cur, wr, wc, fr, fq, lds, wid, lane); }
#undef PG8_SA
#undef PG8_SB
#undef PG8_STAGE
#undef PG8_LDA
#undef PG8_LDB
#undef PG8_MMA
#undef PG8_WAIT_V
#undef PG8_WAIT_L
#undef PG8_BAR
#undef PG8_SCHED
}

#define PG8_FOR_GROUPS(acc, wr, wc, fr, fq, BODY) \
    _Pragma("unroll") for (int ai = 0; ai < 2; ++ai) _Pragma("unroll") for (int m = 0; m < 4; ++m) _Pragma("unroll") for (int bj = 0; bj < 2; ++bj) { \
        const int trow = ai * HALF + wr * 64 + m * 16 + fr, tcol = bj * HALF + wc * 32 + 8 * fq; f32x4 v0 = acc[ai][bj][m][0], v1 = acc[ai][bj][m][1]; BODY }

__device__ __forceinline__ u32x4 pack8(f32x4 v0, f32x4 v1) { u32x4 w; w.x = cvt_pk_bf16(v0[0], v0[1]); w.y = cvt_pk_bf16(v0[2], v0[3]); w.z = cvt_pk_bf16(v1[0], v1[1]); w.w = cvt_pk_bf16(v1[2], v1[3]); return w; }

struct EpiPlain {
    static constexpr bool PERM = true, AFTER_DRAIN = false;
    bf16_t* O; int ldc;
    __device__ __forceinline__ void operator()(const f32x4 (&acc)[2][2][4][2], const Unit& u, int wr, int wc, int fr, int fq) const {
        PG8_FOR_GROUPS(acc, wr, wc, fr, fq, { *(u32x4*)(O + (size_t)(u.pm * BM + trow) * ldc + u.pn * BM + tcol) = pack8(v0, v1); })
    }
};
struct EpiInProj {
    static constexpr bool PERM = true, AFTER_DRAIN = false;
    bf16_t* proja; bf16_t* g01; bf16_t* g2; bf16_t* memkv;
    __device__ __forceinline__ void operator()(const f32x4 (&acc)[2][2][4][2], const Unit& u, int wr, int wc, int fr, int fq) const {
        if (u.tag == 1) {
            PG8_FOR_GROUPS(acc, wr, wc, fr, fq, { *(u32x4*)(memkv + (size_t)((u.pm - 128) * BM + trow) * 1024 + (u.pn - 27) * BM + tcol) = pack8(v0, v1); })
        } else if (u.pn < 15) {
            const float sc = (u.pn < 2) ? C2_FOX : ((u.pn == 12 || u.pn == 13) ? C2_MEM : 1.0f);
            PG8_FOR_GROUPS(acc, wr, wc, fr, fq, { v0 = v0 * sc; v1 = v1 * sc; *(u32x4*)(proja + (size_t)(u.pm * BM + trow) * PA + u.pn * BM + tcol) = pack8(v0, v1); })
        } else {
            bf16_t* base; int ld, c0;
            if (u.pn < 23) { base = g01; ld = 2048; c0 = (u.pn - 15) * BM; } else { base = g2; ld = 1024; c0 = (u.pn - 23) * BM; }
            PG8_FOR_GROUPS(acc, wr, wc, fr, fq, {
                _Pragma("unroll") for (int e = 0; e < 4; ++e) { v0[e] = __builtin_amdgcn_rcpf(1.0f + __builtin_amdgcn_exp2f(-LOG2E * v0[e])); v1[e] = __builtin_amdgcn_rcpf(1.0f + __builtin_amdgcn_exp2f(-LOG2E * v1[e])); }
                *(u32x4*)(base + (size_t)(u.pm * BM + trow) * ld + c0 + tcol) = pack8(v0, v1); })
        }
    }
};
struct EpiMerge {
    static constexpr bool PERM = true, AFTER_DRAIN = false;
    const bf16_t* g01; const bf16_t* g2; bf16_t* merged;
    __device__ __forceinline__ void operator()(const f32x4 (&acc)[2][2][4][2], const Unit& u, int wr, int wc, int fr, int fq) const {
        const int b = u.tag;
        PG8_FOR_GROUPS(acc, wr, wc, fr, fq, {
            const size_t row = (size_t)(u.pm * BM + trow); const int col = u.pn * BM + tcol;
            const u32x4 gw = (b < 2) ? *(const u32x4*)(g01 + row * 2048 + b * 1024 + col) : *(const u32x4*)(g2 + row * 1024 + col);
            v0[0] *= bflo(gw.x); v0[1] *= bfhi(gw.x); v0[2] *= bflo(gw.y); v0[3] *= bfhi(gw.y); v1[0] *= bflo(gw.z); v1[1] *= bfhi(gw.z); v1[2] *= bflo(gw.w); v1[3] *= bfhi(gw.w);
            bf16_t* mp = merged + row * 1024 + col;
            if (b > 0) { const u32x4 mw = *(const u32x4*)mp;
                v0[0] += bflo(mw.x); v0[1] += bfhi(mw.x); v0[2] += bflo(mw.y); v0[3] += bfhi(mw.y); v1[0] += bflo(mw.z); v1[1] += bfhi(mw.z); v1[2] += bflo(mw.w); v1[3] += bfhi(mw.w); }
            *(u32x4*)mp = pack8(v0, v1); })
    }
};
struct EpiSwiGLU {
    static constexpr bool PERM = true, AFTER_DRAIN = false;
    bf16_t* hid;
    __device__ __forceinline__ void operator()(const f32x4 (&acc)[2][2][4][2], const Unit& u, int wr, int wc, int fr, int fq) const {
#pragma unroll
        for (int ai = 0; ai < 2; ++ai)
#pragma unroll
            for (int m = 0; m < 4; ++m) {
                const int trow = ai * HALF + wr * 64 + m * 16 + fr, tcol = wc * 32 + 8 * fq;
                f32x4 g0 = acc[ai][0][m][0], g1 = acc[ai][0][m][1]; const f32x4 u0 = acc[ai][1][m][0], u1 = acc[ai][1][m][1];
#pragma unroll
                for (int e = 0; e < 4; ++e) { g0[e] = g0[e] * __builtin_amdgcn_rcpf(1.0f + __builtin_amdgcn_exp2f(-LOG2E * g0[e])) * u0[e]; g1[e] = g1[e] * __builtin_amdgcn_rcpf(1.0f + __builtin_amdgcn_exp2f(-LOG2E * g1[e])) * u1[e]; }
                *(u32x4*)(hid + (size_t)(u.pm * BM + trow) * DFF + u.pn * HALF + tcol) = pack8(g0, g1);
            }
    }
};
}

typedef GAS unsigned gu32;
#define RLX_AGENT __ATOMIC_RELAXED, __HIP_MEMORY_SCOPE_AGENT
#define XB_TMO      128
#define XB_XCNT(j)  (256  + 64 * (j))
#define XB_XSUB(j)  (1280 + 64 * (j))
#define XB_XGEN(j)  (2304 + 64 * (j))
#define XB_TOP      3328
#define XB_TOPGEN   3392
#define XCD_BAR_WORDS 3456
#define XB_SPIN_CAP (1u << 18)
__device__ __forceinline__ unsigned xb_ld(unsigned* p)              { return __hip_atomic_load(p, __ATOMIC_RELAXED, __HIP_MEMORY_SCOPE_AGENT); }
__device__ __forceinline__ unsigned xb_add(unsigned* p, unsigned v) { return __hip_atomic_fetch_add(p, v, __ATOMIC_RELAXED, __HIP_MEMORY_SCOPE_AGENT); }
__device__ __forceinline__ unsigned xb_xcc_id() { return (unsigned)__builtin_amdgcn_s_getreg((3 << 11) | 20) & 0xFu; }
#define XB_SPIN(cond, bar) do { unsigned _sp = 0; while (cond) { __builtin_amdgcn_s_sleep(1); \
    if ((++_sp & 255u) == 0u) { if (xb_ld(&(bar)[XB_TMO])) break; if (_sp > XB_SPIN_CAP) { atomicAdd(&(bar)[XB_TMO], 1u); break; } } } } while (0)
struct XcdBarrier { unsigned* bar; unsigned x; volatile LAS unsigned* st; };
__device__ __forceinline__ XcdBarrier xcd_barrier_post(unsigned* bar, volatile LAS unsigned* st) {
    XcdBarrier b; b.bar = bar; b.x = xb_xcc_id(); b.st = st;
    if (threadIdx.x == 0) (void)xb_add(&bar[XB_XCNT(b.x)], 1u);
    return b;
}
__device__ __forceinline__ void xcd_barrier_complete(unsigned* bar, unsigned x, unsigned& nloc, unsigned& nx) {
    const unsigned G = gridDim.x * gridDim.y * gridDim.z;
    unsigned sum, cnt, mine, sp = 0u;
    for (;;) {
        sum = 0u; cnt = 0u; mine = 0u;
#pragma unroll
        for (unsigned j = 0; j < 16; ++j) { const unsigned c = xb_ld(&bar[XB_XCNT(j)]); sum += c; cnt += (c > 0u) ? 1u : 0u; mine = (j == x) ? c : mine; }
        if (sum == G) break;
        __builtin_amdgcn_s_sleep(1);
        if ((++sp & 255u) == 0u) { if (xb_ld(&bar[XB_TMO])) break; if (sp > XB_SPIN_CAP) { atomicAdd(&bar[XB_TMO], 1u); break; } }
    }
    nloc = mine > 0u ? mine : 1u; nx = cnt > 0u ? cnt : 1u;
}
__device__ __forceinline__ void xcd_barrier(const XcdBarrier& b) {
    asm volatile("s_waitcnt vmcnt(0)" ::: "memory");
    __syncthreads();
    if (threadIdx.x == 0) {
        unsigned* bar = b.bar;
        __builtin_amdgcn_s_waitcnt(0);
        unsigned nloc = b.st[0], nx = b.st[1];
        if (nloc == 0u) { xcd_barrier_complete(bar, b.x, nloc, nx); b.st[0] = nloc; b.st[1] = nx; }
        const unsigned old = xb_add(&bar[XB_XSUB(b.x)], 1u);
        const unsigned gen = old / nloc;
        if (old + 1u == (gen + 1u) * nloc) {
            __builtin_amdgcn_fence(__ATOMIC_RELEASE, "agent");
            asm volatile("s_waitcnt vmcnt(0)" ::: "memory");
            const unsigned og = xb_add(&bar[XB_TOP], 1u);
            const unsigned tg = og / nx;
            if (og + 1u == (tg + 1u) * nx) xb_add(&bar[XB_TOPGEN], 1u);
            else XB_SPIN(xb_ld(&bar[XB_TOPGEN]) == tg, bar);
            __builtin_amdgcn_fence(__ATOMIC_ACQUIRE, "agent");
            xb_add(&bar[XB_XGEN(b.x)], 1u);
            asm volatile("s_waitcnt vmcnt(0)" ::: "memory");
        } else {
            XB_SPIN(xb_ld(&bar[XB_XGEN(b.x)]) == gen, bar);
            __builtin_amdgcn_fence(__ATOMIC_ACQUIRE, "agent");
            asm volatile("s_waitcnt vmcnt(0)" ::: "memory");
        }
    }
    __syncthreads();
}

struct Frame {
    LAS unsigned char* lds;
    volatile LAS unsigned* MISC;
    gu32* ctl;
    int tid, lane, wave;
    int vcu, G;
    float* out; unsigned char* ws;
};
enum { I_X = 0, I_MEM, I_PRE1, I_POST1, I_PRE2, I_POST2, I_MEMG, I_WIN, I_FBIAS, I_MU, I_W0, I_WUP, I_A0, I_AUP, I_GUP, I_KK, I_KA, I_RK, I_GNG, I_GNB,
       I_WMEMKV, I_WFOX, I_WRWKV, I_WMEMO, I_WO, I_WG, I_WU, I_WD };

__device__ __forceinline__ const float* inptr(int i) {
    int ii = i; asm volatile("" : "+s"(ii));
    const __attribute__((address_space(4))) char* ka = (const __attribute__((address_space(4))) char*)__builtin_amdgcn_kernarg_segment_ptr();
    return *(const float* const __attribute__((address_space(4)))*)(ka + (size_t)ii * 8);
}
#define INP(i) inptr(i)
__device__ __forceinline__ void p0_transpose_item(const float* src, int ldsrc, int K, bf16_t* WT, int drow0, int k0, LAS float* scr, int lane) {
#pragma unroll 8
    for (int i = 0; i < 32; ++i) { const int kk = 2 * i + (lane >> 5); scr[kk * 33 + (lane & 31)] = src[(size_t)(k0 + kk) * ldsrc + (lane & 31)]; }
    LDS_WAIT(); asm volatile("" ::: "memory");
    const int c = lane & 7;
#pragma unroll
    for (int j = 0; j < 4; ++j) { const int n = (lane >> 3) + 8 * j; const LAS float* s = scr + (8 * c) * 33 + n;
        u32x4 o; o.x = pk2(s[0 * 33], s[1 * 33]); o.y = pk2(s[2 * 33], s[3 * 33]); o.z = pk2(s[4 * 33], s[5 * 33]); o.w = pk2(s[6 * 33], s[7 * 33]);
        *(GAS u32x4*)(WT + (size_t)(drow0 + n) * K + k0 + 8 * c) = o; }
    LDS_WAIT(); asm volatile("" ::: "memory");
}
struct TJob { int src_in; int ldsrc; int K; int scol; int ncols; size_t dst_off; int drow; int mode; };
static constexpr TJob kJobs[24] = {
    {I_WUP, 512, 64, 0, 512, WS_WLORA, 0, 0},
    {I_AUP, 512, 64, 0, 512, WS_WLORA + 65536, 0, 0},
    {I_GUP, 512, 128, 0, 512, WS_WLORA + 131072, 0, 0},
    {I_WIN, INCOLS, 1024, 0,    512, WS_WALL, 0,    0},
    {I_WIN, INCOLS, 1024, 512,  512, WS_WALL, 512,  0},
    {I_WIN, INCOLS, 1024, 1024, 512, WS_WALL, 1024, 0},
    {I_WIN, INCOLS, 1024, 1544, 512, WS_WALL, 1536, 0},
    {I_WIN, INCOLS, 1024, 2056, 512, WS_WALL, 2048, 0},
    {I_WIN, INCOLS, 1024, 2568, 512, WS_WALL, 2560, 0},
    {I_WIN, INCOLS, 1024, 3336, 512, WS_WALL, 3072, 0},
    {I_WIN, INCOLS, 1024, 3080, 64,  WS_WALL, 3584, 0},
    {I_WIN, INCOLS, 1024, 3144, 64,  WS_WALL, 3648, 0},
    {I_WIN, INCOLS, 1024, 3208, 128, WS_WALL, 3712, 0},
    {I_WIN, INCOLS, 1024, 3848, 1024, WS_WALL, 3840, 0},
    {I_WIN, INCOLS, 1024, 4872, 1024, WS_WALL, 4864, 0},
    {I_WIN, INCOLS, 1024, 5896, 1024, WS_WALL, 5888, 0},
    {I_WMEMKV, 1024, 1024, 0, 1024, WS_WALL, 6912, 0},
    {I_WFOX,  1024, 512, 0, 1024, WS_WBR, 0,    0},
    {I_WRWKV, 1024, 512, 0, 1024, WS_WBR, 1024, 0},
    {I_WMEMO, 1024, 512, 0, 1024, WS_WBR, 2048, 0},
    {I_WO, 1024, 1024, 0, 1024, WS_WO, 0, 0},
    {I_WG, DFF, 1024, 0, DFF, WS_WGU, 0,   1},
    {I_WU, DFF, 1024, 0, DFF, WS_WGU, 128, 1},
    {I_WD, 1024, DFF, 0, 1024, WS_WDN, 0, 0}};
__device__ __forceinline__ void p0_prologue(Frame& F) {
    int tid_ = threadIdx.x; asm volatile("" : "+v"(tid_)); const int lane_ = tid_ & 63, wave_ = __builtin_amdgcn_readfirstlane(tid_ >> 6);
    LAS float* scr = (LAS float*)(F.lds + RING_OFF + wave_ * 16384);
    const int gw = F.vcu * NWAVES + wave_, NGW = F.G * NWAVES;
    int base = 0;
#pragma unroll
    for (int j = 0; j < 24; ++j) {
        const TJob jb = kJobs[j]; const int nblk = jb.ncols / 32, nitem = (jb.K / 64) * nblk;
        int it = gw - (base % NGW); if (it < 0) it += NGW;
        const float* srcp = INP(jb.src_in) + jb.scol; bf16_t* dstp = (bf16_t*)(F.ws + jb.dst_off);
#pragma unroll 1
        for (; it < nitem; it += NGW) {
            const int kb = it / nblk, nb = it % nblk, n0 = nb * 32;
            const int drow0 = (jb.mode == 0) ? (jb.drow + n0) : (256 * (n0 / 128) + jb.drow + (n0 % 128));
            p0_transpose_item(srcp + n0, jb.ldsrc, jb.K, dstp, drow0, 64 * kb, scr, lane_);
        }
        base += nitem;
    }
    {
        const float* win = INP(I_WIN); const float* g1 = INP(I_PRE1); const float* fb = INP(I_FBIAS); const float* xin = INP(I_X);
        bf16_t* XN = (bf16_t*)(F.ws + WS_XNALL); float* LS = (float*)(F.ws + WS_LS);
        f32x4 gv[4];
#pragma unroll
        for (int j = 0; j < 4; ++j) gv[j] = *(const f32x4*)(g1 + 4 * lane_ + 256 * j);
        for (int m = gw; m < M; m += NGW) {
            const GAS f32x4* xr = (const GAS f32x4*)(xin + (size_t)m * DM) + lane_;
            f32x4 v[4]; float s = 0.f;
#pragma unroll
            for (int j = 0; j < 4; ++j) { v[j] = xr[64 * j]; s += (v[j].x * v[j].x + v[j].y * v[j].y) + (v[j].z * v[j].z + v[j].w * v[j].w); }
            const float rn = 1.0f / sqrtf(wave_sum(s) * (1.f / DM) + NORM_EPS);
            float fa[8];
#pragma unroll
            for (int h = 0; h < 8; ++h) fa[h] = 0.f;
#pragma unroll
            for (int j = 0; j < 4; ++j) { v[j] = v[j] * rn * gv[j];
#pragma unroll
                for (int e = 0; e < 4; ++e) { const float* wp = win + (size_t)(4 * lane_ + 256 * j + e) * INCOLS + 1536; const f32x4 w0 = *(const f32x4*)wp, w1 = *(const f32x4*)(wp + 4);
                    const float u = v[j][e]; fa[0] += u * w0.x; fa[1] += u * w0.y; fa[2] += u * w0.z; fa[3] += u * w0.w; fa[4] += u * w1.x; fa[5] += u * w1.y; fa[6] += u * w1.z; fa[7] += u * w1.w; } }
            GAS unsigned long long* o8 = (GAS unsigned long long*)(XN + (size_t)m * DM) + lane_;
#pragma unroll
            for (int j = 0; j < 4; ++j) o8[64 * j] = (unsigned long long)pk2(v[j].x, v[j].y) | ((unsigned long long)pk2(v[j].z, v[j].w) << 32);
#pragma unroll
            for (int h = 0; h < 8; ++h) fa[h] = wave_sum(fa[h]);
            if (lane_ < 8) { float f = fa[0];
#pragma unroll
                for (int h = 1; h < 8; ++h) f = (lane_ == h) ? fa[h] : f;
                f += fb[lane_];
                const float ls = fminf(f, 0.f) - log1pf(__expf(-fabsf(f)));
                LS[(size_t)m * 8 + lane_] = ls; }
        }
    }
    {
        const float* g1 = INP(I_MEMG); const float* memin = INP(I_MEM); bf16_t* XN = (bf16_t*)(F.ws + WS_XNALL) + (size_t)M * DM;
        f32x4 gv[4];
#pragma unroll
        for (int j = 0; j < 4; ++j) gv[j] = *(const f32x4*)(g1 + 4 * lane_ + 256 * j);
        for (int m = gw; m < MMEM; m += NGW) {
            const GAS f32x4* xr = (const GAS f32x4*)(memin + (size_t)m * DM) + lane_;
            f32x4 v[4]; float s = 0.f;
#pragma unroll
            for (int j = 0; j < 4; ++j) { v[j] = xr[64 * j]; s += (v[j].x * v[j].x + v[j].y * v[j].y) + (v[j].z * v[j].z + v[j].w * v[j].w); }
            const float rn = 1.0f / sqrtf(wave_sum(s) * (1.f / DM) + NORM_EPS);
            GAS unsigned long long* o8 = (GAS unsigned long long*)(XN + (size_t)m * DM) + lane_;
#pragma unroll
            for (int j = 0; j < 4; ++j) { v[j] = v[j] * rn * gv[j]; o8[64 * j] = (unsigned long long)pk2(v[j].x, v[j].y) | ((unsigned long long)pk2(v[j].z, v[j].w) << 32); }
        }
    }
}

__device__ __forceinline__ void load_row_bf16(const bf16_t* p, int lane, f32x4 (&v)[4]) {
#pragma unroll
    for (int j = 0; j < 4; ++j) { const u32x2 w = *(const u32x2*)(p + 4 * lane + 256 * j); v[j] = (f32x4){bflo(w.x), bfhi(w.x), bflo(w.y), bfhi(w.y)}; }
}
__device__ __forceinline__ void p3c_rows(Frame& F) {
    int tid_ = threadIdx.x; asm volatile("" : "+v"(tid_)); const int lane_ = tid_ & 63, wave_ = __builtin_amdgcn_readfirstlane(tid_ >> 6);
    const int gw = F.vcu * NWAVES + wave_, NGW = F.G * NWAVES;
    const bf16_t* Y = (const bf16_t*)(F.ws + WS_Y); bf16_t* U2 = (bf16_t*)(F.ws + WS_U2);
    f32x4 g1[4], g2[4];
    const float* p1_ = INP(I_POST1); const float* p2_ = INP(I_PRE2); const float* xin = INP(I_X);
#pragma unroll
    for (int j = 0; j < 4; ++j) { g1[j] = *(const f32x4*)(p1_ + 4 * lane_ + 256 * j); g2[j] = *(const f32x4*)(p2_ + 4 * lane_ + 256 * j); }
    for (int m = gw; m < M; m += NGW) {
        f32x4 y[4]; load_row_bf16(Y + (size_t)m * DM, lane_, y);
        float s = 0.f;
#pragma unroll
        for (int j = 0; j < 4; ++j) s += (y[j].x * y[j].x + y[j].y * y[j].y) + (y[j].z * y[j].z + y[j].w * y[j].w);
        const float rn = 1.0f / sqrtf(wave_sum(s) * (1.f / DM) + NORM_EPS);
        const GAS f32x4* xr = (const GAS f32x4*)(xin + (size_t)m * DM) + lane_;
        GAS f32x4* hr = (GAS f32x4*)(F.out + (size_t)m * DM) + lane_;
        float s2 = 0.f;
#pragma unroll
        for (int j = 0; j < 4; ++j) { y[j] = xr[64 * j] + y[j] * rn * g1[j]; hr[64 * j] = y[j]; s2 += (y[j].x * y[j].x + y[j].y * y[j].y) + (y[j].z * y[j].z + y[j].w * y[j].w); }
        const float rn2 = 1.0f / sqrtf(wave_sum(s2) * (1.f / DM) + NORM_EPS);
        GAS unsigned long long* o8 = (GAS unsigned long long*)(U2 + (size_t)m * DM) + lane_;
#pragma unroll
        for (int j = 0; j < 4; ++j) { const f32x4 u = y[j] * rn2 * g2[j]; o8[64 * j] = (unsigned long long)pk2(u.x, u.y) | ((unsigned long long)pk2(u.z, u.w) << 32); }
    }
}
__device__ __forceinline__ void p5c_rows(Frame& F) {
    int tid_ = threadIdx.x; asm volatile("" : "+v"(tid_)); const int lane_ = tid_ & 63, wave_ = __builtin_amdgcn_readfirstlane(tid_ >> 6);
    const int gw = F.vcu * NWAVES + wave_, NGW = F.G * NWAVES;
    const bf16_t* FO = (const bf16_t*)(F.ws + WS_FO);
    f32x4 g1[4];
    const float* p2_ = INP(I_POST2);
#pragma unroll
    for (int j = 0; j < 4; ++j) g1[j] = *(const f32x4*)(p2_ + 4 * lane_ + 256 * j);
    for (int m = gw; m < M; m += NGW) {
        f32x4 y[4]; load_row_bf16(FO + (size_t)m * DM, lane_, y);
        float s = 0.f;
#pragma unroll
        for (int j = 0; j < 4; ++j) s += (y[j].x * y[j].x + y[j].y * y[j].y) + (y[j].z * y[j].z + y[j].w * y[j].w);
        const float rn = 1.0f / sqrtf(wave_sum(s) * (1.f / DM) + NORM_EPS);
        GAS f32x4* hr = (GAS f32x4*)(F.out + (size_t)m * DM) + lane_;
#pragma unroll
        for (int j = 0; j < 4; ++j) hr[64 * j] = hr[64 * j] + y[j] * rn * g1[j];
    }
}

namespace fox {
using s16x4=__attribute__((ext_vector_type(4)))short;
using f32x16=__attribute__((ext_vector_type(16)))float;
constexpr int D=64;
constexpr int NW=8,QBLK=32,QB=QBLK*NW,KVBLK=64,NQB=SEQ/QB;
__device__ __forceinline__ int crow(int r,int hi){return (r&3)+8*(r>>2)+4*hi;}
#define SBAR() __builtin_amdgcn_sched_barrier(0)
__device__ __forceinline__ void cmask(f32x16&p0,f32x16&p1,int jb,int qrel,int hi){
  const float NEG=-INFINITY; int kb=64*jb+4*hi;
  #pragma unroll
  for(int r=0;r<16;++r){int kv=kb+(r&3)+8*(r>>2); if(kv>qrel)p0[r]=NEG; if(kv+32>qrel)p1[r]=NEG;}
}
constexpr int NSLOT=3, SLOTB=8192;
constexpr int LDS_K=0, LDS_V=NSLOT*SLOTB, LDS_WS=2*NSLOT*SLOTB, LDS_OST=LDS_WS+NW*64*4, LDS_CB=LDS_OST+NW*4096, LDS_SCAN=LDS_CB+8192, LDS_BYTES_=LDS_SCAN+64;
__device__ __forceinline__ void glds16(const void*gsrc,unsigned lds_dst){unsigned keep;
  asm volatile("s_mov_b32 %0, m0\n\ts_mov_b32 m0, %2\n\ts_nop 0\n\tglobal_load_lds_dwordx4 %1, off\n\ts_mov_b32 m0, %0":"=&s"(keep):"v"(gsrc),"s"(lds_dst):"memory");}
__device__ __forceinline__ float max3f(float a,float b,float c){float r;asm("v_max3_f32 %0, %1, %2, %3":"=v"(r):"v"(a),"v"(b),"v"(c));return r;}
__device__ __forceinline__ float max2f(float a,float b){float r;asm("v_max_f32_e32 %0, %1, %2":"=v"(r):"v"(a),"v"(b));return r;}
__device__ __forceinline__ float fadd_s(float a,float b){float r;asm("v_add_f32_e32 %0, %1, %2":"=v"(r):"v"(a),"v"(b));return r;}
__device__ __forceinline__ float fsub_s(float a,float b){float r;asm("v_sub_f32_e32 %0, %1, %2":"=v"(r):"v"(a),"v"(b));return r;}
typedef float f32x2_t __attribute__((ext_vector_type(2))); typedef __bf16 bf16x2v_t __attribute__((ext_vector_type(2)));
__device__ __forceinline__ unsigned cvtpk_s(float lo,float hi){f32x2_t v={lo,hi};bf16x2v_t b=__builtin_convertvector(v,bf16x2v_t);return __builtin_bit_cast(unsigned,b);}
#define WAIT_BAR(N) asm volatile("s_waitcnt vmcnt(" #N ") lgkmcnt(0)\n\ts_barrier":::"memory")
#define KBF(w) (kbw[0]=(w),kbw)

__device__ __forceinline__ void qkt(f32x16&p0,f32x16&p1,const char*Kslot,const bf16x8*qr,int r32,int hi,u32x4 kb0,u32x4 kb1,bf16x8 qr4){
  const char*kb=Kslot+hi*1024+r32*16;
  #pragma unroll
  for(int d0=0;d0<4;++d0){
    const bf16x8 b0=*reinterpret_cast<const bf16x8*>(kb+d0*2048);
    const bf16x8 b1=*reinterpret_cast<const bf16x8*>(kb+d0*2048+512);
    if(d0==0){p0=__builtin_amdgcn_mfma_f32_32x32x16_bf16(b0,qr[0],f32x16{},0,0,0);p1=__builtin_amdgcn_mfma_f32_32x32x16_bf16(b1,qr[0],f32x16{},0,0,0);}
    else{p0=__builtin_amdgcn_mfma_f32_32x32x16_bf16(b0,qr[d0],p0,0,0,0);p1=__builtin_amdgcn_mfma_f32_32x32x16_bf16(b1,qr[d0],p1,0,0,0);}}
  p0=__builtin_amdgcn_mfma_f32_32x32x16_bf16(__builtin_bit_cast(bf16x8,kb0),qr4,p0,0,0,0);p1=__builtin_amdgcn_mfma_f32_32x32x16_bf16(__builtin_bit_cast(bf16x8,kb1),qr4,p1,0,0,0);
}
typedef __attribute__((address_space(3))) const char* lds_cptr;
typedef short v4i16_t __attribute__((ext_vector_type(4)));
__device__ __forceinline__ void kload8(bf16x8*kf,lds_cptr kp){
  kf[0]=*(const __attribute__((address_space(3))) bf16x8*)(kp);      kf[1]=*(const __attribute__((address_space(3))) bf16x8*)(kp+512);
  kf[2]=*(const __attribute__((address_space(3))) bf16x8*)(kp+2048); kf[3]=*(const __attribute__((address_space(3))) bf16x8*)(kp+2560);
  kf[4]=*(const __attribute__((address_space(3))) bf16x8*)(kp+4096); kf[5]=*(const __attribute__((address_space(3))) bf16x8*)(kp+4608);
  kf[6]=*(const __attribute__((address_space(3))) bf16x8*)(kp+6144); kf[7]=*(const __attribute__((address_space(3))) bf16x8*)(kp+6656);
}
__device__ __forceinline__ void kload2(bf16x8*kf,lds_cptr kp,int j){ kf[2*j]=*(const __attribute__((address_space(3))) bf16x8*)(kp+j*2048); kf[2*j+1]=*(const __attribute__((address_space(3))) bf16x8*)(kp+j*2048+512); }
__device__ __forceinline__ s16x4 vtr(lds_cptr p){ return __builtin_bit_cast(s16x4,__builtin_amdgcn_ds_read_tr16_b64_v4i16((__attribute__((address_space(3))) v4i16_t*)p)); }
__device__ __forceinline__ float rowmax(const f32x16&p0,const f32x16&p1){
  float a=max3f(p0[0],p0[1],p1[0]),b=max3f(p0[2],p0[3],p1[1]);a=max3f(a,p1[2],p1[3]);
  #pragma unroll
  for(int r=4;r<16;r+=4){a=max3f(a,p0[r],p0[r+1]);b=max3f(b,p0[r+2],p0[r+3]);a=max3f(a,p1[r],p1[r+1]);b=max3f(b,p1[r+2],p1[r+3]);}
  const float m=max2f(a,b);
  auto rr=__builtin_amdgcn_permlane32_swap(__float_as_uint(m),__float_as_uint(m),false,false);
  return max2f(__uint_as_float(rr[0]),__uint_as_float(rr[1]));
}
__device__ __forceinline__ void pv(f32x16*o,int vb,bf16x8 pa0,bf16x8 pa1,bf16x8 pa2,bf16x8 pa3){
  #pragma unroll
  for(int d0=0;d0<2;++d0){s16x4 lo[4],hi[4];
    #pragma unroll
    for(int ks=0;ks<4;++ks){
      asm volatile("ds_read_b64_tr_b16 %0,%1 offset:%c2":"=&v"(lo[ks]):"v"(vb),"i"(d0*4096+ks*1024):"memory");
      asm volatile("ds_read_b64_tr_b16 %0,%1 offset:%c2":"=&v"(hi[ks]):"v"(vb),"i"(d0*4096+ks*1024+512):"memory");}
    asm volatile("s_waitcnt lgkmcnt(0)":::"memory");SBAR();
    #define PK(k) (bf16x8){lo[k][0],lo[k][1],lo[k][2],lo[k][3],hi[k][0],hi[k][1],hi[k][2],hi[k][3]}
    o[d0]=__builtin_amdgcn_mfma_f32_32x32x16_bf16(pa0,PK(0),o[d0],0,0,0);
    o[d0]=__builtin_amdgcn_mfma_f32_32x32x16_bf16(pa1,PK(1),o[d0],0,0,0);
    o[d0]=__builtin_amdgcn_mfma_f32_32x32x16_bf16(pa2,PK(2),o[d0],0,0,0);
    o[d0]=__builtin_amdgcn_mfma_f32_32x32x16_bf16(pa3,PK(3),o[d0],0,0,0);
    #undef PK
  }
}
#define ATTN_STORE16(p,v) (*(u32x4*)(p)=(v))
template<int THRL> __device__ __forceinline__ void attn_unit(int b,int h,int qb,bf16_t*PJ,const float*LS,char*shm){
  int tid=threadIdx.x; asm volatile("":"+v"(tid));
  const int lane=tid&63,r32=lane&31,hi=lane>>5; const int wid=__builtin_amdgcn_readfirstlane(tid>>6);
  const long rowbase=(long)b*SEQ; const int q0=qb*QB;
  { float*cs=(float*)(shm+LDS_CB); float*wt=(float*)(shm+LDS_SCAN);
    const float*ls=LS+(size_t)rowbase*8+h;
    const float e0=ls[(4*tid+0)*8],e1=ls[(4*tid+1)*8],e2=ls[(4*tid+2)*8],e3=ls[(4*tid+3)*8];
    const float s=(e0+e1)+(e2+e3); float inc=s;
    #pragma unroll
    for(int o=1;o<64;o<<=1){const float n=__shfl_up(inc,o); if(lane>=o)inc+=n;}
    if(lane==63)wt[wid]=inc;
    __syncthreads();
    float base=0.f; for(int w=0;w<wid;++w)base+=wt[w];
    float c=base+inc-s; c+=e0; const float c0=c; c+=e1; const float c1=c; c+=e2; const float c2=c; c+=e3; const float c3=c;
    cs[4*tid+0]=c0;cs[4*tid+1]=c1;cs[4*tid+2]=c2;cs[4*tid+3]=c3;
    __syncthreads();
    const float cref=cs[q0+QB-1];
    __syncthreads();
    unsigned*cbw=(unsigned*)cs; const float cc[4]={c0,c1,c2,c3};
    #pragma unroll
    for(int e=0;e<4;++e){ const float bv=(cref-cc[e])*LOG2E; const unsigned bh=f2bf(bv); const float res=bv-__builtin_bit_cast(float,bh<<16); cbw[4*tid+e]=bh|(f2bf(res)<<16); }
    __syncthreads();
  }
  const bf16_t*Qw=PJ+(rowbase+q0+wid*QBLK)*PA+C_FQ+h*D;
  const bf16_t*Kh=PJ+rowbase*PA+C_FK+h*D,*Vh=PJ+rowbase*PA+C_FV+h*D;
  const unsigned lds0=(unsigned)(uintptr_t)shm;
  float*wsf=(float*)(shm+LDS_WS)+wid*64;
  const bf16_t*ksrc=Kh+(long)lane*PA+wid*8;
  const bf16_t*vsrc=Vh+(long)(16*(wid&3)+(lane>>2))*PA+(wid>>2)*32+(lane&3)*8;
  const unsigned kdst=lds0+LDS_K+wid*1024, vdst=lds0+LDS_V+wid*1024;
  #define DMA_K(t,slot) glds16(ksrc+(long)(t)*KVBLK*PA,(unsigned)__builtin_amdgcn_readfirstlane(kdst+(slot)))
  #define DMA_V(t,slot) glds16(vsrc+(long)(t)*KVBLK*PA,(unsigned)__builtin_amdgcn_readfirstlane(vdst+(slot)))
  const int vb0=(int)(lds0+LDS_V)+((lane>>4)&1)*32+(lane&3)*8+(4*hi+((lane&15)>>2))*64;
  const char*Kbase=shm+LDS_K; bf16x8 kf[8];
  const lds_cptr shm3=(lds_cptr)shm; const lds_cptr kp0=shm3+LDS_K+hi*1024+r32*16; const lds_cptr vp0=shm3+LDS_V+((lane>>4)&1)*32+(lane&3)*8+(4*hi+((lane&15)>>2))*64;
  const __attribute__((address_space(3))) unsigned* cbp=(const __attribute__((address_space(3))) unsigned*)(shm3+LDS_CB)+r32;
  const unsigned kone1=hi?0u:0x3F803F80u, kone2=hi?0u:0x00003F80u;
  u32x4 kbw=(u32x4){0u,kone1,kone2,0u};
  u32x4 q4w=(u32x4){kone1,0u,0u,0u};
  #define QR4 __builtin_bit_cast(bf16x8,q4w)
  #define SETM() do{ const float nm_=-mhat; const unsigned h1_=f2bf(nm_); const float r1_=nm_-__builtin_bit_cast(float,h1_<<16); const unsigned h2_=f2bf(r1_); const float r2_=r1_-__builtin_bit_cast(float,h2_<<16); \
      q4w[1]=hi?0u:(h1_|(h2_<<16)); q4w[2]=hi?0u:f2bf(r2_); }while(0)
  #define BW(t,half) (hi?0u:cbp[(t)*64+(half)*32])
  const int NT=(q0+QB)/KVBLK;
  DMA_K(0,0);DMA_V(0,0);DMA_K(1,SLOTB);
  bf16x8 qr[4];
  #pragma unroll
  for(int d0=0;d0<4;++d0)qr[d0]=*reinterpret_cast<const bf16x8*>(&Qw[(long)r32*PA+d0*16+hi*8]);
  float mhat=0.f,l_reg=0.f;f32x16 o[2];o[0]=f32x16{};o[1]=f32x16{};
  const int qrel=wid*QBLK+r32;
  #define CMASK(P0,P1,t) do{int jb_=(t)-(NT-4); if(jb_>=0)cmask(P0,P1,jb_,qrel,hi);}while(0)
  bool resc=false;
  #define START(P0,P1) do{ const float rm=rowmax(P0,P1); resc=false; \
    { const float dl=rm; mhat=fadd_s(mhat,dl); \
      _Pragma("unroll") for(int r=0;r<16;++r){P0[r]=fsub_s(P0[r],dl);P1[r]=fsub_s(P1[r],dl);} \
      SETM(); } \
    _Pragma("unroll") for(int r=0;r<16;++r)P0[r]=__builtin_amdgcn_exp2f(P0[r]); }while(0)
  #define RESC() do{ if(resc){ asm volatile("s_waitcnt lgkmcnt(0)":::"memory"); \
      _Pragma("unroll") for(int d_=0;d_<2;++d_) _Pragma("unroll") for(int r=0;r<16;++r)o[d_][r]*=wsf[crow(r,hi)]; } }while(0)
  f32x16 pA0,pA1,pB0,pB1;
  int sl_prev=0,sl_cur=0,sl_next=SLOTB;
  #define ROT() do{sl_prev=sl_cur;sl_cur=sl_next;sl_next=(sl_next==(NSLOT-1)*SLOTB)?0:sl_next+SLOTB;}while(0)
  DMA_K(2,2*SLOTB);
  WAIT_BAR(3);
  { const unsigned bw0=BW(0,0),bw1=BW(0,1);
    u32x4 k0_=kbw; k0_[0]=bw0; u32x4 k1_=kbw; k1_[0]=bw1; qkt(pA0,pA1,Kbase,qr,r32,hi,k0_,k1_,QR4);asm volatile("s_nop 15\n\ts_nop 7":"+v"(pA0),"+v"(pA1));CMASK(pA0,pA1,0); }
  START(pA0,pA1);
  _Pragma("unroll") for(int r=0;r<16;++r)pA1[r]=__builtin_amdgcn_exp2f(pA1[r]);
  WAIT_BAR(0);
  DMA_K(3,0);DMA_V(1,SLOTB);
  ROT();
  kload8(kf,kp0+sl_cur);
  WAIT_BAR(2);
  s16x4 vlo[8],vhi[8]; u32x4 pw0,pw1,pw2,pw3;
  #define PKW(P,B) cvtpk_s(P[B],P[B+1])
  #define PAF(k) __builtin_bit_cast(bf16x8,pw##k)
  #define VFR(i) (bf16x8){vlo[i][0],vlo[i][1],vlo[i][2],vlo[i][3],vhi[i][0],vhi[i][1],vhi[i][2],vhi[i][3]}
  #define PIN(x) asm volatile("":"+v"(x))
  #define MX3(a,b,c) __builtin_fmaxf(__builtin_fmaxf((a),(b)),(c))
  #define GAPA(MF,A0,A1,A2,A3,W0,W1,PW) do{ MF; sacc+=A0; sacc+=A1; sacc+=A2; sacc+=A3; PIN(sacc); W0; W1; PIN(PW); SBAR(); }while(0)
  #define EX(v) __builtin_amdgcn_exp2f(v)
  #define GAPB(MF,X,B) do{ MF; X[B]=EX(X[B]); X[B+1]=EX(X[B+1]); X[B+2]=EX(X[B+2]); X[B+3]=EX(X[B+3]); PIN(X); SBAR(); }while(0)
  #define VRD(i) do{ vlo[i]=vtr(vp_+(((i)>>2)*4096+((i)&3)*1024)); vhi[i]=vtr(vp_+(((i)>>2)*4096+((i)&3)*1024+512)); }while(0)
  #define KRD(G,j) do{ if(G){ kload2(kf,kp0+sl_next,j); SBAR(); } }while(0)
  #define STEP(C0,C1,P0,P1,t,GK,GV,GL) do{ SBAR(); \
    const lds_cptr vp_=vp0+sl_prev; const unsigned bw0_=BW(t,0),bw1_=BW(t,1); \
    VRD(0); SBAR(); float sacc=(P0[0]+P0[1]); \
    GAPA(C0=__builtin_amdgcn_mfma_f32_32x32x16_bf16(kf[0],qr[0],f32x16{},0,0,0), P0[2],P0[3],P0[4],P0[5],     pw0[0]=PKW(P0,0), pw0[1]=PKW(P0,2), pw0); \
    VRD(4); SBAR(); GAPA(C1=__builtin_amdgcn_mfma_f32_32x32x16_bf16(kf[1],qr[0],f32x16{},0,0,0), P0[6],P0[7],P0[8],P0[9],     pw0[2]=PKW(P0,4), pw0[3]=PKW(P0,6), pw0); \
    VRD(1); SBAR(); GAPA(C0=__builtin_amdgcn_mfma_f32_32x32x16_bf16(kf[2],qr[1],C0,0,0,0),   P0[10],P0[11],P0[12],P0[13], pw1[0]=PKW(P0,8), pw1[1]=PKW(P0,10), pw1); \
    VRD(5); SBAR(); GAPA(C1=__builtin_amdgcn_mfma_f32_32x32x16_bf16(kf[3],qr[1],C1,0,0,0),   P0[14],P0[15],P1[0],P1[1],   pw1[2]=PKW(P0,12),pw1[3]=PKW(P0,14), pw1); \
    VRD(2); SBAR(); GAPA(C0=__builtin_amdgcn_mfma_f32_32x32x16_bf16(kf[4],qr[2],C0,0,0,0),   P1[2],P1[3],P1[4],P1[5],     pw2[0]=PKW(P1,0), pw2[1]=PKW(P1,2), pw2); \
    VRD(6); SBAR(); GAPA(C1=__builtin_amdgcn_mfma_f32_32x32x16_bf16(kf[5],qr[2],C1,0,0,0),   P1[6],P1[7],P1[8],P1[9],     pw2[2]=PKW(P1,4), pw2[3]=PKW(P1,6), pw2); \
    VRD(3); SBAR(); GAPA(C0=__builtin_amdgcn_mfma_f32_32x32x16_bf16(kf[6],qr[3],C0,0,0,0),   P1[10],P1[11],P1[12],P1[13], pw3[0]=PKW(P1,8), pw3[1]=PKW(P1,10), pw3); \
    VRD(7); SBAR(); GAPA(C1=__builtin_amdgcn_mfma_f32_32x32x16_bf16(kf[7],qr[3],C1,0,0,0),   P1[14],P1[15],0.f,0.f,       pw3[2]=PKW(P1,12),pw3[3]=PKW(P1,14), pw3); \
    C0=__builtin_amdgcn_mfma_f32_32x32x16_bf16(__builtin_bit_cast(bf16x8,KBF(bw0_)),QR4,C0,0,0,0); C1=__builtin_amdgcn_mfma_f32_32x32x16_bf16(__builtin_bit_cast(bf16x8,KBF(bw1_)),QR4,C1,0,0,0); SBAR(); \
    l_reg+=sacc; \
    if(GK){DMA_K((t)+3,sl_cur);} if(GV){DMA_V((t)+1,sl_next);} \
    CMASK(C0,C1,t); \
    { float a=MX3(C0[0],C0[1],C1[0]),b=MX3(C0[2],C0[3],C1[1]); a=MX3(a,C1[2],C1[3]); \
      _Pragma("unroll") for(int r=4;r<16;r+=4){a=MX3(a,C0[r],C0[r+1]);b=MX3(b,C0[r+2],C0[r+3]);a=MX3(a,C1[r],C1[r+1]);b=MX3(b,C1[r+2],C1[r+3]);} \
      float rm=__builtin_fmaxf(a,b); { auto rr=__builtin_amdgcn_permlane32_swap(__float_as_uint(rm),__float_as_uint(rm),false,false); rm=__builtin_fmaxf(__uint_as_float(rr[0]),__uint_as_float(rr[1])); } \
      resc=false; \
      if(__builtin_expect(__any(rm>(float)THRL),0)){ const float dl=__builtin_fmaxf(rm,0.f); mhat+=dl; \
        _Pragma("unroll") for(int r=0;r<16;++r){C0[r]-=dl;C1[r]-=dl;} \
        SETM(); \
        const float f=__builtin_amdgcn_exp2f(-dl); l_reg*=f; if(hi==0)wsf[r32]=f; resc=true; } } \
    SBAR(); \
    GAPB(o[0]=__builtin_amdgcn_mfma_f32_32x32x16_bf16(PAF(0),VFR(0),o[0],0,0,0), C0,0); \
    GAPB(o[1]=__builtin_amdgcn_mfma_f32_32x32x16_bf16(PAF(0),VFR(4),o[1],0,0,0), C0,4); \
    KRD(GL,0); GAPB(o[0]=__builtin_amdgcn_mfma_f32_32x32x16_bf16(PAF(1),VFR(1),o[0],0,0,0), C0,8); \
    KRD(GL,1); GAPB(o[1]=__builtin_amdgcn_mfma_f32_32x32x16_bf16(PAF(1),VFR(5),o[1],0,0,0), C0,12); \
    KRD(GL,2); GAPB(o[0]=__builtin_amdgcn_mfma_f32_32x32x16_bf16(PAF(2),VFR(2),o[0],0,0,0), C1,0); \
    KRD(GL,3); GAPB(o[1]=__builtin_amdgcn_mfma_f32_32x32x16_bf16(PAF(2),VFR(6),o[1],0,0,0), C1,4); \
    GAPB(o[0]=__builtin_amdgcn_mfma_f32_32x32x16_bf16(PAF(3),VFR(3),o[0],0,0,0), C1,8); \
    GAPB(o[1]=__builtin_amdgcn_mfma_f32_32x32x16_bf16(PAF(3),VFR(7),o[1],0,0,0), C1,12); \
    }while(0)
  int t=1;
  #undef CMASK
  #define CMASK(P0,P1,t) do{}while(0)
  for(;t+5<NT;t+=2){
    STEP(pB0,pB1,pA0,pA1,t,true,true,true);     WAIT_BAR(2); RESC(); ROT();
    STEP(pA0,pA1,pB0,pB1,t+1,true,true,true);   WAIT_BAR(2); RESC(); ROT();
  }
  #undef CMASK
  #define CMASK(P0,P1,t) do{int jb_=(t)-(NT-4); if(jb_>=0)cmask(P0,P1,jb_,qrel,hi);}while(0)
  #define ENDW(tt) do{ if((tt)+3<NT){WAIT_BAR(2);} else if((tt)+2<NT){WAIT_BAR(1);} else {WAIT_BAR(0);} }while(0)
  for(;t+1<NT;t+=2){
    STEP(pB0,pB1,pA0,pA1,t,(t+3<NT),(t+1<NT),(t+1<NT));       ENDW(t);   RESC(); ROT();
    STEP(pA0,pA1,pB0,pB1,t+1,(t+4<NT),(t+2<NT),(t+2<NT));     ENDW(t+1); RESC(); ROT();
  }
  STEP(pB0,pB1,pA0,pA1,NT-1,false,false,false); RESC();
  { float sacc=pB0[0]+pB0[1]; _Pragma("unroll") for(int r=2;r<16;++r)sacc+=pB0[r]; _Pragma("unroll") for(int r=0;r<16;++r)sacc+=pB1[r]; l_reg+=sacc;
    pw0=(u32x4){PKW(pB0,0),PKW(pB0,2),PKW(pB0,4),PKW(pB0,6)};pw1=(u32x4){PKW(pB0,8),PKW(pB0,10),PKW(pB0,12),PKW(pB0,14)};pw2=(u32x4){PKW(pB1,0),PKW(pB1,2),PKW(pB1,4),PKW(pB1,6)};pw3=(u32x4){PKW(pB1,8),PKW(pB1,10),PKW(pB1,12),PKW(pB1,14)};
    SBAR(); pv(o,vb0+sl_cur,PAF(0),PAF(1),PAF(2),PAF(3)); }
  #undef PKW
  #undef PAF
  #undef VFR
  #undef PIN
  #undef MX3
  #undef GAPA
  #undef GAPB
  #undef EX
  #undef VRD
  #undef KRD
  #undef STEP
  #undef ENDW
  {auto rr=__builtin_amdgcn_permlane32_swap(__float_as_uint(l_reg),__float_as_uint(l_reg),false,false);l_reg=__uint_as_float(rr[0])+__uint_as_float(rr[1]);}
  if(hi==0)wsf[32+r32]=l_reg;asm volatile("s_waitcnt lgkmcnt(0)":::"memory");
  float rli[16];
  #pragma unroll
  for(int r=0;r<16;++r)rli[r]=__builtin_amdgcn_rcpf(wsf[32+crow(r,hi)]);
  bf16_t*Ow=PJ+(rowbase+q0+wid*QBLK)*PA+C_FQ+h*D;
  { bf16_t*stg=(bf16_t*)(shm+LDS_OST)+wid*2048;
    #pragma unroll
    for(int r=0;r<16;++r){const int orow=crow(r,hi);
      #pragma unroll
      for(int d0=0;d0<2;++d0)stg[orow*64+d0*32+r32]=(bf16_t)f2bf(o[d0][r]*rli[r]);}
    asm volatile("s_waitcnt lgkmcnt(0)":::"memory");
    #pragma unroll
    for(int i=0;i<4;++i){const int row=i*8+(lane>>3),ch=lane&7; const u32x4 v=*(const u32x4*)(stg+row*64+ch*8); ATTN_STORE16(Ow+(long)row*PA+ch*8,v);} }
  asm volatile("s_waitcnt lgkmcnt(0)\n\ts_barrier":::"memory");
  #undef DMA_K
  #undef DMA_V
  #undef CMASK
  #undef START
  #undef RESC
  #undef ROT
  #undef BW
  #undef QR4
  #undef SETM
}
#undef SBAR
#undef WAIT_BAR
#undef KBF
}


namespace memx {
using fox::f32x16; using fox::s16x4; using fox::crow; using fox::glds16; using fox::cvtpk_s; using fox::vtr; using fox::lds_cptr; using fox::max3f; using fox::max2f;
__device__ __forceinline__ void load_kv(int b,int hd,bool loadv,const bf16_t*KV,char*shm,int wid,int lane){
  const unsigned lds0=(unsigned)(uintptr_t)shm;
  const bf16_t*Kb=KV+(size_t)b*MEMLEN*1024+hd*128; const bf16_t*Vb=Kb+512;
  #pragma unroll
  for(int blk=0;blk<4;++blk){
    #pragma unroll
    for(int cc=0;cc<2;++cc){ const int c=wid+8*cc;
      glds16(Kb+(size_t)(blk*64+lane)*1024+c*8,(unsigned)__builtin_amdgcn_readfirstlane(lds0+blk*16384+c*1024)); }
    if(loadv)
    #pragma unroll
    for(int dh=0;dh<2;++dh){
      glds16(Vb+(size_t)(blk*64+16*(wid&3)+(lane>>2))*1024+dh*64+(wid>>2)*32+(lane&3)*8,(unsigned)__builtin_amdgcn_readfirstlane(lds0+65536+(blk*2+dh)*8192+wid*1024)); }
  }
}
__device__ __forceinline__ void unit(int b,int hd,int qb,bool loadv,bf16_t*PJ,const bf16_t*KV,char*shm){
  int tid=threadIdx.x; asm volatile("":"+v"(tid));
  const int lane=tid&63,r32=lane&31,hi=lane>>5; const int wid=__builtin_amdgcn_readfirstlane(tid>>6);
  load_kv(b,hd,loadv,KV,shm,wid,lane);
  const size_t row0=(size_t)b*SEQ+qb*256+wid*32;
  const bf16_t*Qw=PJ+row0*PA+C_MQ+hd*128;
  bf16x8 qr[8];
  #pragma unroll
  for(int d0=0;d0<8;++d0)qr[d0]=*reinterpret_cast<const bf16x8*>(&Qw[(size_t)r32*PA+d0*16+hi*8]);
  asm volatile("s_waitcnt vmcnt(0)":::"memory"); __syncthreads();
  f32x16 p[8];
  const lds_cptr shm3=(lds_cptr)shm;
  #pragma unroll
  for(int blk=0;blk<4;++blk){
    const lds_cptr kb=shm3+blk*16384+hi*1024+r32*16;
    #pragma unroll
    for(int d0=0;d0<8;++d0){
      const bf16x8 k0=*(const __attribute__((address_space(3))) bf16x8*)(kb+d0*2048);
      const bf16x8 k1=*(const __attribute__((address_space(3))) bf16x8*)(kb+d0*2048+512);
      if(d0==0){p[2*blk]=__builtin_amdgcn_mfma_f32_32x32x16_bf16(k0,qr[0],f32x16{},0,0,0);p[2*blk+1]=__builtin_amdgcn_mfma_f32_32x32x16_bf16(k1,qr[0],f32x16{},0,0,0);}
      else{p[2*blk]=__builtin_amdgcn_mfma_f32_32x32x16_bf16(k0,qr[d0],p[2*blk],0,0,0);p[2*blk+1]=__builtin_amdgcn_mfma_f32_32x32x16_bf16(k1,qr[d0],p[2*blk+1],0,0,0);}
    }
  }
  float m=p[0][0];
  #pragma unroll
  for(int i=0;i<8;++i){
    #pragma unroll
    for(int r=0;r<16;++r)m=__builtin_fmaxf(m,p[i][r]); }
  { auto rr=__builtin_amdgcn_permlane32_swap(__float_as_uint(m),__float_as_uint(m),false,false); m=__builtin_fmaxf(__uint_as_float(rr[0]),__uint_as_float(rr[1])); }
  float l=0.f;
  #pragma unroll
  for(int i=0;i<8;++i){
    #pragma unroll
    for(int r=0;r<16;++r){p[i][r]=__builtin_amdgcn_exp2f(p[i][r]-m); l+=p[i][r];} }
  { auto rr=__builtin_amdgcn_permlane32_swap(__float_as_uint(l),__float_as_uint(l),false,false); l=__uint_as_float(rr[0])+__uint_as_float(rr[1]); }
  f32x16 o[4]; o[0]=f32x16{};o[1]=f32x16{};o[2]=f32x16{};o[3]=f32x16{};
  const lds_cptr vp0=shm3+65536+((lane>>4)&1)*32+(lane&3)*8+(4*hi+((lane&15)>>2))*64;
  #pragma unroll
  for(int blk=0;blk<4;++blk){
    u32x4 pw[4];
    #pragma unroll
    for(int k=0;k<4;++k){ const f32x16&P=p[2*blk+(k>>1)]; const int B=(k&1)*8; pw[k]=(u32x4){cvtpk_s(P[B],P[B+1]),cvtpk_s(P[B+2],P[B+3]),cvtpk_s(P[B+4],P[B+5]),cvtpk_s(P[B+6],P[B+7])}; }
    #pragma unroll
    for(int dh=0;dh<2;++dh){
      const lds_cptr vp=vp0+(blk*2+dh)*8192;
      #pragma unroll
      for(int dt=0;dt<2;++dt){
        #pragma unroll
        for(int k=0;k<4;++k){
          const s16x4 lo=vtr(vp+dt*4096+k*1024), hh=vtr(vp+dt*4096+k*1024+512);
          const bf16x8 vf=(bf16x8){lo[0],lo[1],lo[2],lo[3],hh[0],hh[1],hh[2],hh[3]};
          o[dh*2+dt]=__builtin_amdgcn_mfma_f32_32x32x16_bf16(__builtin_bit_cast(bf16x8,pw[k]),vf,o[dh*2+dt],0,0,0);
        }
      }
    }
  }
  const float rl0=__builtin_amdgcn_rcpf(l);
  __syncthreads();
  bf16_t*stg=(bf16_t*)(shm)+wid*4096;
  { float*tmp=(float*)stg; if(hi==0)tmp[r32]=rl0; asm volatile("s_waitcnt lgkmcnt(0)":::"memory");
    float rli[16];
    #pragma unroll
    for(int r=0;r<16;++r)rli[r]=tmp[crow(r,hi)];
    asm volatile("s_waitcnt lgkmcnt(0)":::"memory");
    #pragma unroll
    for(int r=0;r<16;++r){ const int orow=crow(r,hi);
      #pragma unroll
      for(int t4=0;t4<4;++t4)stg[orow*128+t4*32+r32]=(bf16_t)f2bf(o[t4][r]*rli[r]); }
    asm volatile("s_waitcnt lgkmcnt(0)":::"memory");
  }
  bf16_t*Ow=PJ+row0*PA+C_MQ+hd*128;
  #pragma unroll
  for(int i=0;i<8;++i){ const int row=i*4+(lane>>4),ch=lane&15; const u32x4 v=*(const u32x4*)(stg+row*128+ch*8); *(u32x4*)(Ow+(size_t)row*PA+ch*8)=v; }
  asm volatile("s_waitcnt lgkmcnt(0)":::"memory"); __syncthreads();
}
}

__device__ __forceinline__ void unpack8(const u32x4 w, float (&f)[8]) { f[0] = bflo(w.x); f[1] = bfhi(w.x); f[2] = bflo(w.y); f[3] = bfhi(w.y); f[4] = bflo(w.z); f[5] = bfhi(w.z); f[6] = bflo(w.w); f[7] = bfhi(w.w); }

namespace rwkv {
constexpr size_t WLORA_AUP = 65536, WLORA_GUP = 131072;
constexpr int SLOT = 8192;
constexpr int X_DIAG = EXTRA_OFF, X_SCAN = X_DIAG + 4096, X_GAMMA = X_SCAN + 2048, X_BONUS = X_GAMMA + 256, X_PREV = X_BONUS + 256;
static_assert(X_PREV + 2 * 896 <= LDS_BYTES, "rwkv extra LDS");
typedef LAS unsigned char* lp;
__device__ __forceinline__ unsigned cvtpk(float lo, float hi) { return pg8::cvt_pk_bf16(lo, hi); }
__device__ __forceinline__ bf16_t cvt1(float v) { return (bf16_t)(pg8::cvt_pk_bf16(v, v) & 0xffffu); }
__device__ __forceinline__ int sw64(int row, int k) { return row * 128 + ((k * 2) ^ ((row & 7) << 4)); }
__device__ __forceinline__ int sw128(int row, int k) { return row * 256 + ((k * 2) ^ ((row & 7) << 4)); }
__device__ __forceinline__ bf16x8 ldfrag128(lp base, int rowblk, int ks, int fr, int fg) { return *(const LAS bf16x8*)(base + (16 * rowblk + fr) * 256 + ((64 * ks + 16 * fg) ^ ((fr & 7) << 4))); }
__device__ __forceinline__ float bfu(unsigned short u) { return __builtin_bit_cast(float, (unsigned)u << 16); }
#define MFMA16(a, b, c) __builtin_amdgcn_mfma_f32_16x16x32_bf16(a, b, c, 0, 0, 0)
struct Offs { int a[2]; int b[2][2]; int nm[2]; int mn[2][4]; int f32o[2]; };
__device__ __forceinline__ void mm64(f32x4 (&acc)[2], lp A, lp B, const Offs& O) {
#pragma unroll
    for (int ks = 0; ks < 2; ++ks) { const bf16x8 a = *(const LAS bf16x8*)(A + O.a[ks]), b0 = *(const LAS bf16x8*)(B + O.b[0][ks]), b1 = *(const LAS bf16x8*)(B + O.b[1][ks]);
        acc[0] = MFMA16(a, b0, acc[0]); acc[1] = MFMA16(a, b1, acc[1]); }
}
__device__ __forceinline__ void st_nm(lp base, const f32x4 (&acc)[2], const Offs& O) {
#pragma unroll
    for (int tt = 0; tt < 2; ++tt) *(LAS u32x2*)(base + O.nm[tt]) = (u32x2){cvtpk(acc[tt][0], acc[tt][1]), cvtpk(acc[tt][2], acc[tt][3])};
}
__device__ __forceinline__ void st_mn(lp base, const f32x4 (&acc)[2], const Offs& O) {
#pragma unroll
    for (int tt = 0; tt < 2; ++tt)
#pragma unroll
        for (int e = 0; e < 4; ++e) *(LAS bf16_t*)(base + O.mn[tt][e]) = cvt1(acc[tt][e]);
}
struct Raw { u32x4 r, k, v, wd, ad, g0, g1; };
__device__ __forceinline__ void load_raw(Raw& x, const bf16_t* rp, int hc, int c0, int cg) {
    x.r = *(const u32x4*)(rp + C_RR + hc); x.k = *(const u32x4*)(rp + C_RK + hc); x.v = *(const u32x4*)(rp + C_RV + hc);
    x.wd = *(const u32x4*)(rp + C_WD + c0); x.ad = *(const u32x4*)(rp + C_AD + c0); x.g0 = *(const u32x4*)(rp + C_GD + 16 * cg); x.g1 = *(const u32x4*)(rp + C_GD + 16 * cg + 8);
}
__device__ __forceinline__ void shift8(float (&o)[8], const u32x4 cur, const u32x4 prv, const float* mu) {
    float c[8], p[8]; unpack8(cur, c); unpack8(prv, p); const f32x4 m0 = *(const f32x4*)mu, m1 = *(const f32x4*)(mu + 4);
#pragma unroll
    for (int e = 0; e < 4; ++e) { o[e] = c[e] + (p[e] - c[e]) * m0[e]; o[4 + e] = c[4 + e] + (p[4 + e] - c[4 + e]) * m1[e]; }
}
__device__ __forceinline__ u32x4 pack8f(const float (&f)[8]) { return (u32x4){cvtpk(f[0], f[1]), cvtpk(f[2], f[3]), cvtpk(f[4], f[5]), cvtpk(f[6], f[7])}; }
__device__ __forceinline__ float fsig(float x) { return __builtin_amdgcn_rcpf(1.0f + __builtin_amdgcn_exp2f(-LOG2E * x)); }
#define DPPSUM(v) do { v += __builtin_bit_cast(float, __builtin_amdgcn_update_dpp(0, __builtin_bit_cast(int, v), 0xB1, 0xf, 0xf, true)); \
    v += __builtin_bit_cast(float, __builtin_amdgcn_update_dpp(0, __builtin_bit_cast(int, v), 0x4E, 0xf, 0xf, true)); \
    v += __builtin_bit_cast(float, __builtin_amdgcn_update_dpp(0, __builtin_bit_cast(int, v), 0x141, 0xf, 0xf, true)); \
    v += __builtin_bit_cast(float, __builtin_amdgcn_update_dpp(0, __builtin_bit_cast(int, v), 0x140, 0xf, 0xf, true)); \
    v += __builtin_bit_cast(float, __builtin_amdgcn_update_dpp(0, __builtin_bit_cast(int, v), 0x142, 0xa, 0xf, true)); \
    v += __builtin_bit_cast(float, __builtin_amdgcn_update_dpp(0, __builtin_bit_cast(int, v), 0x143, 0xc, 0xf, true)); } while (0)

__device__ __forceinline__ void unit(Frame& F, int b, int h) {
    int tid0 = threadIdx.x; asm volatile("" : "+v"(tid0));
#define IDX() int tid = tid0; asm volatile("" : "+v"(tid)); const int lane = tid & 63, wid = __builtin_amdgcn_readfirstlane(tid >> 6); \
    const int t = tid >> 3, cg = tid & 7, c0 = 8 * cg, hc = h * 64 + c0; (void)t; (void)cg; (void)c0; (void)hc; (void)lane; (void)wid
    const lp L = F.lds;
#define SL(n) (L + (n) * SLOT)
    bf16_t* PJ = (bf16_t*)(F.ws + WS_PROJA);
    const bf16_t* WUPT = (const bf16_t*)(F.ws + WS_WLORA); const bf16_t* AUPT = (const bf16_t*)(F.ws + WS_WLORA + WLORA_AUP); const bf16_t* GUPT = (const bf16_t*)(F.ws + WS_WLORA + WLORA_GUP);
    const float* mu = INP(I_MU); const float* kkp_ = INP(I_KK); const float* w0p_ = INP(I_W0); const float* a0p_ = INP(I_A0); const float* kap_ = INP(I_KA); const float* rkp_ = INP(I_RK); const float* gngp_ = INP(I_GNG); const float* gnbp_ = INP(I_GNB);
    LAS float* DIAG = (LAS float*)(L + X_DIAG); LAS float* SCANP = (LAS float*)(L + X_SCAN); LAS float* GAMMA = (LAS float*)(L + X_GAMMA); LAS float* BONUS = (LAS float*)(L + X_BONUS);
    LAS u32x4* PREV = (LAS u32x4*)(L + X_PREV);
    Offs O; int ti, tj0, fr, fg;
    { const int lane = tid0 & 63, wid = __builtin_amdgcn_readfirstlane(tid0 >> 6); fr = lane & 15; fg = lane >> 4; ti = wid >> 1; tj0 = 2 * (wid & 1);
      const int xr = (fr & 7) << 4;
#pragma unroll
      for (int ks = 0; ks < 2; ++ks) { O.a[ks] = (16 * ti + fr) * 128 + ((64 * ks + 16 * fg) ^ xr);
#pragma unroll
          for (int tt = 0; tt < 2; ++tt) O.b[tt][ks] = (16 * (tj0 + tt) + fr) * 128 + ((64 * ks + 16 * fg) ^ xr); }
#pragma unroll
      for (int tt = 0; tt < 2; ++tt) { const int n = 16 * (tj0 + tt) + fr, m0 = 16 * ti + 4 * fg; O.nm[tt] = n * 128 + ((m0 * 2) ^ ((n & 7) << 4)); O.f32o[tt] = (m0 * 64 + n) * 4;
#pragma unroll
          for (int e = 0; e < 4; ++e) O.mn[tt][e] = sw64(m0 + e, n); } }
#define OPQ() asm volatile("" : "+v"(O.a[0]), "+v"(O.a[1]), "+v"(O.b[0][0]), "+v"(O.b[0][1]), "+v"(O.b[1][0]), "+v"(O.b[1][1]), "+v"(O.nm[0]), "+v"(O.nm[1]), \
        "+v"(O.mn[0][0]), "+v"(O.mn[0][1]), "+v"(O.mn[0][2]), "+v"(O.mn[0][3]), "+v"(O.mn[1][0]), "+v"(O.mn[1][1]), "+v"(O.mn[1][2]), "+v"(O.mn[1][3]), "+v"(O.f32o[0]), "+v"(O.f32o[1]))
    f32x4 Hreg[2]; Hreg[0] = (f32x4){0.f, 0.f, 0.f, 0.f}; Hreg[1] = Hreg[0];
    __syncthreads();
    Raw cur, prv;
    { IDX(); *(LAS u32x4*)(SL(0) + tid * 16) = (u32x4){0u, 0u, 0u, 0u};
      const bf16_t* rp = PJ + ((size_t)b * SEQ + t) * PA; load_raw(cur, rp, hc, c0, cg); if (t > 0) load_raw(prv, rp - PA, hc, c0, cg); }
#pragma unroll 1
    for (int bt = 0; bt < SEQ / 64; ++bt) {
        { IDX();
            if (t == 0) { const u32x4 z = (u32x4){0u, 0u, 0u, 0u};
                if (bt == 0) { prv.r = z; prv.k = z; prv.v = z; prv.wd = z; prv.ad = z; prv.g0 = z; prv.g1 = z; }
                else { LAS u32x4* pp = PREV + (bt & 1) * 56 + cg; prv.r = pp[0]; prv.k = pp[8]; prv.v = pp[16]; prv.wd = pp[24]; prv.ad = pp[32]; prv.g0 = pp[40]; prv.g1 = pp[48]; } }
            if (t == 63) { LAS u32x4* pp = PREV + ((bt + 1) & 1) * 56 + cg; pp[0] = cur.r; pp[8] = cur.k; pp[16] = cur.v; pp[24] = cur.wd; pp[32] = cur.ad; pp[40] = cur.g0; pp[48] = cur.g1; }
            const int o64 = sw64(t, c0), o128 = sw128(t, 16 * cg);
            float x[8];
            shift8(x, cur.r, prv.r, mu + hc); *(LAS u32x4*)(SL(2) + o64) = pack8f(x);
            shift8(x, cur.v, prv.v, mu + 1024 + hc); *(LAS u32x4*)(SL(4) + o64) = pack8f(x);
            shift8(x, cur.k, prv.k, mu + 512 + hc); *(LAS u32x4*)(SL(3) + o64) = pack8f(x);
            { const f32x4 k0 = *(const f32x4*)(kkp_ + hc), k1 = *(const f32x4*)(kkp_ + hc + 4); float ss = 0.f;
#pragma unroll
              for (int e = 0; e < 4; ++e) { x[e] *= k0[e]; x[4 + e] *= k1[e]; ss += x[e] * x[e] + x[4 + e] * x[4 + e]; }
              ss += __shfl_xor(ss, 1); ss += __shfl_xor(ss, 2); ss += __shfl_xor(ss, 4);
              const float rn = -__builtin_amdgcn_rsqf(fmaxf(ss, 1e-24f));
#pragma unroll
              for (int e = 0; e < 8; ++e) x[e] *= rn;
              *(LAS u32x4*)(SL(1) + o64) = pack8f(x); }
            shift8(x, cur.wd, prv.wd, mu + 1536 + c0);
#pragma unroll
            for (int e = 0; e < 8; ++e) x[e] = 1.0f - 2.0f * __builtin_amdgcn_rcpf(1.0f + __builtin_amdgcn_exp2f((2.0f * LOG2E) * x[e]));
            *(LAS u32x4*)(SL(14) + o64) = pack8f(x);
            shift8(x, cur.ad, prv.ad, mu + 1600 + c0); *(LAS u32x4*)(SL(15) + o64) = pack8f(x);
            shift8(x, cur.g0, prv.g0, mu + 1664 + 16 * cg);
#pragma unroll
            for (int e = 0; e < 8; ++e) x[e] = fsig(x[e]);
            *(LAS u32x4*)(SL(9) + o128) = pack8f(x);
            shift8(x, cur.g1, prv.g1, mu + 1664 + 16 * cg + 8);
#pragma unroll
            for (int e = 0; e < 8; ++e) x[e] = fsig(x[e]);
            *(LAS u32x4*)(SL(9) + (o128 ^ 16)) = pack8f(x);
        }
        __syncthreads();
        { OPQ();
            f32x4 zw[2], za[2], gg[2];
#pragma unroll
            for (int tt = 0; tt < 2; ++tt) { zw[tt] = (f32x4){0.f, 0.f, 0.f, 0.f}; za[tt] = zw[tt]; gg[tt] = zw[tt]; }
            int n0i = h * 64 + 16 * tj0 + fr; asm volatile("" : "+v"(n0i));
            const size_t n0 = (size_t)n0i, n1 = n0 + 16;
#pragma unroll
            for (int ks = 0; ks < 2; ++ks) {
                const bf16x8 aw = *(const LAS bf16x8*)(SL(14) + O.a[ks]), aa = *(const LAS bf16x8*)(SL(15) + O.a[ks]);
                const bf16x8 w0 = *(const bf16x8*)(WUPT + n0 * 64 + 32 * ks + 8 * fg), w1 = *(const bf16x8*)(WUPT + n1 * 64 + 32 * ks + 8 * fg);
                const bf16x8 a0 = *(const bf16x8*)(AUPT + n0 * 64 + 32 * ks + 8 * fg), a1 = *(const bf16x8*)(AUPT + n1 * 64 + 32 * ks + 8 * fg);
                zw[0] = MFMA16(aw, w0, zw[0]); zw[1] = MFMA16(aw, w1, zw[1]); za[0] = MFMA16(aa, a0, za[0]); za[1] = MFMA16(aa, a1, za[1]); }
#pragma unroll
            for (int ks = 0; ks < 4; ++ks) {
                const bf16x8 ag = ldfrag128(SL(9), ti, ks, fr, fg);
                const bf16x8 g0 = *(const bf16x8*)(GUPT + n0 * 128 + 32 * ks + 8 * fg), g1 = *(const bf16x8*)(GUPT + n1 * 128 + 32 * ks + 8 * fg);
                gg[0] = MFMA16(ag, g0, gg[0]); gg[1] = MFMA16(ag, g1, gg[1]); }
#pragma unroll
            for (int tt = 0; tt < 2; ++tt) { const int c = 16 * (tj0 + tt) + fr; const float w0c = w0p_[h * 64 + c], a0c = a0p_[h * 64 + c];
#pragma unroll
                for (int e = 0; e < 4; ++e) {
                    *(LAS float*)(SL(6) + O.f32o[tt] + e * 256) = zw[tt][e] + w0c;
                    *(LAS bf16_t*)(SL(8) + O.mn[tt][e]) = cvt1(fsig(za[tt][e] + a0c));
                    *(LAS bf16_t*)(SL(5) + O.mn[tt][e]) = cvt1(gg[tt][e]); } }
        }
        __syncthreads();
        { IDX();
            const int c = lane, tq = wid;
            float lw[8], lgi[8];
            float run = 0.f;
#pragma unroll
            for (int e = 0; e < 8; ++e) { const float z = *(const LAS float*)(SL(6) + ((8 * tq + e) * 64 + c) * 4); lw[e] = (-0.6065306597126334f * LOG2E) * fsig(z); run += lw[e]; lgi[e] = run; }
            SCANP[tq * 64 + c] = run;
            __syncthreads();
            float pre = 0.f, tot = 0.f;
#pragma unroll
            for (int q = 0; q < 8; ++q) { const float v = SCANP[q * 64 + c]; tot += v; pre += (q < tq) ? v : 0.f; }
            if (tq == 0) GAMMA[c] = __builtin_amdgcn_exp2f(tot);
            const float kac = kap_[h * 64 + c], rkc = rkp_[h * 64 + c];
            float bh[8], kh[8], vv[8], bsum[8];
            const int rb = tq * 1024;
#pragma unroll
            for (int e = 0; e < 8; ++e) { const int off = rb + e * 128 + ((2 * c) ^ (e << 4));
                const float lg = pre + lgi[e], lgx = lg - lw[e];
                const float av = bfu(*(const LAS bf16_t*)(SL(1) + off)), rs = bfu(*(const LAS bf16_t*)(SL(2) + off)), ks = bfu(*(const LAS bf16_t*)(SL(3) + off)), ar = bfu(*(const LAS bf16_t*)(SL(8) + off));
                vv[e] = bfu(*(const LAS bf16_t*)(SL(4) + off));
                const float kp = ks * (1.0f + (ar - 1.0f) * kac), bv = -av * ar;
                const float ein = __builtin_amdgcn_exp2f(-lg), eend = __builtin_amdgcn_exp2f(tot - lg);
                *(LAS bf16_t*)(SL(1) + off) = cvt1(av * __builtin_amdgcn_exp2f(lgx));
                *(LAS bf16_t*)(SL(2) + off) = cvt1(rs * __builtin_amdgcn_exp2f(lg));
                *(LAS bf16_t*)(SL(9) + off) = cvt1(bv * ein);
                *(LAS bf16_t*)(SL(10) + off) = cvt1(kp * ein);
                bh[e] = bv * eend; kh[e] = kp * eend; bsum[e] = rs * kp * rkc; }
#pragma unroll
            for (int e = 0; e < 8; ++e) DPPSUM(bsum[e]);
            if (lane == 63) { *(LAS f32x4*)(BONUS + 8 * tq) = (f32x4){bsum[0], bsum[1], bsum[2], bsum[3]}; *(LAS f32x4*)(BONUS + 8 * tq + 4) = (f32x4){bsum[4], bsum[5], bsum[6], bsum[7]}; }
            const int ot = c * 128 + ((16 * tq) ^ ((c & 7) << 4));
            *(LAS u32x4*)(SL(11) + ot) = pack8f(bh);
            *(LAS u32x4*)(SL(12) + ot) = pack8f(kh);
            *(LAS u32x4*)(SL(13) + ot) = pack8f(vv);
        }
        __syncthreads();
        { OPQ();
            f32x4 acc[2];
            const f32x4 z4 = (f32x4){0.f, 0.f, 0.f, 0.f};
            const int m0 = 16 * ti + 4 * fg;
            acc[0] = z4; acc[1] = z4; mm64(acc, SL(1), SL(9), O);
#pragma unroll
            for (int tt = 0; tt < 2; ++tt) { const int tj = tj0 + tt;
                if (tj == ti) {
#pragma unroll
                    for (int e = 0; e < 4; ++e) DIAG[ti * 256 + (4 * fg + e) * 16 + fr] = (fr < 4 * fg + e) ? acc[tt][e] : 0.f; }
                if (tj >= ti) acc[tt] = z4; }
            st_nm(SL(8), acc, O); OPQ();
            acc[0] = z4; acc[1] = z4; mm64(acc, SL(10), SL(1), O);
#pragma unroll
            for (int tt = 0; tt < 2; ++tt) { const int n = 16 * (tj0 + tt) + fr;
#pragma unroll
                for (int e = 0; e < 4; ++e) if (!(m0 + e < n)) acc[tt][e] = 0.f; }
            st_nm(SL(3), acc, O); OPQ();
            acc[0] = z4; acc[1] = z4; mm64(acc, SL(9), SL(2), O);
#pragma unroll
            for (int tt = 0; tt < 2; ++tt) { const int n = 16 * (tj0 + tt) + fr;
#pragma unroll
                for (int e = 0; e < 4; ++e) if (!(m0 + e <= n)) acc[tt][e] = 0.f; }
            st_nm(SL(6), acc, O); OPQ();
            acc[0] = z4; acc[1] = z4; mm64(acc, SL(10), SL(2), O);
#pragma unroll
            for (int tt = 0; tt < 2; ++tt) { const int n = 16 * (tj0 + tt) + fr;
#pragma unroll
                for (int e = 0; e < 4; ++e) if (!(m0 + e <= n)) acc[tt][e] = 0.f; }
            st_nm(SL(7), acc, O);
        }
        __syncthreads();
        { IDX();
        if (wid == 0) {
            const int blk = lane >> 4, c = lane & 15; float X[16];
#pragma unroll
            for (int tr = 0; tr < 16; ++tr) { float a = (tr == c) ? 1.f : 0.f;
#pragma unroll
                for (int q4 = 0; q4 < (tr + 3) / 4; ++q4) { const f32x4 lr = *(const LAS f32x4*)(DIAG + blk * 256 + tr * 16 + 4 * q4);
#pragma unroll
                    for (int e = 0; e < 4; ++e) if (4 * q4 + e < tr) a += lr[e] * X[4 * q4 + e]; }
                X[tr] = a; if ((tr & 3) == 3) __builtin_amdgcn_sched_barrier(0); }
#pragma unroll
            for (int tr = 0; tr < 16; ++tr) *(LAS bf16_t*)(SL(9) + sw64(16 * blk + tr, 16 * blk + c)) = cvt1(X[tr]);
            { const int rowc = 16 * blk + c; const float x0[8] = {X[0], X[1], X[2], X[3], X[4], X[5], X[6], X[7]}, x1[8] = {X[8], X[9], X[10], X[11], X[12], X[13], X[14], X[15]};
              *(LAS u32x4*)(SL(10) + sw64(rowc, 16 * blk)) = pack8f(x0); *(LAS u32x4*)(SL(10) + sw64(rowc, 16 * blk + 8)) = pack8f(x1); }
        } else {
            const int u = tid - 64;
#pragma unroll
            for (int it = 0; it < 2; ++it) { const int item = u + 448 * it;
                if (item < 768) { const int arr = item / 384, rem = item % 384, rowz = rem / 6, ci = rem % 6, db = 2 * (rowz >> 4), ch = ci + (ci >= db ? 2 : 0);
                    *(LAS u32x4*)(SL(9 + arr) + sw64(rowz, 8 * ch)) = (u32x4){0u, 0u, 0u, 0u}; } }
        } }
        __syncthreads();
        f32x4 g2acc[2];
        { OPQ();
            f32x4 acc[2]; acc[0] = (f32x4){0.f, 0.f, 0.f, 0.f}; acc[1] = acc[0];
            mm64(acc, SL(9), SL(8), O);
            st_nm(SL(15), acc, O); st_mn(SL(14), acc, O);
        }
        __syncthreads();
        { OPQ();
            g2acc[0] = (f32x4){0.f, 0.f, 0.f, 0.f}; g2acc[1] = g2acc[0];
            mm64(g2acc, SL(14), SL(15), O);
#pragma unroll
            for (int tt = 0; tt < 2; ++tt)
#pragma unroll
                for (int e = 0; e < 4; ++e) if (16 * ti + 4 * fg + e == 16 * (tj0 + tt) + fr) g2acc[tt][e] += 1.0f;
            st_nm(SL(9), g2acc, O);
        }
        __syncthreads();
        { OPQ();
            f32x4 acc[2]; acc[0] = g2acc[0]; acc[1] = g2acc[1];
            mm64(acc, SL(14), SL(9), O);
            st_mn(SL(15), acc, O);
        }
        __syncthreads();
        { OPQ();
            f32x4 acc[2]; acc[0] = (f32x4){0.f, 0.f, 0.f, 0.f}; acc[1] = acc[0];
            mm64(acc, SL(15), SL(10), O);
            st_mn(SL(8), acc, O);
        }
        __syncthreads();
        if (bt + 1 < SEQ / 64) { IDX(); const bf16_t* rp = PJ + ((size_t)b * SEQ + bt * 64 + t + 64) * PA; load_raw(cur, rp, hc, c0, cg); if (t > 0) load_raw(prv, rp - PA, hc, c0, cg); }
        { OPQ();
            f32x4 acc[2]; acc[0] = (f32x4){0.f, 0.f, 0.f, 0.f}; acc[1] = acc[0];
            mm64(acc, SL(1), SL(0), O); mm64(acc, SL(3), SL(13), O);
            st_nm(SL(9), acc, O);
        }
        __syncthreads();
        { OPQ();
            f32x4 acc[2]; acc[0] = (f32x4){0.f, 0.f, 0.f, 0.f}; acc[1] = acc[0];
            mm64(acc, SL(8), SL(9), O);
            st_nm(SL(10), acc, O);
        }
        __syncthreads();
        { OPQ();
            f32x4 acc[2]; acc[0] = (f32x4){0.f, 0.f, 0.f, 0.f}; acc[1] = acc[0];
            mm64(acc, SL(2), SL(0), O); mm64(acc, SL(6), SL(10), O); mm64(acc, SL(7), SL(13), O);
#pragma unroll
            for (int tt = 0; tt < 2; ++tt)
#pragma unroll
                for (int e = 0; e < 4; ++e) *(LAS float*)(SL(14) + O.f32o[tt] + e * 256) = acc[tt][e];
            const f32x4 gm = *(const LAS f32x4*)(GAMMA + 16 * ti + 4 * fg);
            Hreg[0] = Hreg[0] * gm; Hreg[1] = Hreg[1] * gm;
            mm64(Hreg, SL(11), SL(10), O); mm64(Hreg, SL(12), SL(13), O);
        }
        __syncthreads();
        { IDX(); OPQ();
            st_nm(SL(0), Hreg, O);
            const size_t row = (size_t)b * SEQ + bt * 64 + t;
            float y[8], s1 = 0.f;
            const f32x4 y0 = *(const LAS f32x4*)(SL(14) + (t * 64 + c0) * 4), y1 = *(const LAS f32x4*)(SL(14) + (t * 64 + c0 + 4) * 4);
#pragma unroll
            for (int e = 0; e < 4; ++e) { y[e] = y0[e]; y[4 + e] = y1[e]; s1 += y0[e] + y1[e]; }
            s1 += __shfl_xor(s1, 1); s1 += __shfl_xor(s1, 2); s1 += __shfl_xor(s1, 4);
            const float mean = s1 * (1.0f / 64.0f); float var = 0.f;
#pragma unroll
            for (int e = 0; e < 8; ++e) { y[e] -= mean; var += y[e] * y[e]; }
            var += __shfl_xor(var, 1); var += __shfl_xor(var, 2); var += __shfl_xor(var, 4);
            const float rstd = __builtin_amdgcn_rsqf(var * (1.0f / 64.0f) + GN_EPS), bn = BONUS[t];
            float vs[8], gt[8]; const int o64 = sw64(t, c0); unpack8(*(const LAS u32x4*)(SL(4) + o64), vs); unpack8(*(const LAS u32x4*)(SL(5) + o64), gt);
            const f32x4 gg0 = *(const f32x4*)(gngp_ + hc), gg1 = *(const f32x4*)(gngp_ + hc + 4), gb0 = *(const f32x4*)(gnbp_ + hc), gb1 = *(const f32x4*)(gnbp_ + hc + 4);
            float ov[8];
#pragma unroll
            for (int e = 0; e < 8; ++e) { const float g1 = (e < 4) ? gg0[e & 3] : gg1[e & 3], b1 = (e < 4) ? gb0[e & 3] : gb1[e & 3];
                ov[e] = (y[e] * rstd * g1 + b1 + bn * vs[e]) * gt[e]; }
            *(u32x4*)(PJ + row * PA + C_RR + hc) = pack8f(ov);
        }
        __syncthreads();
    }
#undef SL
#undef IDX
#undef OPQ
}
#undef MFMA16
#undef DPPSUM
}

struct SchedInProj {
    int G, c; const char* A; const char* B;
    __device__ __forceinline__ bool next(int i, pg8::Unit& u) const {
        const int L = i * G + c; const size_t ts = (size_t)256 * 1024 * 2;
        if (L < 1920) { pg8::tile_of(L, 128, 15, u.pm, u.pn); u.tag = 0; }
        else if (L < 1920 + 64) { const int j = L - 1920; u.pm = 128 + (j & 15); u.pn = 27 + (j >> 4); u.tag = 1; }
        else return false;
        u.a = A + (size_t)u.pm * ts; u.b = B + (size_t)u.pn * ts; return true;
    }
};
struct SchedGates {
    int G, c; const char* A; const char* B;
    __device__ __forceinline__ bool next(int i, pg8::Unit& u) const {
        const int L = i * G + c; const size_t ts = (size_t)256 * 1024 * 2;
        if (L >= 1536) return false;
        pg8::tile_of(L, 128, 12, u.pm, u.pn); u.pn += 15; u.tag = 0;
        u.a = A + (size_t)u.pm * ts; u.b = B + (size_t)u.pn * ts; return true;
    }
};
struct SchedMerge {
    int G, c; const char* A; const char* B;
    __device__ __forceinline__ bool next(int i, pg8::Unit& u) const {
        const int br = i % 3, L = (i / 3) * G + c; if (L >= 512) return false;
        pg8::tile_of(L, 128, 4, u.pm, u.pn); u.tag = br;
        const int coff = (br == 0) ? C_FQ : ((br == 1) ? C_RR : C_MQ);
        u.a = A + ((size_t)u.pm * 256 * PA + coff) * 2; u.b = B + ((size_t)(br * 1024 + u.pn * 256) * 512) * 2; return true;
    }
};
struct SchedPlain {
    int G, c, nM, nN; const char* A; const char* B; size_t tsA, tsB;
    __device__ __forceinline__ bool next(int i, pg8::Unit& u) const {
        const int L = i * G + c; if (L >= nM * nN) return false;
        pg8::tile_of(L, nM, nN, u.pm, u.pn); u.tag = 0; u.a = A + (size_t)u.pm * tsA; u.b = B + (size_t)u.pn * tsB; return true;
    }
};

constexpr int N_PHASES = 9;
struct Args { const float* in[28]; float* out; unsigned char* ws; int ph_lo, ph_hi, li, pad; };
__global__ void __launch_bounds__(NWAVES * 64, 2) hyb_fwd(Args args) {
    extern __shared__ __attribute__((aligned(16))) unsigned char lds[];
    Frame F;
    F.lds = (LAS unsigned char*)lds;
    F.MISC = (volatile LAS unsigned*)(F.lds + MISC_OFF);
    F.tid = threadIdx.x; F.lane = F.tid & 63; F.wave = __builtin_amdgcn_readfirstlane(F.tid >> 6);
    F.G = gridDim.x; { const int bx = blockIdx.x; F.vcu = (F.G % 8 == 0) ? (bx % 8) * (F.G / 8) + bx / 8 : bx; }
    F.ws = args.ws; F.out = args.out; F.ctl = (gu32*)(args.ws + WS_CTL);
    for (int u = F.tid; u < (LDS_BYTES - LDSCTL_OFF) / 4; u += NWAVES * 64) ((LAS unsigned*)(F.lds + LDSCTL_OFF))[u] = 0u;
    __syncthreads();
    XcdBarrier bar; bar = xcd_barrier_post((unsigned*)(F.ctl + CW_BAR) + args.li * XCD_BAR_WORDS, F.MISC + 8);
    const int lo = args.ph_lo, hi = args.ph_hi;
#define IN(k) (lo <= (k) && (k) < hi)
#define SEAM(k) do { if (IN(k) && IN((k) + 1)) xcd_barrier(bar); } while (0)
    unsigned char* ws = args.ws;

    if (IN(0)) { p0_prologue(F); SEAM(0); }

    if (IN(1)) {
        pg8::Gemm g{1024, 1024, 1024};
        SchedInProj S{F.G, (int)blockIdx.x, (const char*)(ws + WS_XNALL), (const char*)(ws + WS_WALL)};
        pg8::EpiInProj E{(bf16_t*)(ws + WS_PROJA), (bf16_t*)(ws + WS_G01), (bf16_t*)args.out, (bf16_t*)(ws + WS_MEMKV)};
        pg8::gemm_phase<pg8::EpiInProj, SchedInProj, true, true>(F.lds + RING_OFF, g, S, E);
        SEAM(1);
    }

    if (IN(2)) {
        for (int u = blockIdx.x; u < 128; u += F.G) rwkv::unit(F, u >> 3, u & 7);
        if (F.G > 128 && (int)blockIdx.x >= 128) {
            pg8::Gemm g{1024, 1024, 1024};
            SchedGates S{F.G - 128, (int)blockIdx.x - 128, (const char*)(ws + WS_XNALL), (const char*)(ws + WS_WALL)};
            pg8::EpiInProj E{(bf16_t*)(ws + WS_PROJA), (bf16_t*)(ws + WS_G01), (bf16_t*)args.out, (bf16_t*)(ws + WS_MEMKV)};
            pg8::gemm_phase<pg8::EpiInProj, SchedGates, true, true>(F.lds + RING_OFF, g, S, E);
        }
        for (;;) {
            __syncthreads();
            if (threadIdx.x == 0) F.MISC[16] = __hip_atomic_fetch_add((unsigned*)(F.ctl + CW_QUEUE), 1u, __ATOMIC_RELAXED, __HIP_MEMORY_SCOPE_AGENT);
            __syncthreads();
            const int it = (int)F.MISC[16];
            if (it >= 768) break;
            if (it < 512) {
                const int bh = it >> 2, sidx = it & 3;
                fox::attn_unit<8>(bh >> 3, bh & 7, 7 - sidx, (bf16_t*)(ws + WS_PROJA), (const float*)(ws + WS_LS), (char*)lds + RING_OFF);
                fox::attn_unit<8>(bh >> 3, bh & 7, sidx, (bf16_t*)(ws + WS_PROJA), (const float*)(ws + WS_LS), (char*)lds + RING_OFF);
            } else {
                const int p = it - 512, bh = p >> 2;
                memx::unit(bh >> 2, bh & 3, 2 * (p & 3), true, (bf16_t*)(ws + WS_PROJA), (const bf16_t*)(ws + WS_MEMKV), (char*)lds + RING_OFF);
                memx::unit(bh >> 2, bh & 3, 2 * (p & 3) + 1, false, (bf16_t*)(ws + WS_PROJA), (const bf16_t*)(ws + WS_MEMKV), (char*)lds + RING_OFF);
            }
        }
        SEAM(2);
    }

    if (IN(3)) {
        pg8::Gemm g{512, PA, 512};
        SchedMerge S{F.G, (int)blockIdx.x, (const char*)(ws + WS_PROJA), (const char*)(ws + WS_WBR)};
        pg8::EpiMerge E{(const bf16_t*)(ws + WS_G01), (const bf16_t*)args.out, (bf16_t*)(ws + WS_MERGED)};
        pg8::gemm_phase<pg8::EpiMerge, SchedMerge, true, true>(F.lds + RING_OFF, g, S, E);
        SEAM(3);
    }

    if (IN(4)) {
        pg8::Gemm g{1024, 1024, 1024};
        SchedPlain S{F.G, (int)blockIdx.x, 128, 4, (const char*)(ws + WS_MERGED), (const char*)(ws + WS_WO), (size_t)256 * 1024 * 2, (size_t)256 * 1024 * 2};
        pg8::EpiPlain E{(bf16_t*)(ws + WS_Y), 1024};
        pg8::gemm_phase<pg8::EpiPlain, SchedPlain, true, true>(F.lds + RING_OFF, g, S, E);
        SEAM(4);
    }

    if (IN(5)) { p3c_rows(F); SEAM(5); }

    if (IN(6)) {
        pg8::Gemm g{1024, 1024, 1024};
        SchedPlain S{F.G, (int)blockIdx.x, 128, 22, (const char*)(ws + WS_U2), (const char*)(ws + WS_WGU), (size_t)256 * 1024 * 2, (size_t)256 * 1024 * 2};
        pg8::EpiSwiGLU E{(bf16_t*)(ws + WS_HID)};
        pg8::gemm_phase<pg8::EpiSwiGLU, SchedPlain, true, true>(F.lds + RING_OFF, g, S, E);
        SEAM(6);
    }

    if (IN(7)) {
        pg8::Gemm g{DFF, DFF, DFF};
        SchedPlain S{F.G, (int)blockIdx.x, 128, 4, (const char*)(ws + WS_HID), (const char*)(ws + WS_WDN), (size_t)256 * DFF * 2, (size_t)256 * DFF * 2};
        pg8::EpiPlain E{(bf16_t*)(ws + WS_FO), 1024};
        pg8::gemm_phase<pg8::EpiPlain, SchedPlain, true, true>(F.lds + RING_OFF, g, S, E);
        SEAM(7);
    }

    if (IN(8)) { p5c_rows(F); }
#undef IN
#undef SEAM
}

extern "C" void kernel_launch(void* const* d_in, const int* in_sizes, int n_in, void* d_out, int out_size, void* d_ws, size_t ws_size, hipStream_t stream) {
    static int grid = 0;
    if (grid == 0) {
        if (n_in != 28 || in_sizes[0] != M * DM || out_size != M * DM || ws_size < WS_END) { fprintf(stderr, "kernel_launch: unexpected shapes (n_in %d, in0 %d, out %d, ws %zu)\n", n_in, n_in > 0 ? in_sizes[0] : -1, out_size, ws_size); grid = -1; return; }
        int dev = 0, cus = 0, per_cu = 0;
        if (hipGetDevice(&dev) != hipSuccess || hipDeviceGetAttribute(&cus, hipDeviceAttributeMultiprocessorCount, dev) != hipSuccess) { grid = -1; return; }
        if (hipFuncSetAttribute((const void*)hyb_fwd, hipFuncAttributeMaxDynamicSharedMemorySize, LDS_BYTES) != hipSuccess) { fprintf(stderr, "kernel_launch: hipFuncSetAttribute failed\n"); grid = -1; return; }
        if (hipOccupancyMaxActiveBlocksPerMultiprocessor(&per_cu, (const void*)hyb_fwd, NWAVES * 64, LDS_BYTES) != hipSuccess || per_cu < 1) { fprintf(stderr, "kernel_launch: occupancy query says %d blocks per CU\n", per_cu); (void)hipGetLastError(); grid = -1; return; }
        grid = cus;
    }
    if (grid < 0) return;
    if (hipMemsetAsync((char*)d_ws + WS_CTL, 0, CTL_ZERO_BYTES, stream) != hipSuccess) return;
    Args a{};
    for (int i = 0; i < 28; ++i) a.in[i] = (const float*)d_in[i];
    a.out = (float*)d_out; a.ws = (unsigned char*)d_ws;
#ifdef PROBE_PLAN
    {
        static const int plan[][2] = PROBE_PLAN; const int np = (int)(sizeof(plan) / sizeof(plan[0]));
        for (int li = 0; li < np; ++li) { a.ph_lo = plan[li][0]; a.ph_hi = plan[li][1]; a.li = li; hipLaunchKernelGGL(hyb_fwd, dim3(grid), dim3(NWAVES * 64), LDS_BYTES, stream, a); }
    }
#else
    a.ph_lo = 0; a.ph_hi = N_PHASES; a.li = 0; hipLaunchKernelGGL(hyb_fwd, dim3(grid), dim3(NWAVES * 64), LDS_BYTES, stream, a);
#endif
}
```
